# Optimizing an MI355X kernel written in HIP

```python
import math
import jax, jax.numpy as jnp
from jax import lax
import numpy as np

D_MODEL = 1024
BATCH = 8
SEQ = 2048
DEPTH = 2

N_MIXERS = 2
N_HEADS = 16
A_LATENT = 128
A_VHEAD = 64
IDX_HEADS = 8
IDX_DIM = 64
TOPK_MAX = 256
Q_BLOCK = 128
B_KV_HEADS = 2
B_HEAD_DIM = 64
WINDOW = 128
D_FF = ((8 * D_MODEL + 3 * 256 - 1) // (3 * 256)) * 256
REL_BUCKETS = 32
REL_MAX_DIST = 128
EPS = 1e-6

A_SIZES = [N_HEADS * A_LATENT, A_LATENT, IDX_HEADS * IDX_DIM, IDX_DIM, IDX_HEADS]
A_IN = sum(A_SIZES)
B_SIZES = [N_HEADS * B_HEAD_DIM, B_KV_HEADS * B_HEAD_DIM, B_KV_HEADS * B_HEAD_DIM]
B_IN = sum(B_SIZES)
N_A_LAYERS = (DEPTH + 1) // 2
N_B_LAYERS = DEPTH // 2

kernel_name = "hybrid_dsa_swa_sink_t5bias_swiglu"


def _split(proj, sizes):
    offs, o = [], 0
    for s in sizes[:-1]:
        o += s
        offs.append(o)
    return jnp.split(proj, offs, axis=-1)


def rms_norm(x, g):
    xf = x.astype(jnp.float32)
    y = xf * lax.rsqrt(jnp.mean(xf * xf, axis=-1, keepdims=True) + EPS)
    return (y * g.astype(jnp.float32)).astype(x.dtype)


def rel_bucket(rel):
    n = jnp.maximum(rel, 0)
    max_exact = REL_BUCKETS // 2
    nf = jnp.maximum(n, max_exact).astype(jnp.float32)
    large = max_exact + (jnp.log(nf / max_exact) / math.log(REL_MAX_DIST / max_exact)
                         * (REL_BUCKETS - max_exact)).astype(jnp.int32)
    large = jnp.minimum(large, REL_BUCKETS - 1)
    return jnp.where(n < max_exact, n, large)


def dsa_mixer(h, w_in, latent_g, w_uv, w_out, rel_bias):
    B, T, _ = h.shape
    H, R = N_HEADS, A_LATENT
    k_sel = min(TOPK_MAX, T // 4)
    nblk = T // Q_BLOCK
    q_lat, c_kv, q_idx, k_idx, w_idx = _split(h @ w_in, A_SIZES)
    q_lat = q_lat.reshape(B, T, H, R)
    q_idx = q_idx.reshape(B, T, IDX_HEADS, IDX_DIM)
    c_kv = rms_norm(c_kv, latent_g)
    w_idx = w_idx * (IDX_HEADS ** -0.5)

    def to_blocks(a):
        return jnp.moveaxis(a.reshape((B, nblk, Q_BLOCK) + a.shape[2:]), 1, 0)

    s_pos = jnp.arange(T)

    def block(args):
        i, qlb, qib, wib = args
        t_pos = i * Q_BLOCK + jnp.arange(Q_BLOCK)
        dots = jnp.einsum('bqjd,bsd->bqjs', qib, k_idx) * (IDX_DIM ** -0.5)
        score = jnp.einsum('bqj,bqjs->bqs', wib, jax.nn.relu(dots)).astype(jnp.float32)
        causal = s_pos[None, :] <= t_pos[:, None]
        score = jnp.where(causal[None], score, -jnp.inf)
        _, idx = lax.top_k(score, k_sel)
        valid = idx <= t_pos[None, :, None]
        kv = jax.vmap(lambda c, ix: c[ix])(c_kv, idx)
        logits = jnp.einsum('bqhr,bqkr->bhqk', qlb, kv).astype(jnp.float32) * (R ** -0.5)
        bias = rel_bias[rel_bucket(t_pos[None, :, None] - idx)]
        logits = logits + jnp.transpose(bias, (0, 3, 1, 2)).astype(jnp.float32)
        logits = jnp.where(valid[:, None], logits, -jnp.inf)
        p = jax.nn.softmax(logits, axis=-1).astype(kv.dtype)
        return jnp.einsum('bhqk,bqkr->bqhr', p, kv)

    o = lax.map(block, (jnp.arange(nblk), to_blocks(q_lat), to_blocks(q_idx), to_blocks(w_idx)))
    o = jnp.moveaxis(o, 0, 1).reshape(B, T, H, R)
    o = jnp.einsum('bthr,hrd->bthd', o, w_uv).reshape(B, T, H * A_VHEAD)
    return o @ w_out


def swa_mixer(h, w_in, b_in, sinks, w_out, b_out, rel_bias):
    B, T, _ = h.shape
    W, G, KV, Dh = WINDOW, N_HEADS // B_KV_HEADS, B_KV_HEADS, B_HEAD_DIM
    nb = T // W
    q, k, v = _split(h @ w_in + b_in, B_SIZES)
    q = q.reshape(B, nb, W, KV, G, Dh)
    k = k.reshape(B, nb, W, KV, Dh)
    v = v.reshape(B, nb, W, KV, Dh)

    def with_prev(a):
        prev = jnp.pad(a, ((0, 0), (1, 0), (0, 0), (0, 0), (0, 0)))[:, :-1]
        return jnp.concatenate([prev, a], axis=2)

    kk, vv = with_prev(k), with_prev(v)
    logits = jnp.einsum('bnqkgd,bnskd->bnkgqs', q, kk).astype(jnp.float32) * (Dh ** -0.5)
    rel = (W + jnp.arange(W))[:, None] - jnp.arange(2 * W)[None, :]
    in_win = (rel >= 0) & (rel < W)
    key_exists = (jnp.arange(nb)[:, None] * W + jnp.arange(2 * W)[None, :] - W) >= 0
    mask = in_win[None] & key_exists[:, None, :]
    bias = rel_bias[rel_bucket(rel)].reshape(W, 2 * W, KV, G)
    logits = logits + jnp.transpose(bias, (2, 3, 0, 1)).astype(jnp.float32)
    logits = jnp.where(mask[None, :, None, None], logits, -jnp.inf)
    sink = jnp.broadcast_to(sinks.reshape(KV, G)[None, None, :, :, None, None].astype(jnp.float32),
                            logits.shape[:-1] + (1,))
    p = jax.nn.softmax(jnp.concatenate([logits, sink], axis=-1), axis=-1)[..., :-1]
    o = jnp.einsum('bnkgqs,bnskd->bnqkgd', p.astype(vv.dtype), vv)
    return o.reshape(B, T, N_HEADS * Dh) @ w_out + b_out


def swiglu(h, w_gate_up, w_down):
    g, u = jnp.split(h @ w_gate_up, 2, axis=-1)
    return (jax.nn.silu(g) * u) @ w_down


def setup_inputs(seed: int = 0) -> dict:
    key = jax.random.key(seed)
    ks = jax.random.split(key, 20)
    f = jnp.float32

    def w(k, shape, fan_in):
        return jax.random.normal(k, shape, f) * (fan_in ** -0.5)

    def gain(k, shape):
        return 1.0 + 0.02 * jax.random.normal(k, shape, f)

    return {
        "x": jax.random.normal(ks[0], (BATCH, SEQ, D_MODEL), f),
        "rel_bias": 0.5 * jax.random.normal(ks[1], (REL_BUCKETS, N_HEADS), f),
        "attn_norm": gain(ks[2], (DEPTH, D_MODEL)),
        "ffn_norm": gain(ks[3], (DEPTH, D_MODEL)),
        "final_norm": gain(ks[4], (D_MODEL,)),
        "a_w_in": w(ks[5], (N_A_LAYERS, D_MODEL, A_IN), D_MODEL),
        "a_latent_norm": gain(ks[6], (N_A_LAYERS, A_LATENT)),
        "a_w_uv": w(ks[7], (N_A_LAYERS, N_HEADS, A_LATENT, A_VHEAD), A_LATENT),
        "a_w_out": w(ks[8], (N_A_LAYERS, N_HEADS * A_VHEAD, D_MODEL), N_HEADS * A_VHEAD),
        "b_w_in": w(ks[9], (N_B_LAYERS, D_MODEL, B_IN), D_MODEL),
        "b_b_in": 0.02 * jax.random.normal(ks[10], (N_B_LAYERS, B_IN), f),
        "b_sinks": 0.5 * jax.random.normal(ks[11], (N_B_LAYERS, N_HEADS), f),
        "b_w_out": w(ks[12], (N_B_LAYERS, N_HEADS * B_HEAD_DIM, D_MODEL), N_HEADS * B_HEAD_DIM),
        "b_b_out": 0.02 * jax.random.normal(ks[13], (N_B_LAYERS, D_MODEL), f),
        "ffn_w_gate_up": w(ks[14], (DEPTH, D_MODEL, 2 * D_FF), D_MODEL),
        "ffn_w_down": w(ks[15], (DEPTH, D_FF, D_MODEL), D_FF),
    }


def reference(x, rel_bias, attn_norm, ffn_norm, final_norm,
              a_w_in, a_latent_norm, a_w_uv, a_w_out,
              b_w_in, b_b_in, b_sinks, b_w_out, b_b_out,
              ffn_w_gate_up, ffn_w_down):
    for layer in range(DEPTH):
        j = layer // N_MIXERS
        h = rms_norm(x, attn_norm[layer])
        if layer % N_MIXERS == 0:
            x = x + dsa_mixer(h, a_w_in[j], a_latent_norm[j], a_w_uv[j], a_w_out[j], rel_bias)
        else:
            x = x + swa_mixer(h, b_w_in[j], b_b_in[j], b_sinks[j], b_w_out[j], b_b_out[j], rel_bias)
        h = rms_norm(x, ffn_norm[layer])
        x = x + swiglu(h, ffn_w_gate_up[layer], ffn_w_down[layer])
    return rms_norm(x, final_norm)
```

```cpp
#include <hip/hip_runtime.h>
#include <hip/hip_cooperative_groups.h>
#include <cstdio>
#include <cstdint>
namespace cg = cooperative_groups;

typedef _Float16 f16x8 __attribute__((ext_vector_type(8)));
typedef _Float16 f16x2 __attribute__((ext_vector_type(2)));
typedef _Float16 f16;
namespace pg8 {
#define PG8_LAS __attribute__((address_space(3)))
typedef unsigned short bf16_t;
typedef short bf16x8 __attribute__((ext_vector_type(8)));
typedef float f32x4 __attribute__((ext_vector_type(4)));
typedef unsigned u32x4 __attribute__((ext_vector_type(4)));
constexpr int BM = 256, BK = 64, HALF = 128, HTB = HALF * BK * 2  , STAGE_BYTES = 8 * HTB, NXCD = 8, WGM = 8;

__host__ __device__ __forceinline__ int lds_byte(int r, int c) { const int st = (r >> 4) * 2 + (c >> 5), rr = r & 15, cc = c & 31, ob = rr * 64 + cc * 2; return st * 1024 + (ob ^ (((ob >> 9) & 1) << 5)); }
__host__ __device__ __forceinline__ void stage_rc(int b, int& R, int& C) { const int st = b / 1024, sb = b % 1024, swz = sb ^ (((sb >> 9) & 1) << 5); R = (st >> 1) * 16 + swz / 64; C = (st & 1) * 32 + (swz % 64) / 2; }
__host__ __device__ __forceinline__ int perm32(int rho) { const int n = rho >> 4, i = rho & 15; return 8 * (i >> 2) + 4 * n + (i & 3); }

struct Unit { int pm, pn; };
struct Gemm { const bf16_t* A; const bf16_t* Bt; int M, N, K; };

struct StaticOrder {
    int nM, nN, nwg, G, c;
    __host__ __device__ void init(int M, int N, int G_, int c_) { nM = M / BM; nN = N / BM; nwg = nM * nN; G = G_; c = c_; }
    __host__ __device__ bool next(int i, Unit& u) const {
        const long L = (long)i * G + c; if (L >= nwg) return false;
        int wgid = (int)L; { const int q = nwg / NXCD, r = nwg % NXCD, xcd = wgid % NXCD, off = wgid / NXCD; wgid = (xcd < r ? xcd * (q + 1) : r * (q + 1) + (xcd - r) * q) + off; }
        const int nig = WGM * nN, gid = wgid / nig, fm = gid * WGM, gsz = (nM - fm) < WGM ? (nM - fm) : WGM;
        u.pm = fm + ((wgid % nig) % gsz); u.pn = (wgid % nig) / gsz; return true;
    }
    __device__ __forceinline__ void a_ready(const Unit&) const {}
    __device__ __forceinline__ void done(const Unit&) const {}
};

__device__ __forceinline__ unsigned pk2h(float lo, float hi) { f16x2 v = {(_Float16)lo, (_Float16)hi}; return __builtin_bit_cast(unsigned, v); }
__device__ __forceinline__ u32x4 pk8h(f32x4 a, f32x4 b) { u32x4 w; w.x = pk2h(a[0], a[1]); w.y = pk2h(a[2], a[3]); w.z = pk2h(b[0], b[1]); w.w = pk2h(b[2], b[3]); return w; }
constexpr float RMS_EPS = 1e-6f;

struct EpiInA {
    static constexpr bool PERM = true, AFTER_DRAIN = false;
    const float* rs; bf16_t* QL; float* CKV; bf16_t* QI; bf16_t* KI; float* WI;
    __device__ __forceinline__ void operator()(const f32x4 (&acc)[2][2][4][2], const Unit& u, int wr, int wc, int fr, int fq) const {
        const int row0 = u.pm * BM + wr * 64 + fr;
#pragma unroll
        for (int ai = 0; ai < 2; ++ai)
#pragma unroll
            for (int m = 0; m < 4; ++m) { const int row = row0 + ai * HALF + m * 16; const float r = rs[row];
#pragma unroll
                for (int bj = 0; bj < 2; ++bj) { const int col = u.pn * BM + bj * HALF + wc * 32 + 8 * fq;
                    f32x4 v0 = acc[ai][bj][m][0] * r, v1 = acc[ai][bj][m][1] * r;
                    if (col < 2048) { *(u32x4*)(QL + (size_t)row * 2048 + col) = pk8h(v0, v1); }
                    else if (col < 2176) { float* p = CKV + (size_t)row * 128 + (col - 2048); *(f32x4*)p = v0; *(f32x4*)(p + 4) = v1; }
                    else if (col < 2688) { v0 = v0 * 0.125f; v1 = v1 * 0.125f; *(u32x4*)(QI + (size_t)row * 512 + (col - 2176)) = pk8h(v0, v1); }
                    else if (col < 2752) { *(u32x4*)(KI + (size_t)row * 64 + (col - 2688)) = pk8h(v0, v1); }
                    else if (col < 2760) { const float s = 0.35355339059327373f; float* p = WI + (size_t)row * 8; *(f32x4*)p = v0 * s; *(f32x4*)(p + 4) = v1 * s; }
                } }
    }
};
struct EpiRes {
    static constexpr bool PERM = true, AFTER_DRAIN = false;
    const float* xold; float* xnew; bf16_t* xh; float* ss; const float* bias;
    __device__ __forceinline__ void operator()(const f32x4 (&acc)[2][2][4][2], const Unit& u, int wr, int wc, int fr, int fq) const {
        const int row0 = u.pm * BM + wr * 64 + fr;
#pragma unroll
        for (int ai = 0; ai < 2; ++ai)
#pragma unroll
            for (int m = 0; m < 4; ++m) { const int row = row0 + ai * HALF + m * 16; float sq = 0.f;
#pragma unroll
                for (int bj = 0; bj < 2; ++bj) { const int col = u.pn * BM + bj * HALF + wc * 32 + 8 * fq; const size_t off = (size_t)row * 1024 + col;
                    f32x4 v0 = acc[ai][bj][m][0] + *(const f32x4*)(xold + off), v1 = acc[ai][bj][m][1] + *(const f32x4*)(xold + off + 4);
                    if (bias) { v0 = v0 + *(const f32x4*)(bias + col); v1 = v1 + *(const f32x4*)(bias + col + 4); }
                    *(f32x4*)(xnew + off) = v0; *(f32x4*)(xnew + off + 4) = v1;
                    *(u32x4*)(xh + off) = pk8h(v0, v1);
                    sq += (v0[0] * v0[0] + v0[1] * v0[1]) + (v0[2] * v0[2] + v0[3] * v0[3]) + (v1[0] * v1[0] + v1[1] * v1[1]) + (v1[2] * v1[2] + v1[3] * v1[3]); }
                sq += __shfl_xor(sq, 16); sq += __shfl_xor(sq, 32);
                if (fq == 0) atomicAdd(ss + row, sq); }
    }
};
struct EpiGU {
    static constexpr bool PERM = true, AFTER_DRAIN = false;
    const float* ss; bf16_t* HB;
    __device__ __forceinline__ void operator()(const f32x4 (&acc)[2][2][4][2], const Unit& u, int wr, int wc, int fr, int fq) const {
        const int row0 = u.pm * BM + wr * 64 + fr; const int col = u.pn * HALF + wc * 32 + 8 * fq;
#pragma unroll
        for (int ai = 0; ai < 2; ++ai)
#pragma unroll
            for (int m = 0; m < 4; ++m) { const int row = row0 + ai * HALF + m * 16; const float r = 1.0f / sqrtf(ss[row] * (1.0f / 1024.0f) + RMS_EPS);
                f32x4 hv[2];
#pragma unroll
                for (int n = 0; n < 2; ++n)
#pragma unroll
                    for (int j = 0; j < 4; ++j) { const float g = acc[ai][0][m][n][j] * r, uu = acc[ai][1][m][n][j] * r;
                        hv[n][j] = g * __builtin_amdgcn_rcpf(1.0f + __builtin_amdgcn_exp2f(-1.4426950408889634f * g)) * uu; }
                *(u32x4*)(HB + (size_t)row * 2816 + col) = pk8h(hv[0], hv[1]); }
    }
};
struct EpiInB {
    static constexpr bool PERM = true, AFTER_DRAIN = false;
    const float* ss; const float* bias; bf16_t* QKV;
    __device__ __forceinline__ void operator()(const f32x4 (&acc)[2][2][4][2], const Unit& u, int wr, int wc, int fr, int fq) const {
        const int row0 = u.pm * BM + wr * 64 + fr;
#pragma unroll
        for (int ai = 0; ai < 2; ++ai)
#pragma unroll
            for (int m = 0; m < 4; ++m) { const int row = row0 + ai * HALF + m * 16; const float r = 1.0f / sqrtf(ss[row] * (1.0f / 1024.0f) + RMS_EPS);
#pragma unroll
                for (int bj = 0; bj < 2; ++bj) { const int col = u.pn * BM + bj * HALF + wc * 32 + 8 * fq;
                    const f32x4 v0 = acc[ai][bj][m][0] * r + *(const f32x4*)(bias + col), v1 = acc[ai][bj][m][1] * r + *(const f32x4*)(bias + col + 4);
                    *(u32x4*)(QKV + (size_t)row * 1280 + col) = pk8h(v0, v1); } }
    }
};

template <class Epi, class Sched, bool ALIGN_EPI = false, bool SP2 = false>
__device__ __forceinline__ void gemm_phase(PG8_LAS unsigned char* lds, const Gemm g, const Sched& S, const Epi& E) {
    const int tid = threadIdx.x, wid = __builtin_amdgcn_readfirstlane(tid >> 6), lane = tid & 63, wr = wid >> 2, wc = wid & 3, fr = lane & 15, fq = lane >> 4;
    const int K = g.K, nt = K / BK;
    unsigned voffA[2], voffB[2];
#pragma unroll
    for (int i = 0; i < 2; ++i) { int R, C; stage_rc(tid * 16 + i * 8192, R, C); const int Rb = Epi::PERM ? ((R & ~31) + perm32(R & 31)) : R;
        voffA[i] = (unsigned)(R * K + C) * 2u; voffB[i] = (unsigned)(Rb * K + C) * 2u; }
    const size_t kstep = (size_t)(BK * 2);
    const size_t hstep = (size_t)HALF * K * 2;
    const size_t tstep = 2 * hstep;
    const unsigned ldsw = (unsigned)wid * 1024u;
    const int aoff = lds_byte(wr * 64 + fr, fq * 8), boff = lds_byte(wc * 32 + fr, fq * 8);
#define PG8_SA(b, h) (((b) * 2 + (h)) * HTB)
#define PG8_SB(b, h) ((4 + (b) * 2 + (h)) * HTB)
#define PG8_STAGE(bufoff, gbase, voff) do { _Pragma("unroll") for (int _i = 0; _i < 2; ++_i) \
        __builtin_amdgcn_global_load_lds((const unsigned*)((const char*)(gbase) + (voff)[_i]), (PG8_LAS unsigned*)(lds + (bufoff) + ldsw + _i * 8192), 16, 0, 0); } while (0)
#define PG8_LDA(dst, b, h) do { _Pragma("unroll") for (int m = 0; m < 4; ++m) _Pragma("unroll") for (int k = 0; k < 2; ++k) dst[m][k] = *(const PG8_LAS bf16x8*)(lds + PG8_SA(b, h) + aoff + m * 2048 + k * 1024); } while (0)
#define PG8_LDB(dst, b, h) do { _Pragma("unroll") for (int n = 0; n < 2; ++n) _Pragma("unroll") for (int k = 0; k < 2; ++k) dst[n][k] = *(const PG8_LAS bf16x8*)(lds + PG8_SB(b, h) + boff + n * 2048 + k * 1024); } while (0)
#define PG8_MMA(ai, bj, At, Bt) do { __builtin_amdgcn_s_setprio(1); _Pragma("unroll") for (int m = 0; m < 4; ++m) _Pragma("unroll") for (int n = 0; n < 2; ++n) _Pragma("unroll") for (int k = 0; k < 2; ++k) \
        acc[ai][bj][m][n] = __builtin_amdgcn_mfma_f32_16x16x32_f16(__builtin_bit_cast(f16x8, Bt[n][k]), __builtin_bit_cast(f16x8, At[m][k]), acc[ai][bj][m][n], 0, 0, 0); __builtin_amdgcn_s_setprio(0); } while (0)
#define PG8_WAIT_V(n) asm volatile("s_waitcnt vmcnt(" #n ")" ::: "memory")
#define PG8_WAIT_L(n) asm volatile("s_waitcnt lgkmcnt(" #n ")" ::: "memory")
#define PG8_BAR __builtin_amdgcn_s_barrier()
#define PG8_SCHED __builtin_amdgcn_sched_barrier(0)
    Unit cur, nxt; int ui = 0;
    if (!S.next(0, cur)) return;
    f32x4 acc[2][2][4][2];
#pragma unroll
    for (int a = 0; a < 2; ++a)
#pragma unroll
        for (int b = 0; b < 2; ++b)
#pragma unroll
            for (int m = 0; m < 4; ++m)
#pragma unroll
                for (int n = 0; n < 2; ++n) acc[a][b][m][n] = (f32x4){0.f, 0.f, 0.f, 0.f};
    bf16x8 At[4][2], B0[2][2], B1[2][2];
    const char* cA = (const char*)g.A + (size_t)cur.pm * tstep; const char* cB = (const char*)g.Bt + (size_t)cur.pn * tstep;
    S.a_ready(cur);
    if constexpr (SP2) {
        PG8_STAGE(PG8_SB(0, 0), cB, voffB); PG8_STAGE(PG8_SB(0, 1), cB + hstep, voffB); PG8_STAGE(PG8_SA(0, 0), cA, voffA); PG8_STAGE(PG8_SA(0, 1), cA + hstep, voffA);
        if (wr == 1) PG8_BAR;
        PG8_WAIT_V(2); PG8_BAR;
        PG8_STAGE(PG8_SB(1, 0), cB + kstep, voffB); PG8_STAGE(PG8_SA(1, 0), cA + kstep, voffA); PG8_STAGE(PG8_SB(1, 1), cB + hstep + kstep, voffB);
        PG8_WAIT_V(6); PG8_BAR;
    } else {
        PG8_STAGE(PG8_SB(0, 0), cB, voffB); PG8_STAGE(PG8_SA(0, 0), cA, voffA); PG8_STAGE(PG8_SB(0, 1), cB + hstep, voffB); PG8_STAGE(PG8_SA(0, 1), cA + hstep, voffA);
        if (wr == 1) PG8_BAR;
        PG8_WAIT_V(4); PG8_BAR;
        PG8_STAGE(PG8_SB(1, 0), cB + kstep, voffB); PG8_STAGE(PG8_SA(1, 0), cA + kstep, voffA); PG8_STAGE(PG8_SB(1, 1), cB + hstep + kstep, voffB);
        PG8_WAIT_V(6); PG8_BAR;
    }
    for (;;) {
        const bool has_next = S.next(ui + 1, nxt);
        const char* nA = has_next ? (const char*)g.A + (size_t)nxt.pm * tstep : cA; const char* nB = has_next ? (const char*)g.Bt + (size_t)nxt.pn * tstep : cB;
        for (int t = 0; t < nt; t += 2) {
            const bool last = (t == nt - 2);
            const char* a1 = cA + (size_t)(t + 1) * kstep;
            const char* a2 = last ? nA : cA + (size_t)(t + 2) * kstep; const char* b2 = last ? nB : cB + (size_t)(t + 2) * kstep;
            const char* a3 = a2 + kstep; const char* b3 = b2 + kstep;
            if (last && has_next) S.a_ready(nxt);
            if constexpr (SP2) {
            PG8_LDB(B0, 0, 0); PG8_LDB(B1, 0, 1); PG8_SCHED; PG8_LDA(At, 0, 0); PG8_STAGE(PG8_SA(1, 1), a1 + hstep, voffA);
            PG8_WAIT_V(8); PG8_WAIT_L(0); PG8_BAR; PG8_MMA(0, 0, At, B0); PG8_MMA(0, 1, At, B1); PG8_BAR; PG8_SCHED;
            PG8_LDA(At, 0, 1); PG8_STAGE(PG8_SB(0, 0), b2, voffB); PG8_STAGE(PG8_SB(0, 1), b2 + hstep, voffB); PG8_STAGE(PG8_SA(0, 0), a2, voffA);
            PG8_WAIT_V(8); PG8_WAIT_L(0); PG8_BAR; PG8_MMA(1, 0, At, B0); PG8_MMA(1, 1, At, B1); PG8_BAR; PG8_SCHED;
            PG8_LDB(B0, 1, 0); PG8_LDB(B1, 1, 1); PG8_SCHED; PG8_LDA(At, 1, 0); PG8_STAGE(PG8_SA(0, 1), a2 + hstep, voffA);
            PG8_WAIT_V(8); PG8_WAIT_L(0); PG8_BAR; PG8_MMA(0, 0, At, B0); PG8_MMA(0, 1, At, B1); PG8_BAR; PG8_SCHED;
            PG8_LDA(At, 1, 1); PG8_STAGE(PG8_SB(1, 0), b3, voffB); PG8_STAGE(PG8_SB(1, 1), b3 + hstep, voffB); PG8_STAGE(PG8_SA(1, 0), a3, voffA);
            PG8_WAIT_V(8); PG8_WAIT_L(0); PG8_BAR; PG8_MMA(1, 0, At, B0); PG8_MMA(1, 1, At, B1); PG8_BAR; PG8_SCHED;
            } else {
            PG8_LDB(B0, 0, 0); PG8_SCHED; PG8_LDA(At, 0, 0); PG8_STAGE(PG8_SA(1, 1), a1 + hstep, voffA);
            PG8_WAIT_L(8); PG8_BAR; PG8_WAIT_L(0); PG8_MMA(0, 0, At, B0); PG8_BAR; PG8_SCHED;
            PG8_LDB(B1, 0, 1); PG8_STAGE(PG8_SB(0, 0), b2, voffB);
            PG8_BAR; PG8_WAIT_L(0); PG8_MMA(0, 1, At, B1); PG8_BAR;
            PG8_LDA(At, 0, 1); PG8_STAGE(PG8_SA(0, 0), a2, voffA);
            PG8_BAR; PG8_WAIT_L(0); PG8_MMA(1, 0, At, B0); PG8_BAR; PG8_SCHED;
            PG8_STAGE(PG8_SB(0, 1), b2 + hstep, voffB);
            PG8_WAIT_V(6); PG8_BAR; PG8_MMA(1, 1, At, B1); PG8_BAR;
            PG8_LDB(B0, 1, 0); PG8_SCHED; PG8_LDA(At, 1, 0); PG8_STAGE(PG8_SA(0, 1), a2 + hstep, voffA);
            PG8_WAIT_L(8); PG8_BAR; PG8_WAIT_L(0); PG8_MMA(0, 0, At, B0); PG8_BAR; PG8_SCHED;
            PG8_LDB(B1, 1, 1); PG8_STAGE(PG8_SB(1, 0), b3, voffB);
            PG8_BAR; PG8_WAIT_L(0); PG8_MMA(0, 1, At, B1); PG8_BAR;
            PG8_LDA(At, 1, 1); PG8_STAGE(PG8_SA(1, 0), a3, voffA);
            PG8_BAR; PG8_WAIT_L(0); PG8_MMA(1, 0, At, B0); PG8_BAR; PG8_SCHED;
            PG8_STAGE(PG8_SB(1, 1), b3 + hstep, voffB);
            PG8_WAIT_V(6); PG8_BAR; PG8_MMA(1, 1, At, B1); PG8_BAR;
            }
        }
        if constexpr (ALIGN_EPI) { if (wr == 0) PG8_BAR; }
        if constexpr (!Epi::AFTER_DRAIN) { E(acc, cur, wr, wc, fr, fq); S.done(cur); }
        if (!has_next) break;
#pragma unroll
        for (int a = 0; a < 2; ++a)
#pragma unroll
            for (int b = 0; b < 2; ++b)
#pragma unroll
                for (int m = 0; m < 4; ++m)
#pragma unroll
                    for (int n = 0; n < 2; ++n) acc[a][b][m][n] = (f32x4){0.f, 0.f, 0.f, 0.f};
        cur = nxt; cA = nA; cB = nB; ++ui;
        if constexpr (ALIGN_EPI) { if (wr == 1) PG8_BAR; }
    }
    PG8_WAIT_V(0);
    if constexpr (!ALIGN_EPI) { if (wr == 0) PG8_BAR; }
    PG8_BAR;
    if constexpr (Epi::AFTER_DRAIN) { E.fused(acc, cur, wr, wc, fr, fq, lds, wid, lane); S.done(cur); }
#undef PG8_SA
#undef PG8_SB
#undef PG8_STAGE
#undef PG8_LDA
#undef PG8_LDB
#undef PG8_MMA
#undef PG8_WAIT_V
#undef PG8_WAIT_L
#undef PG8_BAR
#undef PG8_SCHED
}
}

constexpr int NB = 8, T = 2048, D = 1024, M = NB * T, NH = 16, RL = 128, VH = 64, HI = 8, DI = 64, KSEL = 256;
constexpr int A_IN = 2760, A_PAD = 2816, B_IN = 1280, FF = 2816, WIN = 128;
constexpr int NWAVES = 8, NTHREADS = NWAVES * 64;
constexpr int N_PHASES = 13;
#ifndef MK_ONE_LAUNCH
#define MK_ONE_LAUNCH 0
#endif
constexpr size_t MiB = 1u << 20;
constexpr size_t WS_CTL = 0, CTL_ZERO_BYTES = 1 * MiB;
constexpr size_t WS_SS1 = 256 * 1024, WS_SS2 = 320 * 1024, WS_SS3 = 384 * 1024;
constexpr size_t WS_RS0 = 1 * MiB;
constexpr size_t WS_WA = 2 * MiB, WS_WUV = WS_WA + (size_t)A_PAD * D * 2, WS_WAO = 8 * MiB, WS_WGU0 = 10 * MiB, WS_WGU1 = 21 * MiB, WS_WD0 = 32 * MiB,
                 WS_WD1 = WS_WD0 + (size_t)D * FF * 2, WS_WB = 43 * MiB, WS_WBO = 46 * MiB;
constexpr size_t WS_XH = 50 * MiB;
constexpr size_t WS_QL = 82 * MiB, WS_CKV = 146 * MiB, WS_CKVN = 154 * MiB, WS_QI = 158 * MiB, WS_KI = 174 * MiB, WS_WI = 176 * MiB, WS_IDX = 178 * MiB, WS_OV = 186 * MiB;
constexpr size_t WS_HB = 82 * MiB, WS_QKV1 = 170 * MiB, WS_OB = 210 * MiB, WS_END = 242 * MiB;
static_assert(WS_WUV + 16 * 64 * 128 * 2 <= WS_WAO && WS_WD1 + (size_t)D * FF * 2 <= WS_WB && WS_WB + (size_t)B_IN * D * 2 <= WS_WBO && WS_WBO + 2 * MiB <= WS_XH, "weights map");
static_assert(WS_HB + (size_t)M * FF * 2 <= WS_QKV1 && WS_QKV1 + (size_t)M * B_IN * 2 <= WS_OB && WS_OB + (size_t)M * D * 2 <= WS_END, "activation map");
constexpr int LDS_BYTES = 147456;

#define GAS __attribute__((address_space(1)))
#define LAS __attribute__((address_space(3)))
typedef unsigned v4u __attribute__((ext_vector_type(4)));
typedef float f32x4 __attribute__((ext_vector_type(4)));
typedef unsigned short hbits;
using pg8::pk2h;

__device__ const unsigned char BUCKET_TAB[129] = {0,1,2,3,4,5,6,7,8,9,10,11,12,13,14,15,16,16,16,17,17,18,18,18,19,19,19,20,20,20,20,21,21,21,21,22,22,22,22,22,23,23,23,23,23,23,24,24,24,24,24,24,25,25,25,25,25,25,25,26,26,26,26,26,26,26,26,27,27,27,27,27,27,27,27,27,27,28,28,28,28,28,28,28,28,28,28,29,29,29,29,29,29,29,29,29,29,29,29,30,30,30,30,30,30,30,30,30,30,30,30,30,30,31,31,31,31,31,31,31,31,31,31,31,31,31,31,31,31};

__device__ __forceinline__ float wave_sum(float v) {
#pragma unroll
    for (int o = 1; o < 64; o <<= 1) v += __shfl_xor(v, o);
    return v;
}
__device__ __forceinline__ float wave_max(float v) {
#pragma unroll
    for (int o = 1; o < 64; o <<= 1) v = fmaxf(v, __shfl_xor(v, o));
    return v;
}
#define LDS_WAIT() asm volatile("s_waitcnt lgkmcnt(0)" ::: "memory")

struct Frame {
    LAS unsigned char* lds;
    int tid, lane, wave, G, bid;
    const float* in[16]; float* out; unsigned char* ws;
};

__device__ __forceinline__ void tr_item(const float* W, int ldw, int nvalid, const float* gain, hbits* WT, int K, int k0, int n0s, int n0d, LAS float* scr, int lane) {
#pragma unroll 8
    for (int i = 0; i < 32; ++i) { const int kk = 2 * i + (lane >> 5), n = n0s + (lane & 31);
        float v = (n < nvalid) ? W[(size_t)(k0 + kk) * ldw + n] : 0.f; if (gain) v *= gain[k0 + kk]; scr[kk * 33 + (lane & 31)] = v; }
    LDS_WAIT(); asm volatile("" ::: "memory");
    const int c = lane & 7;
#pragma unroll
    for (int j = 0; j < 4; ++j) { const int n = (lane >> 3) + 8 * j; const LAS float* s = scr + (8 * c) * 33 + n;
        v4u o; o.x = pk2h(s[0 * 33], s[1 * 33]); o.y = pk2h(s[2 * 33], s[3 * 33]); o.z = pk2h(s[4 * 33], s[5 * 33]); o.w = pk2h(s[6 * 33], s[7 * 33]);
        *(GAS v4u*)(WT + (size_t)(n0d + n) * K + k0 + 8 * c) = o; }
    LDS_WAIT(); asm volatile("" ::: "memory");
}
__device__ __forceinline__ void p0_prologue(Frame& F) {
    LAS float* scr = (LAS float*)(F.lds + F.wave * 16384);
    const int gw = F.bid * NWAVES + F.wave, NGW = F.G * NWAVES;
    hbits* WA = (hbits*)(F.ws + WS_WA); hbits* WUV = (hbits*)(F.ws + WS_WUV); hbits* WAO = (hbits*)(F.ws + WS_WAO);
    hbits* WB = (hbits*)(F.ws + WS_WB); hbits* WBO = (hbits*)(F.ws + WS_WBO);
    constexpr int I_WA = 16 * (A_PAD / 32), I_UV = 64, I_SQ = 16 * 32, I_GU = 16 * (2 * FF / 32), I_D = (FF / 64) * 32, I_WB = 16 * (B_IN / 32);
    constexpr int NITEMS = I_WA + I_UV + I_SQ + 2 * I_GU + 2 * I_D + I_WB + I_SQ;
    for (int it = gw; it < NITEMS; it += NGW) {
        int r = it;
        if (r < I_WA) { const int nnb = A_PAD / 32, kb = r / nnb, nb = r % nnb; tr_item(F.in[5], A_IN, A_IN, F.in[2], WA, D, 64 * kb, 32 * nb, 32 * nb, scr, F.lane); continue; } r -= I_WA;
        if (r < I_UV) { const int h = r >> 2, kb = (r >> 1) & 1, nb = r & 1; tr_item(F.in[7] + (size_t)h * RL * VH, VH, VH, nullptr, WUV + (size_t)h * VH * RL, RL, 64 * kb, 32 * nb, 32 * nb, scr, F.lane); continue; } r -= I_UV;
        if (r < I_SQ) { const int kb = r / 32, nb = r % 32; tr_item(F.in[8], D, D, nullptr, WAO, D, 64 * kb, 32 * nb, 32 * nb, scr, F.lane); continue; } r -= I_SQ;
        if (r < 2 * I_GU) { const int l = r / I_GU; r -= l * I_GU; const int nnb = 2 * FF / 32, kb = r / nnb, nb = r % nnb; const int c = 32 * nb;
            const int nd = (c < FF) ? ((c / 128) * 256 + (c % 128)) : (((c - FF) / 128) * 256 + 128 + ((c - FF) % 128));
            tr_item(F.in[14] + (size_t)l * D * 2 * FF, 2 * FF, 2 * FF, F.in[3] + l * D, (hbits*)(F.ws + (l ? WS_WGU1 : WS_WGU0)), D, 64 * kb, c, nd, scr, F.lane); continue; } r -= 2 * I_GU;
        if (r < 2 * I_D) { const int l = r / I_D; r -= l * I_D; const int kb = r / 32, nb = r % 32;
            tr_item(F.in[15] + (size_t)l * FF * D, D, D, nullptr, (hbits*)(F.ws + (l ? WS_WD1 : WS_WD0)), FF, 64 * kb, 32 * nb, 32 * nb, scr, F.lane); continue; } r -= 2 * I_D;
        if (r < I_WB) { const int nnb = B_IN / 32, kb = r / nnb, nb = r % nnb; tr_item(F.in[9], B_IN, B_IN, F.in[2] + D, WB, D, 64 * kb, 32 * nb, 32 * nb, scr, F.lane); continue; } r -= I_WB;
        { const int kb = r / 32, nb = r % 32; tr_item(F.in[12], D, D, nullptr, WBO, D, 64 * kb, 32 * nb, 32 * nb, scr, F.lane); }
    }
    const float* x = F.in[0]; hbits* XH = (hbits*)(F.ws + WS_XH); float* RS0 = (float*)(F.ws + WS_RS0);
    for (int m = gw; m < M; m += NGW) {
        const GAS f32x4* xr = (const GAS f32x4*)(x + (size_t)m * D) + F.lane;
        f32x4 v[4]; float s = 0.f;
#pragma unroll
        for (int j = 0; j < 4; ++j) { v[j] = xr[64 * j]; s += (v[j].x * v[j].x + v[j].y * v[j].y) + (v[j].z * v[j].z + v[j].w * v[j].w); }
        s = wave_sum(s);
        if (F.lane == 0) RS0[m] = 1.0f / sqrtf(s * (1.0f / D) + pg8::RMS_EPS);
        GAS unsigned long long* o8 = (GAS unsigned long long*)(XH + (size_t)m * D) + F.lane;
#pragma unroll
        for (int j = 0; j < 4; ++j) o8[64 * j] = (unsigned long long)pk2h(v[j].x, v[j].y) | ((unsigned long long)pk2h(v[j].z, v[j].w) << 32);
    }
}

__device__ __forceinline__ unsigned okey(float f) { const unsigned u = __builtin_bit_cast(unsigned, f); return (u & 0x80000000u) ? ~u : (u | 0x80000000u); }
__device__ __forceinline__ void p2_indexer(Frame& F) {
    const int gw = F.bid * NWAVES + F.wave, NGW = F.G * NWAVES, lane = F.lane;
    { const float* CKV = (const float*)(F.ws + WS_CKV); hbits* CKVN = (hbits*)(F.ws + WS_CKVN); const float* lg = F.in[6];
      for (int m = gw; m < M; m += NGW) { const float a = CKV[(size_t)m * RL + 2 * lane], b = CKV[(size_t)m * RL + 2 * lane + 1];
          const float s = wave_sum(a * a + b * b); const float r = 1.0f / sqrtf(s * (1.0f / RL) + pg8::RMS_EPS);
          *(unsigned*)(CKVN + (size_t)m * RL + 2 * lane) = pk2h(a * r * lg[2 * lane], b * r * lg[2 * lane + 1]); } }
    LAS float* qs = (LAS float*)(F.lds + F.wave * 16384);
    LAS float* sc = qs + 512;
    const hbits* QI = (const hbits*)(F.ws + WS_QI); const hbits* KI = (const hbits*)(F.ws + WS_KI); const float* WI = (const float*)(F.ws + WS_WI);
    unsigned short* IDX = (unsigned short*)(F.ws + WS_IDX);
    const unsigned long long lt_mask = (1ull << lane) - 1ull;
    for (int i = 0; i * NGW < M; ++i) {
        const int tok = i * NGW + ((i & 1) ? (NGW - 1 - gw) : gw); if (tok >= M) continue; const int b = tok >> 11, t = tok & (T - 1);
        if (t < KSEL) continue;
#pragma unroll
        for (int j = 0; j < 8; ++j) qs[lane + 64 * j] = (float)__builtin_bit_cast(f16, QI[(size_t)tok * 512 + lane + 64 * j]);
        float w[8];
#pragma unroll
        for (int j = 0; j < 8; ++j) w[j] = WI[(size_t)tok * 8 + j];
        LDS_WAIT(); asm volatile("" ::: "memory");
        for (int s0 = 0; s0 <= t; s0 += 64) { const int s = s0 + lane; float score = -INFINITY;
            if (s <= t) { const hbits* kr = KI + ((size_t)b * T + s) * DI; float d[8];
#pragma unroll
                for (int j = 0; j < 8; ++j) d[j] = 0.f;
#pragma unroll
                for (int c = 0; c < 8; ++c) { const f16x8 kv = __builtin_bit_cast(f16x8, *(const v4u*)(kr + 8 * c));
#pragma unroll
                    for (int e = 0; e < 8; ++e) { const float kf = (float)kv[e];
#pragma unroll
                        for (int j = 0; j < 8; ++j) d[j] = fmaf(qs[j * 64 + c * 8 + e], kf, d[j]); } }
                score = 0.f;
#pragma unroll
                for (int j = 0; j < 8; ++j) score = fmaf(w[j], fmaxf(d[j], 0.f), score); }
            sc[s] = score; }
        for (int s = ((t >> 6) + 1) * 64 + lane; s < T; s += 64) sc[s] = -INFINITY;
        LDS_WAIT(); asm volatile("" ::: "memory");
        unsigned key[32];
#pragma unroll
        for (int q = 0; q < 32; ++q) { const int s = lane + 64 * q; key[q] = (s <= t) ? okey(sc[s]) : 0u; }
        unsigned prefix = 0u;
        for (int bit = 31; bit >= 0; --bit) { const unsigned cand = prefix | (1u << bit); int cnt = 0;
#pragma unroll
            for (int q = 0; q < 32; ++q) cnt += __builtin_popcountll(__ballot(key[q] >= cand));
            if (cnt >= KSEL) prefix = cand; }
        int ngt = 0;
#pragma unroll
        for (int q = 0; q < 32; ++q) ngt += __builtin_popcountll(__ballot(key[q] > prefix));
        const int need = KSEL - ngt; int eq_seen = 0, pos = 0;
#pragma unroll
        for (int q = 0; q < 32; ++q) { const bool gt = key[q] > prefix, eq = key[q] == prefix;
            const unsigned long long meq = __ballot(eq); const bool take = eq && (eq_seen + __builtin_popcountll(meq & lt_mask) < need); eq_seen += __builtin_popcountll(meq);
            const bool sel = gt || take; const unsigned long long ms = __ballot(sel);
            if (sel) IDX[(size_t)tok * KSEL + pos + __builtin_popcountll(ms & lt_mask)] = (unsigned short)(lane + 64 * q);
            pos += __builtin_popcountll(ms); }
        LDS_WAIT(); asm volatile("" ::: "memory");
    }
}

__device__ __forceinline__ void p3_sparse_attn(Frame& F) {
    LAS unsigned char* L = F.lds; const int tid = F.tid, lane = F.lane, wave = F.wave;
    LAS hbits* kv = (LAS hbits*)L;
    LAS float* qf = (LAS float*)(L + 69632);
    LAS float* pf = (LAS float*)(L + 69632 + 8192);
    LAS float* of = (LAS float*)(L + 69632 + 8192 + 16384);
    LAS int* ix = (LAS int*)(L + 69632 + 8192 + 16384 + 8192);
    LAS float* bt = (LAS float*)(L + 69632 + 8192 + 16384 + 8192 + 1024);
    const float* rel_bias = F.in[1]; const float* w_uv = F.in[7];
    const hbits* QL = (const hbits*)(F.ws + WS_QL); const hbits* CKVN = (const hbits*)(F.ws + WS_CKVN); const unsigned short* IDX = (const unsigned short*)(F.ws + WS_IDX);
    hbits* OV = (hbits*)(F.ws + WS_OV);
    for (int i = tid; i < 129 * 16; i += NTHREADS) bt[i] = rel_bias[(int)BUCKET_TAB[i >> 4] * 16 + (i & 15)];
    for (int tok = F.bid; tok < M; tok += F.G) {
        const int b = tok >> 11, t = tok & (T - 1); const int n = (t + 1 < KSEL) ? t + 1 : KSEL;
        __syncthreads();
        if (tid < KSEL) ix[tid] = (tid < n) ? ((t < KSEL) ? tid : (int)IDX[(size_t)tok * KSEL + tid]) : 0;
        for (int i = tid; i < NH * RL; i += NTHREADS) qf[i] = (float)__builtin_bit_cast(f16, QL[(size_t)tok * (NH * RL) + i]);
        __syncthreads();
#pragma unroll
        for (int p = 0; p < 8; ++p) { const int k = (tid >> 4) + 32 * p, c = tid & 15;
            if (k < n) { const v4u v = *(const v4u*)(CKVN + ((size_t)b * T + ix[k]) * RL + c * 8); *(LAS v4u*)(kv + k * 136 + c * 8) = v; } }
        __syncthreads();
#pragma unroll
        for (int hh = 0; hh < 2; ++hh) { const int h = 2 * wave + hh; float lg[4]; float mx = -INFINITY;
#pragma unroll
            for (int kk = 0; kk < 4; ++kk) { const int key = lane + 64 * kk; float l = -INFINITY;
                if (key < n) { float d = 0.f;
#pragma unroll
                    for (int c = 0; c < 16; ++c) { const f16x8 kvv = __builtin_bit_cast(f16x8, *(const LAS v4u*)(kv + key * 136 + c * 8));
#pragma unroll
                        for (int e = 0; e < 8; ++e) d = fmaf((float)kvv[e], qf[h * RL + c * 8 + e], d); }
                    const int rel = t - ix[key]; l = d * 0.08838834764831845f + bt[((rel < 128) ? rel : 128) * 16 + h]; }
                lg[kk] = l; mx = fmaxf(mx, l); }
            mx = wave_max(mx); float s = 0.f;
#pragma unroll
            for (int kk = 0; kk < 4; ++kk) { const float p = (lg[kk] == -INFINITY) ? 0.f : __expf(lg[kk] - mx); lg[kk] = p; s += p; }
            s = wave_sum(s); const float inv = 1.0f / s;
#pragma unroll
            for (int kk = 0; kk < 4; ++kk) pf[h * 256 + lane + 64 * kk] = lg[kk] * inv; }
        __syncthreads();
#pragma unroll
        for (int hh = 0; hh < 2; ++hh) { const int h = 2 * wave + hh; float o0 = 0.f, o1 = 0.f;
            for (int k = 0; k < n; ++k) { const float p = pf[h * 256 + k]; const f16x2 vv = __builtin_bit_cast(f16x2, *(const LAS unsigned*)(kv + k * 136 + 2 * lane));
                o0 = fmaf(p, (float)vv[0], o0); o1 = fmaf(p, (float)vv[1], o1); }
            of[h * RL + 2 * lane] = o0; of[h * RL + 2 * lane + 1] = o1; }
        __syncthreads();
#pragma unroll
        for (int hh = 0; hh < 2; ++hh) { const int h = 2 * wave + hh; float a = 0.f;
            for (int r = 0; r < RL; ++r) a = fmaf(of[h * RL + r], w_uv[((size_t)h * RL + r) * VH + lane], a);
            OV[(size_t)tok * D + h * VH + lane] = __builtin_bit_cast(hbits, (f16)a); }
    }
}

__device__ __forceinline__ void p8_swa(Frame& F) {
    const int lane = F.lane, gw = F.bid * NWAVES + F.wave, NGW = F.G * NWAVES;
    LAS float* bt = (LAS float*)(F.lds + 16384);
    LAS float* qs = (LAS float*)(F.lds + F.wave * 1024);
    LAS float* ps = qs + 64;
    const float* rel_bias = F.in[1]; const float* sinks = F.in[11];
    const hbits* QKV = (const hbits*)(F.ws + WS_QKV1); hbits* OB = (hbits*)(F.ws + WS_OB);
    for (int i = F.tid; i < 128 * 16; i += NTHREADS) bt[i] = rel_bias[(int)BUCKET_TAB[i >> 4] * 16 + (i & 15)];
    __syncthreads();
    for (int item = gw; item < M * NH; item += NGW) {
        const int tok = item >> 4, h = item & 15, b = tok >> 11, t = tok & (T - 1), kvh = h >> 3;
        qs[lane] = (float)__builtin_bit_cast(f16, QKV[(size_t)tok * B_IN + h * 64 + lane]);
        LDS_WAIT(); asm volatile("" ::: "memory");
        float l[2];
#pragma unroll
        for (int jj = 0; jj < 2; ++jj) { const int j = lane + 64 * jj, s = t - (WIN - 1) + j; float v = -INFINITY;
            if (s >= 0) { const hbits* kr = QKV + ((size_t)b * T + s) * B_IN + 1024 + kvh * 64; float d = 0.f;
#pragma unroll
                for (int c = 0; c < 8; ++c) { const f16x8 k8 = __builtin_bit_cast(f16x8, *(const v4u*)(kr + 8 * c));
#pragma unroll
                    for (int e = 0; e < 8; ++e) d = fmaf((float)k8[e], qs[c * 8 + e], d); }
                v = d * 0.125f + bt[(WIN - 1 - j) * 16 + h]; }
            l[jj] = v; }
        const float sink = sinks[h];
        float mx = fmaxf(wave_max(fmaxf(l[0], l[1])), sink);
        const float p0 = (l[0] == -INFINITY) ? 0.f : __expf(l[0] - mx), p1 = (l[1] == -INFINITY) ? 0.f : __expf(l[1] - mx);
        const float den = wave_sum(p0 + p1) + __expf(sink - mx); const float inv = 1.0f / den;
        ps[lane] = p0 * inv; ps[lane + 64] = p1 * inv;
        LDS_WAIT(); asm volatile("" ::: "memory");
        float o = 0.f; const int j0 = (t >= WIN - 1) ? 0 : (WIN - 1 - t);
        for (int j = j0; j < WIN; ++j) { const int s = t - (WIN - 1) + j;
            o = fmaf(ps[j], (float)__builtin_bit_cast(f16, QKV[((size_t)b * T + s) * B_IN + 1152 + kvh * 64 + lane]), o); }
        OB[(size_t)tok * D + h * 64 + lane] = __builtin_bit_cast(hbits, (f16)o);
        LDS_WAIT(); asm volatile("" ::: "memory");
    }
}

__device__ __forceinline__ void p12_final(Frame& F) {
    const int gw = F.bid * NWAVES + F.wave, NGW = F.G * NWAVES; const float* g = F.in[4];
    for (int m = gw; m < M; m += NGW) {
        GAS f32x4* xr = (GAS f32x4*)(F.out + (size_t)m * D) + F.lane;
        f32x4 v[4]; float s = 0.f;
#pragma unroll
        for (int j = 0; j < 4; ++j) { v[j] = xr[64 * j]; s += (v[j].x * v[j].x + v[j].y * v[j].y) + (v[j].z * v[j].z + v[j].w * v[j].w); }
        const float r = 1.0f / sqrtf(wave_sum(s) * (1.0f / D) + pg8::RMS_EPS);
#pragma unroll
        for (int j = 0; j < 4; ++j) { const f32x4 gv = *((const f32x4*)g + F.lane + 64 * j); xr[64 * j] = v[j] * r * gv; }
    }
}

struct Args { const float* in[16]; float* out; unsigned char* ws; int ph_lo, ph_hi; };
template <bool COOP>
__global__ void __launch_bounds__(NTHREADS, 2) fwd(Args args) {
    extern __shared__ __attribute__((aligned(16))) unsigned char lds[];
    Frame F;
    F.lds = (LAS unsigned char*)lds; F.tid = threadIdx.x; F.lane = F.tid & 63; F.wave = __builtin_amdgcn_readfirstlane(F.tid >> 6);
    F.G = gridDim.x; F.bid = blockIdx.x;
#pragma unroll
    for (int i = 0; i < 16; ++i) F.in[i] = args.in[i];
    F.out = args.out; F.ws = args.ws;
    unsigned char* ws = args.ws;
    const int lo = args.ph_lo, hi = args.ph_hi;
#define IN(k) (lo <= (k) && (k) < hi)
#define SEAM(k) do { if constexpr (COOP) { if (IN(k) && IN((k) + 1)) cg::this_grid().sync(); } } while (0)
    typedef pg8::bf16_t hb;
    float* SS1 = (float*)(ws + WS_SS1); float* SS2 = (float*)(ws + WS_SS2); float* SS3 = (float*)(ws + WS_SS3);
    hb* XH = (hb*)(ws + WS_XH);

    if (IN(0)) { p0_prologue(F); } SEAM(0);
    if (IN(1)) {
        pg8::Gemm g{XH, (const hb*)(ws + WS_WA), M, A_PAD, D}; pg8::StaticOrder S; S.init(M, A_PAD, F.G, F.bid);
        pg8::EpiInA E{(const float*)(ws + WS_RS0), (hb*)(ws + WS_QL), (float*)(ws + WS_CKV), (hb*)(ws + WS_QI), (hb*)(ws + WS_KI), (float*)(ws + WS_WI)};
        pg8::gemm_phase<pg8::EpiInA, pg8::StaticOrder, true, true>(F.lds, g, S, E);
    } SEAM(1);
    if (IN(2)) { p2_indexer(F); } SEAM(2);
    if (IN(3)) { p3_sparse_attn(F); } SEAM(3);
    if (IN(4)) {
        pg8::Gemm g{(const hb*)(ws + WS_OV), (const hb*)(ws + WS_WAO), M, D, D}; pg8::StaticOrder S; S.init(M, D, F.G, F.bid);
        pg8::EpiRes E{F.in[0], F.out, XH, SS1, nullptr};
        pg8::gemm_phase<pg8::EpiRes, pg8::StaticOrder, true, true>(F.lds, g, S, E);
    } SEAM(4);
    if (IN(5)) {
        pg8::Gemm g{XH, (const hb*)(ws + WS_WGU0), M, 2 * FF, D}; pg8::StaticOrder S; S.init(M, 2 * FF, F.G, F.bid);
        pg8::EpiGU E{SS1, (hb*)(ws + WS_HB)};
        pg8::gemm_phase<pg8::EpiGU, pg8::StaticOrder, true, true>(F.lds, g, S, E);
    } SEAM(5);
    if (IN(6)) {
        pg8::Gemm g{(const hb*)(ws + WS_HB), (const hb*)(ws + WS_WD0), M, D, FF}; pg8::StaticOrder S; S.init(M, D, F.G, F.bid);
        pg8::EpiRes E{F.out, F.out, XH, SS2, nullptr};
        pg8::gemm_phase<pg8::EpiRes, pg8::StaticOrder, true, true>(F.lds, g, S, E);
    } SEAM(6);
    if (IN(7)) {
        pg8::Gemm g{XH, (const hb*)(ws + WS_WB), M, B_IN, D}; pg8::StaticOrder S; S.init(M, B_IN, F.G, F.bid);
        pg8::EpiInB E{SS2, F.in[10], (hb*)(ws + WS_QKV1)};
        pg8::gemm_phase<pg8::EpiInB, pg8::StaticOrder, true, true>(F.lds, g, S, E);
    } SEAM(7);
    if (IN(8)) { p8_swa(F); } SEAM(8);
    if (IN(9)) {
        pg8::Gemm g{(const hb*)(ws + WS_OB), (const hb*)(ws + WS_WBO), M, D, D}; pg8::StaticOrder S; S.init(M, D, F.G, F.bid);
        pg8::EpiRes E{F.out, F.out, XH, SS3, F.in[13]};
        pg8::gemm_phase<pg8::EpiRes, pg8::StaticOrder, true, true>(F.lds, g, S, E);
    } SEAM(9);
    if (IN(10)) {
        pg8::Gemm g{XH, (const hb*)(ws + WS_WGU1), M, 2 * FF, D}; pg8::StaticOrder S; S.init(M, 2 * FF, F.G, F.bid);
        pg8::EpiGU E{SS3, (hb*)(ws + WS_HB)};
        pg8::gemm_phase<pg8::EpiGU, pg8::StaticOrder, true, true>(F.lds, g, S, E);
    } SEAM(10);
    if (IN(11)) {
        pg8::Gemm g{(const hb*)(ws + WS_HB), (const hb*)(ws + WS_WD1), M, D, FF}; pg8::StaticOrder S; S.init(M, D, F.G, F.bid);
        pg8::EpiRes E{F.out, F.out, XH, SS1, nullptr};
        pg8::gemm_phase<pg8::EpiRes, pg8::StaticOrder, true, true>(F.lds, g, S, E);
    } SEAM(11);
    if (IN(12)) { p12_final(F); }
#undef IN
#undef SEAM
}

extern "C" void kernel_launch(void* const* d_in, const int* in_sizes, int n_in, void* d_out, int out_size, void* d_ws, size_t ws_size, hipStream_t stream) {
    static int grid = 0;
    if (grid == 0) {
        if (n_in != 16 || in_sizes[0] != M * D || out_size != M * D || ws_size < WS_END) { fprintf(stderr, "kernel_launch: unexpected shapes (n_in %d, in0 %d, out %d, ws %zu)\n", n_in, n_in > 0 ? in_sizes[0] : -1, out_size, ws_size); grid = -1; return; }
        int dev = 0, cus = 0, per_cu = 0;
        if (hipGetDevice(&dev) != hipSuccess || hipDeviceGetAttribute(&cus, hipDeviceAttributeMultiprocessorCount, dev) != hipSuccess) { grid = -1; return; }
        const void* fn = MK_ONE_LAUNCH ? (const void*)fwd<true> : (const void*)fwd<false>;
        if (hipFuncSetAttribute(fn, hipFuncAttributeMaxDynamicSharedMemorySize, LDS_BYTES) != hipSuccess) { fprintf(stderr, "kernel_launch: hipFuncSetAttribute failed\n"); grid = -1; return; }
        if (hipOccupancyMaxActiveBlocksPerMultiprocessor(&per_cu, fn, NTHREADS, LDS_BYTES) != hipSuccess || per_cu < 1) { fprintf(stderr, "kernel_launch: occupancy query says %d blocks per CU\n", per_cu); per_cu = 1; }
        (void)hipGetLastError();
        grid = cus;
    }
    if (grid < 0) return;
    (void)hipMemsetAsync((char*)d_ws + WS_CTL, 0, CTL_ZERO_BYTES, stream);
    Args a{};
    for (int i = 0; i < 16; ++i) a.in[i] = (const float*)d_in[i];
    a.out = (float*)d_out; a.ws = (unsigned char*)d_ws;
#if MK_ONE_LAUNCH
    a.ph_lo = 0; a.ph_hi = N_PHASES;
    void* kargs[] = {&a};
    hipError_t e = hipLaunchCooperativeKernel((const void*)fwd<true>, dim3(grid), dim3(NTHREADS), kargs, LDS_BYTES, stream);
    if (e != hipSuccess) fprintf(stderr, "cooperative launch failed: %s (grid %d)\n", hipGetErrorString(e), grid);
#else
    for (int p = 0; p < N_PHASES; ++p) { a.ph_lo = p; a.ph_hi = p + 1; hipLaunchKernelGGL(fwd<false>, dim3(grid), dim3(NTHREADS), LDS_BYTES, stream, a); }
#endif
}
```

```cpp
#include <hip/hip_runtime.h>
#include <hip/hip_cooperative_groups.h>
#include <cstdio>
#include <cstdint>
namespace cg = cooperative_groups;

typedef _Float16 f16x8 __attribute__((ext_vector_type(8)));
typedef _Float16 f16x2 __attribute__((ext_vector_type(2)));
typedef _Float16 f16;
namespace pg8 {
#define PG8_LAS __attribute__((address_space(3)))
typedef unsigned short bf16_t;
typedef short bf16x8 __attribute__((ext_vector_type(8)));
typedef float f32x4 __attribute__((ext_vector_type(4)));
typedef unsigned u32x4 __attribute__((ext_vector_type(4)));
constexpr int BM = 256, BK = 64, HALF = 128, HTB = HALF * BK * 2  , STAGE_BYTES = 8 * HTB, NXCD = 8, WGM = 8;

__host__ __device__ __forceinline__ int lds_byte(int r, int c) { const int st = (r >> 4) * 2 + (c >> 5), rr = r & 15, cc = c & 31, ob = rr * 64 + cc * 2; return st * 1024 + (ob ^ (((ob >> 9) & 1) << 5)); }
__host__ __device__ __forceinline__ void stage_rc(int b, int& R, int& C) { const int st = b / 1024, sb = b % 1024, swz = sb ^ (((sb >> 9) & 1) << 5); R = (st >> 1) * 16 + swz / 64; C = (st & 1) * 32 + (swz % 64) / 2; }
__host__ __device__ __forceinline__ int perm32(int rho) { const int n = rho >> 4, i = rho & 15; return 8 * (i >> 2) + 4 * n + (i & 3); }

struct Unit { int pm, pn; };
struct Gemm { const bf16_t* A; const bf16_t* Bt; int M, N, K; };

struct StaticOrder {
    int nM, nN, nwg, G, c;
    __host__ __device__ void init(int M, int N, int G_, int c_) { nM = M / BM; nN = N / BM; nwg = nM * nN; G = G_; c = c_; }
    __host__ __device__ bool next(int i, Unit& u) const {
        const long L = (long)i * G + c; if (L >= nwg) return false;
        int wgid = (int)L; { const int q = nwg / NXCD, r = nwg % NXCD, xcd = wgid % NXCD, off = wgid / NXCD; wgid = (xcd < r ? xcd * (q + 1) : r * (q + 1) + (xcd - r) * q) + off; }
        const int nig = WGM * nN, gid = wgid / nig, fm = gid * WGM, gsz = (nM - fm) < WGM ? (nM - fm) : WGM;
        u.pm = fm + ((wgid % nig) % gsz); u.pn = (wgid % nig) / gsz; return true;
    }
    __device__ __forceinline__ void a_ready(const Unit&) const {}
    __device__ __forceinline__ void done(const Unit&) const {}
};

__device__ __forceinline__ unsigned pk2h(float lo, float hi) { f16x2 v = {(_Float16)lo, (_Float16)hi}; return __builtin_bit_cast(unsigned, v); }
__device__ __forceinline__ u32x4 pk8h(f32x4 a, f32x4 b) { u32x4 w; w.x = pk2h(a[0], a[1]); w.y = pk2h(a[2], a[3]); w.z = pk2h(b[0], b[1]); w.w = pk2h(b[2], b[3]); return w; }
constexpr float RMS_EPS = 1e-6f;

struct EpiInA {
    static constexpr bool PERM = true, AFTER_DRAIN = false;
    const float* rs; bf16_t* QL; float* CKV; bf16_t* QI; bf16_t* KI; float* WI;
    __device__ __forceinline__ void operator()(const f32x4 (&acc)[2][2][4][2], const Unit& u, int wr, int wc, int fr, int fq) const {
        const int row0 = u.pm * BM + wr * 64 + fr;
#pragma unroll
        for (int ai = 0; ai < 2; ++ai)
#pragma unroll
            for (int m = 0; m < 4; ++m) { const int row = row0 + ai * HALF + m * 16; const float r = rs[row];
#pragma unroll
                for (int bj = 0; bj < 2; ++bj) { const int col = u.pn * BM + bj * HALF + wc * 32 + 8 * fq;
                    f32x4 v0 = acc[ai][bj][m][0] * r, v1 = acc[ai][bj][m][1] * r;
                    if (col < 2048) { *(u32x4*)(QL + (size_t)row * 2048 + col) = pk8h(v0, v1); }
                    else if (col < 2176) { float* p = CKV + (size_t)row * 128 + (col - 2048); *(f32x4*)p = v0; *(f32x4*)(p + 4) = v1; }
                    else if (col < 2688) { v0 = v0 * 0.125f; v1 = v1 * 0.125f; *(u32x4*)(QI + (size_t)row * 512 + (col - 2176)) = pk8h(v0, v1); }
                    else if (col < 2752) { *(u32x4*)(KI + (size_t)row * 64 + (col - 2688)) = pk8h(v0, v1); }
                    else if (col < 2760) { const float s = 0.35355339059327373f; float* p = WI + (size_t)row * 8; *(f32x4*)p = v0 * s; *(f32x4*)(p + 4) = v1 * s; }
                } }
    }
};
struct EpiRes {
    static constexpr bool PERM = true, AFTER_DRAIN = false;
    const float* xold; float* xnew; bf16_t* xh; float* ss; const float* bias;
    __device__ __forceinline__ void operator()(const f32x4 (&acc)[2][2][4][2], const Unit& u, int wr, int wc, int fr, int fq) const {
        const int row0 = u.pm * BM + wr * 64 + fr;
#pragma unroll
        for (int ai = 0; ai < 2; ++ai)
#pragma unroll
            for (int m = 0; m < 4; ++m) { const int row = row0 + ai * HALF + m * 16; float sq = 0.f;
#pragma unroll
                for (int bj = 0; bj < 2; ++bj) { const int col = u.pn * BM + bj * HALF + wc * 32 + 8 * fq; const size_t off = (size_t)row * 1024 + col;
                    f32x4 v0 = acc[ai][bj][m][0] + *(const f32x4*)(xold + off), v1 = acc[ai][bj][m][1] + *(const f32x4*)(xold + off + 4);
                    if (bias) { v0 = v0 + *(const f32x4*)(bias + col); v1 = v1 + *(const f32x4*)(bias + col + 4); }
                    *(f32x4*)(xnew + off) = v0; *(f32x4*)(xnew + off + 4) = v1;
                    *(u32x4*)(xh + off) = pk8h(v0, v1);
                    sq += (v0[0] * v0[0] + v0[1] * v0[1]) + (v0[2] * v0[2] + v0[3] * v0[3]) + (v1[0] * v1[0] + v1[1] * v1[1]) + (v1[2] * v1[2] + v1[3] * v1[3]); }
                sq += __shfl_xor(sq, 16); sq += __shfl_xor(sq, 32);
                if (fq == 0) atomicAdd(ss + row, sq); }
    }
};
struct EpiGU {
    static constexpr bool PERM = true, AFTER_DRAIN = false;
    const float* ss; bf16_t* HB;
    __device__ __forceinline__ void operator()(const f32x4 (&acc)[2][2][4][2], const Unit& u, int wr, int wc, int fr, int fq) const {
        const int row0 = u.pm * BM + wr * 64 + fr; const int col = u.pn * HALF + wc * 32 + 8 * fq;
#pragma unroll
        for (int ai = 0; ai < 2; ++ai)
#pragma unroll
            for (int m = 0; m < 4; ++m) { const int row = row0 + ai * HALF + m * 16; const float r = 1.0f / sqrtf(ss[row] * (1.0f / 1024.0f) + RMS_EPS);
                f32x4 hv[2];
#pragma unroll
                for (int n = 0; n < 2; ++n)
#pragma unroll
                    for (int j = 0; j < 4; ++j) { const float g = acc[ai][0][m][n][j] * r, uu = acc[ai][1][m][n][j] * r;
                        hv[n][j] = g * __builtin_amdgcn_rcpf(1.0f + __builtin_amdgcn_exp2f(-1.4426950408889634f * g)) * uu; }
                *(u32x4*)(HB + (size_t)row * 2816 + col) = pk8h(hv[0], hv[1]); }
    }
};
struct EpiInB {
    static constexpr bool PERM = true, AFTER_DRAIN = false;
    const float* ss; const float* bias; bf16_t* QKV;
    __device__ __forceinline__ void operator()(const f32x4 (&acc)[2][2][4][2], const Unit& u, int wr, int wc, int fr, int fq) const {
        const int row0 = u.pm * BM + wr * 64 + fr;
#pragma unroll
        for (int ai = 0; ai < 2; ++ai)
#pragma unroll
            for (int m = 0; m < 4; ++m) { const int row = row0 + ai * HALF + m * 16; const float r = 1.0f / sqrtf(ss[row] * (1.0f / 1024.0f) + RMS_EPS);
#pragma unroll
                for (int bj = 0; bj < 2; ++bj) { const int col = u.pn * BM + bj * HALF + wc * 32 + 8 * fq;
                    const f32x4 v0 = acc[ai][bj][m][0] * r + *(const f32x4*)(bias + col), v1 = acc[ai][bj][m][1] * r + *(const f32x4*)(bias + col + 4);
                    *(u32x4*)(QKV + (size_t)row * 1280 + col) = pk8h(v0, v1); } }
    }
};

template <class Epi, class Sched, bool ALIGN_EPI = false, bool SP2 = false>
__device__ __forceinline__ void gemm_phase(PG8_LAS unsigned char* lds, const Gemm g, const Sched& S, const Epi& E) {
    const int tid = threadIdx.x, wid = __builtin_amdgcn_readfirstlane(tid >> 6), lane = tid & 63, wr = wid >> 2, wc = wid & 3, fr = lane & 15, fq = lane >> 4;
    const int K = g.K, nt = K / BK;
    unsigned voffA[2], voffB[2];
#pragma unroll
    for (int i = 0; i < 2; ++i) { int R, C; stage_rc(tid * 16 + i * 8192, R, C); const int Rb = Epi::PERM ? ((R & ~31) + perm32(R & 31)) : R;
        voffA[i] = (unsigned)(R * K + C) * 2u; voffB[i] = (unsigned)(Rb * K + C) * 2u; }
    const size_t kstep = (size_t)(BK * 2);
    const size_t hstep = (size_t)HALF * K * 2;
    const size_t tstep = 2 * hstep;
    const unsigned ldsw = (unsigned)wid * 1024u;
    const int aoff = lds_byte(wr * 64 + fr, fq * 8), boff = lds_byte(wc * 32 + fr, fq * 8);
#define PG8_SA(b, h) (((b) * 2 + (h)) * HTB)
#define PG8_SB(b, h) ((4 + (b) * 2 + (h)) * HTB)
#define PG8_STAGE(bufoff, gbase, voff) do { _Pragma("unroll") for (int _i = 0; _i < 2; ++_i) \
        __builtin_amdgcn_global_load_lds((const unsigned*)((const char*)(gbase) + (voff)[_i]), (PG8_LAS unsigned*)(lds + (bufoff) + ldsw + _i * 8192), 16, 0, 0); } while (0)
#define PG8_LDA(dst, b, h) do { _Pragma("unroll") for (int m = 0; m < 4; ++m) _Pragma("unroll") for (int k = 0; k < 2; ++k) dst[m][k] = *(const PG8_LAS bf16x8*)(lds + PG8_SA(b, h) + aoff + m * 2048 + k * 1024); } while (0)
#define PG8_LDB(dst, b, h) do { _Pragma("unroll") for (int n = 0; n < 2; ++n) _Pragma("unroll") for (int k = 0; k < 2; ++k) dst[n][k] = *(const PG8_LAS bf16x8*)(lds + PG8_SB(b, h) + boff + n * 2048 + k * 1024); } while (0)
#define PG8_MMA(ai, bj, At, Bt) do { __builtin_amdgcn_s_setprio(1); _Pragma("unroll") for (int m = 0; m < 4; ++m) _Pragma("unroll") for (int n = 0; n < 2; ++n) _Pragma("unroll") for (int k = 0; k < 2; ++k) \
        acc[ai][bj][m][n] = __builtin_amdgcn_mfma_f32_16x16x32_f16(__builtin_bit_cast(f16x8, Bt[n][k]), __builtin_bit_cast(f16x8, At[m][k]), acc[ai][bj][m][n], 0, 0, 0); __builtin_amdgcn_s_setprio(0); } while (0)
#define PG8_WAIT_V(n) asm volatile("s_waitcnt vmcnt(" #n ")" ::: "memory")
#define PG8_WAIT_L(n) asm volatile("s_waitcnt lgkmcnt(" #n ")" ::: "memory")
#define PG8_BAR __builtin_amdgcn_s_barrier()
#define PG8_SCHED __builtin_amdgcn_sched_barrier(0)
    Unit cur, nxt; int ui = 0;
    if (!S.next(0, cur)) return;
    f32x4 acc[2][2][4][2];
#pragma unroll
    for (int a = 0; a < 2; ++a)
#pragma unroll
        for (int b = 0; b < 2; ++b)
#pragma unroll
            for (int m = 0; m < 4; ++m)
#pragma unroll
                for (int n = 0; n < 2; ++n) acc[a][b][m][n] = (f32x4){0.f, 0.f, 0.f, 0.f};
    bf16x8 At[4][2], B0[2][2], B1[2][2];
    const char* cA = (const char*)g.A + (size_t)cur.pm * tstep; const char* cB = (const char*)g.Bt + (size_t)cur.pn * tstep;
    S.a_ready(cur);
    if constexpr (SP2) {
        PG8_STAGE(PG8_SB(0, 0), cB, voffB); PG8_STAGE(PG8_SB(0, 1), cB + hstep, voffB); PG8_STAGE(PG8_SA(0, 0), cA, voffA); PG8_STAGE(PG8_SA(0, 1), cA + hstep, voffA);
        if (wr == 1) PG8_BAR;
        PG8_WAIT_V(2); PG8_BAR;
        PG8_STAGE(PG8_SB(1, 0), cB + kstep, voffB); PG8_STAGE(PG8_SA(1, 0), cA + kstep, voffA); PG8_STAGE(PG8_SB(1, 1), cB + hstep + kstep, voffB);
        PG8_WAIT_V(6); PG8_BAR;
    } else {
        PG8_STAGE(PG8_SB(0, 0), cB, voffB); PG8_STAGE(PG8_SA(0, 0), cA, voffA); PG8_STAGE(PG8_SB(0, 1), cB + hstep, voffB); PG8_STAGE(PG8_SA(0, 1), cA + hstep, voffA);
        if (wr == 1) PG8_BAR;
        PG8_WAIT_V(4); PG8_BAR;
        PG8_STAGE(PG8_SB(1, 0), cB + kstep, voffB); PG8_STAGE(PG8_SA(1, 0), cA + kstep, voffA); PG8_STAGE(PG8_SB(1, 1), cB + hstep + kstep, voffB);
        PG8_WAIT_V(6); PG8_BAR;
    }
    for (;;) {
        const bool has_next = S.next(ui + 1, nxt);
        const char* nA = has_next ? (const char*)g.A + (size_t)nxt.pm * tstep : cA; const char* nB = has_next ? (const char*)g.Bt + (size_t)nxt.pn * tstep : cB;
        for (int t = 0; t < nt; t += 2) {
            const bool last = (t == nt - 2);
            const char* a1 = cA + (size_t)(t + 1) * kstep;
            const char* a2 = last ? nA : cA + (size_t)(t + 2) * kstep; const char* b2 = last ? nB : cB + (size_t)(t + 2) * kstep;
            const char* a3 = a2 + kstep; const char* b3 = b2 + kstep;
            if (last && has_next) S.a_ready(nxt);
            if constexpr (SP2) {
            PG8_LDB(B0, 0, 0); PG8_LDB(B1, 0, 1); PG8_SCHED; PG8_LDA(At, 0, 0); PG8_STAGE(PG8_SA(1, 1), a1 + hstep, voffA);
            PG8_WAIT_V(8); PG8_WAIT_L(0); PG8_BAR; PG8_MMA(0, 0, At, B0); PG8_MMA(0, 1, At, B1); PG8_BAR; PG8_SCHED;
            PG8_LDA(At, 0, 1); PG8_STAGE(PG8_SB(0, 0), b2, voffB); PG8_STAGE(PG8_SB(0, 1), b2 + hstep, voffB); PG8_STAGE(PG8_SA(0, 0), a2, voffA);
            PG8_WAIT_V(8); PG8_WAIT_L(0); PG8_BAR; PG8_MMA(1, 0, At, B0); PG8_MMA(1, 1, At, B1); PG8_BAR; PG8_SCHED;
            PG8_LDB(B0, 1, 0); PG8_LDB(B1, 1, 1); PG8_SCHED; PG8_LDA(At, 1, 0); PG8_STAGE(PG8_SA(0, 1), a2 + hstep, voffA);
            PG8_WAIT_V(8); PG8_WAIT_L(0); PG8_BAR; PG8_MMA(0, 0, At, B0); PG8_MMA(0, 1, At, B1); PG8_BAR; PG8_SCHED;
            PG8_LDA(At, 1, 1); PG8_STAGE(PG8_SB(1, 0), b3, voffB); PG8_STAGE(PG8_SB(1, 1), b3 + hstep, voffB); PG8_STAGE(PG8_SA(1, 0), a3, voffA);
            PG8_WAIT_V(8); PG8_WAIT_L(0); PG8_BAR; PG8_MMA(1, 0, At, B0); PG8_MMA(1, 1, At, B1); PG8_BAR; PG8_SCHED;
            } else {
            PG8_LDB(B0, 0, 0); PG8_SCHED; PG8_LDA(At, 0, 0); PG8_STAGE(PG8_SA(1, 1), a1 + hstep, voffA);
            PG8_WAIT_L(8); PG8_BAR; PG8_WAIT_L(0); PG8_MMA(0, 0, At, B0); PG8_BAR; PG8_SCHED;
            PG8_LDB(B1, 0, 1); PG8_STAGE(PG8_SB(0, 0), b2, voffB);
            PG8_BAR; PG8_WAIT_L(0); PG8_MMA(0, 1, At, B1); PG8_BAR;
            PG8_LDA(At, 0, 1); PG8_STAGE(PG8_SA(0, 0), a2, voffA);
            PG8_BAR; PG8_WAIT_L(0); PG8_MMA(1, 0, At, B0); PG8_BAR; PG8_SCHED;
            PG8_STAGE(PG8_SB(0, 1), b2 + hstep, voffB);
            PG8_WAIT_V(6); PG8_BAR; PG8_MMA(1, 1, At, B1); PG8_BAR;
            PG8_LDB(B0, 1, 0); PG8_SCHED; PG8_LDA(At, 1, 0); PG8_STAGE(PG8_SA(0, 1), a2 + hstep, voffA);
            PG8_WAIT_L(8); PG8_BAR; PG8_WAIT_L(0); PG8_MMA(0, 0, At, B0); PG8_BAR; PG8_SCHED;
            PG8_LDB(B1, 1, 1); PG8_STAGE(PG8_SB(1, 0), b3, voffB);
            PG8_BAR; PG8_WAIT_L(0); PG8_MMA(0, 1, At, B1); PG8_BAR;
            PG8_LDA(At, 1, 1); PG8_STAGE(PG8_SA(1, 0), a3, voffA);
            PG8_BAR; PG8_WAIT_L(0); PG8_MMA(1, 0, At, B0); PG8_BAR; PG8_SCHED;
            PG8_STAGE(PG8_SB(1, 1), b3 + hstep, voffB);
            PG8_WAIT_V(6); PG8_BAR; PG8_MMA(1, 1, At, B1); PG8_BAR;
            }
        }
        if constexpr (ALIGN_EPI) { if (wr == 0) PG8_BAR; }
        if constexpr (!Epi::AFTER_DRAIN) { E(acc, cur, wr, wc, fr, fq); S.done(cur); }
        if (!has_next) break;
#pragma unroll
        for (int a = 0; a < 2; ++a)
#pragma unroll
            for (int b = 0; b < 2; ++b)
#pragma unroll
                for (int m = 0; m < 4; ++m)
#pragma unroll
                    for (int n = 0; n < 2; ++n) acc[a][b][m][n] = (f32x4){0.f, 0.f, 0.f, 0.f};
        cur = nxt; cA = nA; cB = nB; ++ui;
        if constexpr (ALIGN_EPI) { if (wr == 1) PG8_BAR; }
    }
    PG8_WAIT_V(0);
    if constexpr (!ALIGN_EPI) { if (wr == 0) PG8_BAR; }
    PG8_BAR;
    if constexpr (Epi::AFTER_DRAIN) { E.fused(acc, cur, wr, wc, fr, fq, lds, wid, lane); S.done(cur); }
#undef PG8_SA
#undef PG8_SB
#undef PG8_STAGE
#undef PG8_LDA
#undef PG8_LDB
#undef PG8_MMA
#undef PG8_WAIT_V
#undef PG8_WAIT_L
#undef PG8_BAR
#undef PG8_SCHED
}
}

constexpr int NB = 8, T = 2048, D = 1024, M = NB * T, NH = 16, RL = 128, VH = 64, HI = 8, DI = 64, KSEL = 256;
constexpr int A_IN = 2760, A_PAD = 2816, B_IN = 1280, FF = 2816, WIN = 128;
constexpr int NWAVES = 8, NTHREADS = NWAVES * 64;
constexpr int N_PHASES = 13;
#ifndef MK_ONE_LAUNCH
#define MK_ONE_LAUNCH 1
#endif
constexpr size_t MiB = 1u << 20;
constexpr size_t WS_CTL = 0, CTL_ZERO_BYTES = 1 * MiB;
constexpr size_t WS_SS1 = 256 * 1024, WS_SS2 = 320 * 1024, WS_SS3 = 384 * 1024;
constexpr size_t WS_RS0 = 1 * MiB;
constexpr size_t WS_WA = 2 * MiB, WS_WUV = WS_WA + (size_t)A_PAD * D * 2, WS_WAO = 8 * MiB, WS_WGU0 = 10 * MiB, WS_WGU1 = 21 * MiB, WS_WD0 = 32 * MiB,
                 WS_WD1 = WS_WD0 + (size_t)D * FF * 2, WS_WB = 43 * MiB, WS_WBO = 46 * MiB;
constexpr size_t WS_XH = 50 * MiB;
constexpr size_t WS_QL = 82 * MiB, WS_CKV = 146 * MiB, WS_CKVN = 154 * MiB, WS_QI = 158 * MiB, WS_KI = 174 * MiB, WS_WI = 176 * MiB, WS_IDX = 178 * MiB, WS_OV = 186 * MiB;
constexpr size_t WS_HB = 82 * MiB, WS_QKV1 = 170 * MiB, WS_OB = 210 * MiB, WS_END = 242 * MiB;
static_assert(WS_WUV + 16 * 64 * 128 * 2 <= WS_WAO && WS_WD1 + (size_t)D * FF * 2 <= WS_WB && WS_WB + (size_t)B_IN * D * 2 <= WS_WBO && WS_WBO + 2 * MiB <= WS_XH, "weights map");
static_assert(WS_HB + (size_t)M * FF * 2 <= WS_QKV1 && WS_QKV1 + (size_t)M * B_IN * 2 <= WS_OB && WS_OB + (size_t)M * D * 2 <= WS_END, "activation map");
constexpr int LDS_BYTES = 147456;

#define GAS __attribute__((address_space(1)))
#define LAS __attribute__((address_space(3)))
typedef unsigned v4u __attribute__((ext_vector_type(4)));
typedef float f32x4 __attribute__((ext_vector_type(4)));
typedef unsigned short hbits;
using pg8::pk2h;

__device__ const unsigned char BUCKET_TAB[129] = {0,1,2,3,4,5,6,7,8,9,10,11,12,13,14,15,16,16,16,17,17,18,18,18,19,19,19,20,20,20,20,21,21,21,21,22,22,22,22,22,23,23,23,23,23,23,24,24,24,24,24,24,25,25,25,25,25,25,25,26,26,26,26,26,26,26,26,27,27,27,27,27,27,27,27,27,27,28,28,28,28,28,28,28,28,28,28,29,29,29,29,29,29,29,29,29,29,29,29,30,30,30,30,30,30,30,30,30,30,30,30,30,30,31,31,31,31,31,31,31,31,31,31,31,31,31,31,31,31};

__device__ __forceinline__ float wave_sum(float v) {
#pragma unroll
    for (int o = 1; o < 64; o <<= 1) v += __shfl_xor(v, o);
    return v;
}
__device__ __forceinline__ float wave_max(float v) {
#pragma unroll
    for (int o = 1; o < 64; o <<= 1) v = fmaxf(v, __shfl_xor(v, o));
    return v;
}
#define LDS_WAIT() asm volatile("s_waitcnt lgkmcnt(0)" ::: "memory")

struct Frame {
    LAS unsigned char* lds;
    int tid, lane, wave, G, bid;
    const float* in[16]; float* out; unsigned char* ws;
};

__device__ __forceinline__ void tr_item(const float* W, int ldw, int nvalid, const float* gain, hbits* WT, int K, int k0, int n0s, int n0d, LAS float* scr, int lane) {
#pragma unroll 8
    for (int i = 0; i < 32; ++i) { const int kk = 2 * i + (lane >> 5), n = n0s + (lane & 31);
        float v = (n < nvalid) ? W[(size_t)(k0 + kk) * ldw + n] : 0.f; if (gain) v *= gain[k0 + kk]; scr[kk * 33 + (lane & 31)] = v; }
    LDS_WAIT(); asm volatile("" ::: "memory");
    const int c = lane & 7;
#pragma unroll
    for (int j = 0; j < 4; ++j) { const int n = (lane >> 3) + 8 * j; const LAS float* s = scr + (8 * c) * 33 + n;
        v4u o; o.x = pk2h(s[0 * 33], s[1 * 33]); o.y = pk2h(s[2 * 33], s[3 * 33]); o.z = pk2h(s[4 * 33], s[5 * 33]); o.w = pk2h(s[6 * 33], s[7 * 33]);
        *(GAS v4u*)(WT + (size_t)(n0d + n) * K + k0 + 8 * c) = o; }
    LDS_WAIT(); asm volatile("" ::: "memory");
}
__device__ __forceinline__ void p0_prologue(Frame& F) {
    LAS float* scr = (LAS float*)(F.lds + F.wave * 16384);
    const int gw = F.bid * NWAVES + F.wave, NGW = F.G * NWAVES;
    hbits* WA = (hbits*)(F.ws + WS_WA); hbits* WUV = (hbits*)(F.ws + WS_WUV); hbits* WAO = (hbits*)(F.ws + WS_WAO);
    hbits* WB = (hbits*)(F.ws + WS_WB); hbits* WBO = (hbits*)(F.ws + WS_WBO);
    constexpr int I_WA = 16 * (A_PAD / 32), I_UV = 64, I_SQ = 16 * 32, I_GU = 16 * (2 * FF / 32), I_D = (FF / 64) * 32, I_WB = 16 * (B_IN / 32);
    constexpr int NITEMS = I_WA + I_UV + I_SQ + 2 * I_GU + 2 * I_D + I_WB + I_SQ;
    for (int it = gw; it < NITEMS; it += NGW) {
        int r = it;
        if (r < I_WA) { const int nnb = A_PAD / 32, kb = r / nnb, nb = r % nnb; tr_item(F.in[5], A_IN, A_IN, F.in[2], WA, D, 64 * kb, 32 * nb, 32 * nb, scr, F.lane); continue; } r -= I_WA;
        if (r < I_UV) { const int h = r >> 2, kb = (r >> 1) & 1, nb = r & 1; tr_item(F.in[7] + (size_t)h * RL * VH, VH, VH, nullptr, WUV + (size_t)h * VH * RL, RL, 64 * kb, 32 * nb, 32 * nb, scr, F.lane); continue; } r -= I_UV;
        if (r < I_SQ) { const int kb = r / 32, nb = r % 32; tr_item(F.in[8], D, D, nullptr, WAO, D, 64 * kb, 32 * nb, 32 * nb, scr, F.lane); continue; } r -= I_SQ;
        if (r < 2 * I_GU) { const int l = r / I_GU; r -= l * I_GU; const int nnb = 2 * FF / 32, kb = r / nnb, nb = r % nnb; const int c = 32 * nb;
            const int nd = (c < FF) ? ((c / 128) * 256 + (c % 128)) : (((c - FF) / 128) * 256 + 128 + ((c - FF) % 128));
            tr_item(F.in[14] + (size_t)l * D * 2 * FF, 2 * FF, 2 * FF, F.in[3] + l * D, (hbits*)(F.ws + (l ? WS_WGU1 : WS_WGU0)), D, 64 * kb, c, nd, scr, F.lane); continue; } r -= 2 * I_GU;
        if (r < 2 * I_D) { const int l = r / I_D; r -= l * I_D; const int kb = r / 32, nb = r % 32;
            tr_item(F.in[15] + (size_t)l * FF * D, D, D, nullptr, (hbits*)(F.ws + (l ? WS_WD1 : WS_WD0)), FF, 64 * kb, 32 * nb, 32 * nb, scr, F.lane); continue; } r -= 2 * I_D;
        if (r < I_WB) { const int nnb = B_IN / 32, kb = r / nnb, nb = r % nnb; tr_item(F.in[9], B_IN, B_IN, F.in[2] + D, WB, D, 64 * kb, 32 * nb, 32 * nb, scr, F.lane); continue; } r -= I_WB;
        { const int kb = r / 32, nb = r % 32; tr_item(F.in[12], D, D, nullptr, WBO, D, 64 * kb, 32 * nb, 32 * nb, scr, F.lane); }
    }
    const float* x = F.in[0]; hbits* XH = (hbits*)(F.ws + WS_XH); float* RS0 = (float*)(F.ws + WS_RS0);
    for (int m = gw; m < M; m += NGW) {
        const GAS f32x4* xr = (const GAS f32x4*)(x + (size_t)m * D) + F.lane;
        f32x4 v[4]; float s = 0.f;
#pragma unroll
        for (int j = 0; j < 4; ++j) { v[j] = xr[64 * j]; s += (v[j].x * v[j].x + v[j].y * v[j].y) + (v[j].z * v[j].z + v[j].w * v[j].w); }
        s = wave_sum(s);
        if (F.lane == 0) RS0[m] = 1.0f / sqrtf(s * (1.0f / D) + pg8::RMS_EPS);
        GAS unsigned long long* o8 = (GAS unsigned long long*)(XH + (size_t)m * D) + F.lane;
#pragma unroll
        for (int j = 0; j < 4; ++j) o8[64 * j] = (unsigned long long)pk2h(v[j].x, v[j].y) | ((unsigned long long)pk2h(v[j].z, v[j].w) << 32);
    }
}

__device__ __forceinline__ unsigned okey(float f) { const unsigned u = __builtin_bit_cast(unsigned, f); return (u & 0x80000000u) ? ~u : (u | 0x80000000u); }
__device__ __forceinline__ void p2_indexer(Frame& F) {
    const int gw = F.bid * NWAVES + F.wave, NGW = F.G * NWAVES, lane = F.lane;
    { const float* CKV = (const float*)(F.ws + WS_CKV); hbits* CKVN = (hbits*)(F.ws + WS_CKVN); const float* lg = F.in[6];
      for (int m = gw; m < M; m += NGW) { const float a = CKV[(size_t)m * RL + 2 * lane], b = CKV[(size_t)m * RL + 2 * lane + 1];
          const float s = wave_sum(a * a + b * b); const float r = 1.0f / sqrtf(s * (1.0f / RL) + pg8::RMS_EPS);
          *(unsigned*)(CKVN + (size_t)m * RL + 2 * lane) = pk2h(a * r * lg[2 * lane], b * r * lg[2 * lane + 1]); } }
    LAS float* qs = (LAS float*)(F.lds + F.wave * 16384);
    LAS float* sc = qs + 512;
    const hbits* QI = (const hbits*)(F.ws + WS_QI); const hbits* KI = (const hbits*)(F.ws + WS_KI); const float* WI = (const float*)(F.ws + WS_WI);
    unsigned short* IDX = (unsigned short*)(F.ws + WS_IDX);
    const unsigned long long lt_mask = (1ull << lane) - 1ull;
    for (int i = 0; i * NGW < M; ++i) {
        const int tok = i * NGW + ((i & 1) ? (NGW - 1 - gw) : gw); if (tok >= M) continue; const int b = tok >> 11, t = tok & (T - 1);
        if (t < KSEL) continue;
#pragma unroll
        for (int j = 0; j < 8; ++j) qs[lane + 64 * j] = (float)__builtin_bit_cast(f16, QI[(size_t)tok * 512 + lane + 64 * j]);
        float w[8];
#pragma unroll
        for (int j = 0; j < 8; ++j) w[j] = WI[(size_t)tok * 8 + j];
        LDS_WAIT(); asm volatile("" ::: "memory");
        for (int s0 = 0; s0 <= t; s0 += 64) { const int s = s0 + lane; float score = -INFINITY;
            if (s <= t) { const hbits* kr = KI + ((size_t)b * T + s) * DI; float d[8];
#pragma unroll
                for (int j = 0; j < 8; ++j) d[j] = 0.f;
#pragma unroll
                for (int c = 0; c < 8; ++c) { const f16x8 kv = __builtin_bit_cast(f16x8, *(const v4u*)(kr + 8 * c));
#pragma unroll
                    for (int e = 0; e < 8; ++e) { const float kf = (float)kv[e];
#pragma unroll
                        for (int j = 0; j < 8; ++j) d[j] = fmaf(qs[j * 64 + c * 8 + e], kf, d[j]); } }
                score = 0.f;
#pragma unroll
                for (int j = 0; j < 8; ++j) score = fmaf(w[j], fmaxf(d[j], 0.f), score); }
            sc[s] = score; }
        for (int s = ((t >> 6) + 1) * 64 + lane; s < T; s += 64) sc[s] = -INFINITY;
        LDS_WAIT(); asm volatile("" ::: "memory");
        unsigned key[32];
#pragma unroll
        for (int q = 0; q < 32; ++q) { const int s = lane + 64 * q; key[q] = (s <= t) ? okey(sc[s]) : 0u; }
        unsigned prefix = 0u;
        for (int bit = 31; bit >= 0; --bit) { const unsigned cand = prefix | (1u << bit); int cnt = 0;
#pragma unroll
            for (int q = 0; q < 32; ++q) cnt += __builtin_popcountll(__ballot(key[q] >= cand));
            if (cnt >= KSEL) prefix = cand; }
        int ngt = 0;
#pragma unroll
        for (int q = 0; q < 32; ++q) ngt += __builtin_popcountll(__ballot(key[q] > prefix));
        const int need = KSEL - ngt; int eq_seen = 0, pos = 0;
#pragma unroll
        for (int q = 0; q < 32; ++q) { const bool gt = key[q] > prefix, eq = key[q] == prefix;
            const unsigned long long meq = __ballot(eq); const bool take = eq && (eq_seen + __builtin_popcountll(meq & lt_mask) < need); eq_seen += __builtin_popcountll(meq);
            const bool sel = gt || take; const unsigned long long ms = __ballot(sel);
            if (sel) IDX[(size_t)tok * KSEL + pos + __builtin_popcountll(ms & lt_mask)] = (unsigned short)(lane + 64 * q);
            pos += __builtin_popcountll(ms); }
        LDS_WAIT(); asm volatile("" ::: "memory");
    }
}

__device__ __forceinline__ void p3_sparse_attn(Frame& F) {
    LAS unsigned char* L = F.lds; const int tid = F.tid, lane = F.lane, wave = F.wave;
    LAS hbits* kv = (LAS hbits*)L;
    LAS float* qf = (LAS float*)(L + 69632);
    LAS float* pf = (LAS float*)(L + 69632 + 8192);
    LAS float* of = (LAS float*)(L + 69632 + 8192 + 16384);
    LAS int* ix = (LAS int*)(L + 69632 + 8192 + 16384 + 8192);
    LAS float* bt = (LAS float*)(L + 69632 + 8192 + 16384 + 8192 + 1024);
    const float* rel_bias = F.in[1]; const float* w_uv = F.in[7];
    const hbits* QL = (const hbits*)(F.ws + WS_QL); const hbits* CKVN = (const hbits*)(F.ws + WS_CKVN); const unsigned short* IDX = (const unsigned short*)(F.ws + WS_IDX);
    hbits* OV = (hbits*)(F.ws + WS_OV);
    for (int i = tid; i < 129 * 16; i += NTHREADS) bt[i] = rel_bias[(int)BUCKET_TAB[i >> 4] * 16 + (i & 15)];
    for (int tok = F.bid; tok < M; tok += F.G) {
        const int b = tok >> 11, t = tok & (T - 1); const int n = (t + 1 < KSEL) ? t + 1 : KSEL;
        __syncthreads();
        if (tid < KSEL) ix[tid] = (tid < n) ? ((t < KSEL) ? tid : (int)IDX[(size_t)tok * KSEL + tid]) : 0;
        for (int i = tid; i < NH * RL; i += NTHREADS) qf[i] = (float)__builtin_bit_cast(f16, QL[(size_t)tok * (NH * RL) + i]);
        __syncthreads();
#pragma unroll
        for (int p = 0; p < 8; ++p) { const int k = (tid >> 4) + 32 * p, c = tid & 15;
            if (k < n) { const v4u v = *(const v4u*)(CKVN + ((size_t)b * T + ix[k]) * RL + c * 8); *(LAS v4u*)(kv + k * 136 + c * 8) = v; } }
        __syncthreads();
#pragma unroll
        for (int hh = 0; hh < 2; ++hh) { const int h = 2 * wave + hh; float lg[4]; float mx = -INFINITY;
#pragma unroll
            for (int kk = 0; kk < 4; ++kk) { const int key = lane + 64 * kk; float l = -INFINITY;
                if (key < n) { float d = 0.f;
#pragma unroll
                    for (int c = 0; c < 16; ++c) { const f16x8 kvv = __builtin_bit_cast(f16x8, *(const LAS v4u*)(kv + key * 136 + c * 8));
#pragma unroll
                        for (int e = 0; e < 8; ++e) d = fmaf((float)kvv[e], qf[h * RL + c * 8 + e], d); }
                    const int rel = t - ix[key]; l = d * 0.08838834764831845f + bt[((rel < 128) ? rel : 128) * 16 + h]; }
                lg[kk] = l; mx = fmaxf(mx, l); }
            mx = wave_max(mx); float s = 0.f;
#pragma unroll
            for (int kk = 0; kk < 4; ++kk) { const float p = (lg[kk] == -INFINITY) ? 0.f : __expf(lg[kk] - mx); lg[kk] = p; s += p; }
            s = wave_sum(s); const float inv = 1.0f / s;
#pragma unroll
            for (int kk = 0; kk < 4; ++kk) pf[h * 256 + lane + 64 * kk] = lg[kk] * inv; }
        __syncthreads();
#pragma unroll
        for (int hh = 0; hh < 2; ++hh) { const int h = 2 * wave + hh; float o0 = 0.f, o1 = 0.f;
            for (int k = 0; k < n; ++k) { const float p = pf[h * 256 + k]; const f16x2 vv = __builtin_bit_cast(f16x2, *(const LAS unsigned*)(kv + k * 136 + 2 * lane));
                o0 = fmaf(p, (float)vv[0], o0); o1 = fmaf(p, (float)vv[1], o1); }
            of[h * RL + 2 * lane] = o0; of[h * RL + 2 * lane + 1] = o1; }
        __syncthreads();
#pragma unroll
        for (int hh = 0; hh < 2; ++hh) { const int h = 2 * wave + hh; float a = 0.f;
            for (int r = 0; r < RL; ++r) a = fmaf(of[h * RL + r], w_uv[((size_t)h * RL + r) * VH + lane], a);
            OV[(size_t)tok * D + h * VH + lane] = __builtin_bit_cast(hbits, (f16)a); }
    }
}

__device__ __forceinline__ void p8_swa(Frame& F) {
    const int lane = F.lane, gw = F.bid * NWAVES + F.wave, NGW = F.G * NWAVES;
    LAS float* bt = (LAS float*)(F.lds + 16384);
    LAS float* qs = (LAS float*)(F.lds + F.wave * 1024);
    LAS float* ps = qs + 64;
    const float* rel_bias = F.in[1]; const float* sinks = F.in[11];
    const hbits* QKV = (const hbits*)(F.ws + WS_QKV1); hbits* OB = (hbits*)(F.ws + WS_OB);
    for (int i = F.tid; i < 128 * 16; i += NTHREADS) bt[i] = rel_bias[(int)BUCKET_TAB[i >> 4] * 16 + (i & 15)];
    __syncthreads();
    for (int item = gw; item < M * NH; item += NGW) {
        const int tok = item >> 4, h = item & 15, b = tok >> 11, t = tok & (T - 1), kvh = h >> 3;
        qs[lane] = (float)__builtin_bit_cast(f16, QKV[(size_t)tok * B_IN + h * 64 + lane]);
        LDS_WAIT(); asm volatile("" ::: "memory");
        float l[2];
#pragma unroll
        for (int jj = 0; jj < 2; ++jj) { const int j = lane + 64 * jj, s = t - (WIN - 1) + j; float v = -INFINITY;
            if (s >= 0) { const hbits* kr = QKV + ((size_t)b * T + s) * B_IN + 1024 + kvh * 64; float d = 0.f;
#pragma unroll
                for (int c = 0; c < 8; ++c) { const f16x8 k8 = __builtin_bit_cast(f16x8, *(const v4u*)(kr + 8 * c));
#pragma unroll
                    for (int e = 0; e < 8; ++e) d = fmaf((float)k8[e], qs[c * 8 + e], d); }
                v = d * 0.125f + bt[(WIN - 1 - j) * 16 + h]; }
            l[jj] = v; }
        const float sink = sinks[h];
        float mx = fmaxf(wave_max(fmaxf(l[0], l[1])), sink);
        const float p0 = (l[0] == -INFINITY) ? 0.f : __expf(l[0] - mx), p1 = (l[1] == -INFINITY) ? 0.f : __expf(l[1] - mx);
        const float den = wave_sum(p0 + p1) + __expf(sink - mx); const float inv = 1.0f / den;
        ps[lane] = p0 * inv; ps[lane + 64] = p1 * inv;
        LDS_WAIT(); asm volatile("" ::: "memory");
        float o = 0.f; const int j0 = (t >= WIN - 1) ? 0 : (WIN - 1 - t);
        for (int j = j0; j < WIN; ++j) { const int s = t - (WIN - 1) + j;
            o = fmaf(ps[j], (float)__builtin_bit_cast(f16, QKV[((size_t)b * T + s) * B_IN + 1152 + kvh * 64 + lane]), o); }
        OB[(size_t)tok * D + h * 64 + lane] = __builtin_bit_cast(hbits, (f16)o);
        LDS_WAIT(); asm volatile("" ::: "memory");
    }
}

__device__ __forceinline__ void p12_final(Frame& F) {
    const int gw = F.bid * NWAVES + F.wave, NGW = F.G * NWAVES; const float* g = F.in[4];
    for (int m = gw; m < M; m += NGW) {
        GAS f32x4* xr = (GAS f32x4*)(F.out + (size_t)m * D) + F.lane;
        f32x4 v[4]; float s = 0.f;
#pragma unroll
        for (int j = 0; j < 4; ++j) { v[j] = xr[64 * j]; s += (v[j].x * v[j].x + v[j].y * v[j].y) + (v[j].z * v[j].z + v[j].w * v[j].w); }
        const float r = 1.0f / sqrtf(wave_sum(s) * (1.0f / D) + pg8::RMS_EPS);
#pragma unroll
        for (int j = 0; j < 4; ++j) { const f32x4 gv = *((const f32x4*)g + F.lane + 64 * j); xr[64 * j] = v[j] * r * gv; }
    }
}

struct Args { const float* in[16]; float* out; unsigned char* ws; int ph_lo, ph_hi; };
template <bool COOP>
__global__ void __launch_bounds__(NTHREADS, 2) fwd(Args args) {
    extern __shared__ __attribute__((aligned(16))) unsigned char lds[];
    Frame F;
    F.lds = (LAS unsigned char*)lds; F.tid = threadIdx.x; F.lane = F.tid & 63; F.wave = __builtin_amdgcn_readfirstlane(F.tid >> 6);
    F.G = gridDim.x; F.bid = blockIdx.x;
#pragma unroll
    for (int i = 0; i < 16; ++i) F.in[i] = args.in[i];
    F.out = args.out; F.ws = args.ws;
    unsigned char* ws = args.ws;
    const int lo = args.ph_lo, hi = args.ph_hi;
#define IN(k) (lo <= (k) && (k) < hi)
#define SEAM(k) do { if constexpr (COOP) { if (IN(k) && IN((k) + 1)) cg::this_grid().sync(); } } while (0)
    typedef pg8::bf16_t hb;
    float* SS1 = (float*)(ws + WS_SS1); float* SS2 = (float*)(ws + WS_SS2); float* SS3 = (float*)(ws + WS_SS3);
    hb* XH = (hb*)(ws + WS_XH);

    if (IN(0)) { p0_prologue(F); } SEAM(0);
    if (IN(1)) {
        pg8::Gemm g{XH, (const hb*)(ws + WS_WA), M, A_PAD, D}; pg8::StaticOrder S; S.init(M, A_PAD, F.G, F.bid);
        pg8::EpiInA E{(const float*)(ws + WS_RS0), (hb*)(ws + WS_QL), (float*)(ws + WS_CKV), (hb*)(ws + WS_QI), (hb*)(ws + WS_KI), (float*)(ws + WS_WI)};
        pg8::gemm_phase<pg8::EpiInA, pg8::StaticOrder, true, true>(F.lds, g, S, E);
    } SEAM(1);
    if (IN(2)) { p2_indexer(F); } SEAM(2);
    if (IN(3)) { p3_sparse_attn(F); } SEAM(3);
    if (IN(4)) {
        pg8::Gemm g{(const hb*)(ws + WS_OV), (const hb*)(ws + WS_WAO), M, D, D}; pg8::StaticOrder S; S.init(M, D, F.G, F.bid);
        pg8::EpiRes E{F.in[0], F.out, XH, SS1, nullptr};
        pg8::gemm_phase<pg8::EpiRes, pg8::StaticOrder, true, true>(F.lds, g, S, E);
    } SEAM(4);
    if (IN(5)) {
        pg8::Gemm g{XH, (const hb*)(ws + WS_WGU0), M, 2 * FF, D}; pg8::StaticOrder S; S.init(M, 2 * FF, F.G, F.bid);
        pg8::EpiGU E{SS1, (hb*)(ws + WS_HB)};
        pg8::gemm_phase<pg8::EpiGU, pg8::StaticOrder, true, true>(F.lds, g, S, E);
    } SEAM(5);
    if (IN(6)) {
        pg8::Gemm g{(const hb*)(ws + WS_HB), (const hb*)(ws + WS_WD0), M, D, FF}; pg8::StaticOrder S; S.init(M, D, F.G, F.bid);
        pg8::EpiRes E{F.out, F.out, XH, SS2, nullptr};
        pg8::gemm_phase<pg8::EpiRes, pg8::StaticOrder, true, true>(F.lds, g, S, E);
    } SEAM(6);
    if (IN(7)) {
        pg8::Gemm g{XH, (const hb*)(ws + WS_WB), M, B_IN, D}; pg8::StaticOrder S; S.init(M, B_IN, F.G, F.bid);
        pg8::EpiInB E{SS2, F.in[10], (hb*)(ws + WS_QKV1)};
        pg8::gemm_phase<pg8::EpiInB, pg8::StaticOrder, true, true>(F.lds, g, S, E);
    } SEAM(7);
    if (IN(8)) { p8_swa(F); } SEAM(8);
    if (IN(9)) {
        pg8::Gemm g{(const hb*)(ws + WS_OB), (const hb*)(ws + WS_WBO), M, D, D}; pg8::StaticOrder S; S.init(M, D, F.G, F.bid);
        pg8::EpiRes E{F.out, F.out, XH, SS3, F.in[13]};
        pg8::gemm_phase<pg8::EpiRes, pg8::StaticOrder, true, true>(F.lds, g, S, E);
    } SEAM(9);
    if (IN(10)) {
        pg8::Gemm g{XH, (const hb*)(ws + WS_WGU1), M, 2 * FF, D}; pg8::StaticOrder S; S.init(M, 2 * FF, F.G, F.bid);
        pg8::EpiGU E{SS3, (hb*)(ws + WS_HB)};
        pg8::gemm_phase<pg8::EpiGU, pg8::StaticOrder, true, true>(F.lds, g, S, E);
    } SEAM(10);
    if (IN(11)) {
        pg8::Gemm g{(const hb*)(ws + WS_HB), (const hb*)(ws + WS_WD1), M, D, FF}; pg8::StaticOrder S; S.init(M, D, F.G, F.bid);
        pg8::EpiRes E{F.out, F.out, XH, SS1, nullptr};
        pg8::gemm_phase<pg8::EpiRes, pg8::StaticOrder, true, true>(F.lds, g, S, E);
    } SEAM(11);
    if (IN(12)) { p12_final(F); }
#undef IN
#undef SEAM
}

extern "C" void kernel_launch(void* const* d_in, const int* in_sizes, int n_in, void* d_out, int out_size, void* d_ws, size_t ws_size, hipStream_t stream) {
    static int grid = 0;
    if (grid == 0) {
        if (n_in != 16 || in_sizes[0] != M * D || out_size != M * D || ws_size < WS_END) { fprintf(stderr, "kernel_launch: unexpected shapes (n_in %d, in0 %d, out %d, ws %zu)\n", n_in, n_in > 0 ? in_sizes[0] : -1, out_size, ws_size); grid = -1; return; }
        int dev = 0, cus = 0, per_cu = 0;
        if (hipGetDevice(&dev) != hipSuccess || hipDeviceGetAttribute(&cus, hipDeviceAttributeMultiprocessorCount, dev) != hipSuccess) { grid = -1; return; }
        const void* fn = MK_ONE_LAUNCH ? (const void*)fwd<true> : (const void*)fwd<false>;
        if (hipFuncSetAttribute(fn, hipFuncAttributeMaxDynamicSharedMemorySize, LDS_BYTES) != hipSuccess) { fprintf(stderr, "kernel_launch: hipFuncSetAttribute failed\n"); grid = -1; return; }
        if (hipOccupancyMaxActiveBlocksPerMultiprocessor(&per_cu, fn, NTHREADS, LDS_BYTES) != hipSuccess || per_cu < 1) { fprintf(stderr, "kernel_launch: occupancy query says %d blocks per CU\n", per_cu); per_cu = 1; }
        (void)hipGetLastError();
        grid = cus;
    }
    if (grid < 0) return;
    (void)hipMemsetAsync((char*)d_ws + WS_CTL, 0, CTL_ZERO_BYTES, stream);
    Args a{};
    for (int i = 0; i < 16; ++i) a.in[i] = (const float*)d_in[i];
    a.out = (float*)d_out; a.ws = (unsigned char*)d_ws;
#if MK_ONE_LAUNCH
    a.ph_lo = 0; a.ph_hi = N_PHASES;
    void* kargs[] = {&a};
    hipError_t e = hipLaunchCooperativeKernel((const void*)fwd<true>, dim3(grid), dim3(NTHREADS), kargs, LDS_BYTES, stream);
    if (e != hipSuccess) fprintf(stderr, "cooperative launch failed: %s (grid %d)\n", hipGetErrorString(e), grid);
#else
    for (int p = 0; p < N_PHASES; ++p) { a.ph_lo = p; a.ph_hi = p + 1; hipLaunchKernelGGL(fwd<false>, dim3(grid), dim3(NTHREADS), LDS_BYTES, stream, a); }
#endif
}
```

```cpp
#include <hip/hip_runtime.h>
#include <hip/hip_cooperative_groups.h>
#include <cstdio>
#include <cstdint>
namespace cg = cooperative_groups;

typedef _Float16 f16x8 __attribute__((ext_vector_type(8)));
typedef _Float16 f16x2 __attribute__((ext_vector_type(2)));
typedef _Float16 f16;
namespace pg8 {
#define PG8_LAS __attribute__((address_space(3)))
typedef unsigned short bf16_t;
typedef short bf16x8 __attribute__((ext_vector_type(8)));
typedef float f32x4 __attribute__((ext_vector_type(4)));
typedef unsigned u32x4 __attribute__((ext_vector_type(4)));
constexpr int BM = 256, BK = 64, HALF = 128, HTB = HALF * BK * 2  , STAGE_BYTES = 8 * HTB, NXCD = 8, WGM = 8;

__host__ __device__ __forceinline__ int lds_byte(int r, int c) { const int st = (r >> 4) * 2 + (c >> 5), rr = r & 15, cc = c & 31, ob = rr * 64 + cc * 2; return st * 1024 + (ob ^ (((ob >> 9) & 1) << 5)); }
__host__ __device__ __forceinline__ void stage_rc(int b, int& R, int& C) { const int st = b / 1024, sb = b % 1024, swz = sb ^ (((sb >> 9) & 1) << 5); R = (st >> 1) * 16 + swz / 64; C = (st & 1) * 32 + (swz % 64) / 2; }
__host__ __device__ __forceinline__ int perm32(int rho) { const int n = rho >> 4, i = rho & 15; return 8 * (i >> 2) + 4 * n + (i & 3); }

struct Unit { int pm, pn; };
struct Gemm { const bf16_t* A; const bf16_t* Bt; int M, N, K; };

struct StaticOrder {
    int nM, nN, nwg, G, c;
    __host__ __device__ void init(int M, int N, int G_, int c_) { nM = M / BM; nN = N / BM; nwg = nM * nN; G = G_; c = c_; }
    __host__ __device__ bool next(int i, Unit& u) const {
        const long L = (long)i * G + c; if (L >= nwg) return false;
        int wgid = (int)L; { const int q = nwg / NXCD, r = nwg % NXCD, xcd = wgid % NXCD, off = wgid / NXCD; wgid = (xcd < r ? xcd * (q + 1) : r * (q + 1) + (xcd - r) * q) + off; }
        const int nig = WGM * nN, gid = wgid / nig, fm = gid * WGM, gsz = (nM - fm) < WGM ? (nM - fm) : WGM;
        u.pm = fm + ((wgid % nig) % gsz); u.pn = (wgid % nig) / gsz; return true;
    }
    __device__ __forceinline__ void a_ready(const Unit&) const {}
    __device__ __forceinline__ void done(const Unit&) const {}
};

__device__ __forceinline__ unsigned pk2h(float lo, float hi) { f16x2 v = {(_Float16)lo, (_Float16)hi}; return __builtin_bit_cast(unsigned, v); }
__device__ __forceinline__ u32x4 pk8h(f32x4 a, f32x4 b) { u32x4 w; w.x = pk2h(a[0], a[1]); w.y = pk2h(a[2], a[3]); w.z = pk2h(b[0], b[1]); w.w = pk2h(b[2], b[3]); return w; }
constexpr float RMS_EPS = 1e-6f;
constexpr float LOG2E = 1.4426950408889634f, QSCALE = 0.08838834764831845f * 1.4426950408889634f;

struct EpiInA {
    static constexpr bool PERM = true, AFTER_DRAIN = false;
    const float* rs; bf16_t* QL; float* CKV; bf16_t* QI; bf16_t* KI; float* WI;
    __device__ __forceinline__ void operator()(const f32x4 (&acc)[2][2][4][2], const Unit& u, int wr, int wc, int fr, int fq) const {
        const int row0 = u.pm * BM + wr * 64 + fr;
#pragma unroll
        for (int ai = 0; ai < 2; ++ai)
#pragma unroll
            for (int m = 0; m < 4; ++m) { const int row = row0 + ai * HALF + m * 16; const float r = rs[row];
#pragma unroll
                for (int bj = 0; bj < 2; ++bj) { const int col = u.pn * BM + bj * HALF + wc * 32 + 8 * fq;
                    f32x4 v0 = acc[ai][bj][m][0] * r, v1 = acc[ai][bj][m][1] * r;
                    if (col < 2048) { v0 = v0 * QSCALE; v1 = v1 * QSCALE; *(u32x4*)(QL + (size_t)row * 2048 + col) = pk8h(v0, v1); }
                    else if (col < 2176) { float* p = CKV + (size_t)row * 128 + (col - 2048); *(f32x4*)p = v0; *(f32x4*)(p + 4) = v1; }
                    else if (col < 2688) { v0 = v0 * 0.125f; v1 = v1 * 0.125f; *(u32x4*)(QI + (size_t)row * 512 + (col - 2176)) = pk8h(v0, v1); }
                    else if (col < 2752) { *(u32x4*)(KI + (size_t)row * 64 + (col - 2688)) = pk8h(v0, v1); }
                    else if (col < 2760) { const float s = 0.35355339059327373f; float* p = WI + (size_t)row * 8; *(f32x4*)p = v0 * s; *(f32x4*)(p + 4) = v1 * s; }
                } }
    }
};
struct EpiRes {
    static constexpr bool PERM = true, AFTER_DRAIN = false;
    const float* xold; float* xnew; bf16_t* xh; float* ss; const float* bias;
    __device__ __forceinline__ void operator()(const f32x4 (&acc)[2][2][4][2], const Unit& u, int wr, int wc, int fr, int fq) const {
        const int row0 = u.pm * BM + wr * 64 + fr;
#pragma unroll
        for (int ai = 0; ai < 2; ++ai)
#pragma unroll
            for (int m = 0; m < 4; ++m) { const int row = row0 + ai * HALF + m * 16; float sq = 0.f;
#pragma unroll
                for (int bj = 0; bj < 2; ++bj) { const int col = u.pn * BM + bj * HALF + wc * 32 + 8 * fq; const size_t off = (size_t)row * 1024 + col;
                    f32x4 v0 = acc[ai][bj][m][0] + *(const f32x4*)(xold + off), v1 = acc[ai][bj][m][1] + *(const f32x4*)(xold + off + 4);
                    if (bias) { v0 = v0 + *(const f32x4*)(bias + col); v1 = v1 + *(const f32x4*)(bias + col + 4); }
                    *(f32x4*)(xnew + off) = v0; *(f32x4*)(xnew + off + 4) = v1;
                    *(u32x4*)(xh + off) = pk8h(v0, v1);
                    sq += (v0[0] * v0[0] + v0[1] * v0[1]) + (v0[2] * v0[2] + v0[3] * v0[3]) + (v1[0] * v1[0] + v1[1] * v1[1]) + (v1[2] * v1[2] + v1[3] * v1[3]); }
                sq += __shfl_xor(sq, 16); sq += __shfl_xor(sq, 32);
                if (fq == 0) atomicAdd(ss + row, sq); }
    }
};
struct EpiGU {
    static constexpr bool PERM = true, AFTER_DRAIN = false;
    const float* ss; bf16_t* HB;
    __device__ __forceinline__ void operator()(const f32x4 (&acc)[2][2][4][2], const Unit& u, int wr, int wc, int fr, int fq) const {
        const int row0 = u.pm * BM + wr * 64 + fr; const int col = u.pn * HALF + wc * 32 + 8 * fq;
#pragma unroll
        for (int ai = 0; ai < 2; ++ai)
#pragma unroll
            for (int m = 0; m < 4; ++m) { const int row = row0 + ai * HALF + m * 16; const float r = 1.0f / sqrtf(ss[row] * (1.0f / 1024.0f) + RMS_EPS);
                f32x4 hv[2];
#pragma unroll
                for (int n = 0; n < 2; ++n)
#pragma unroll
                    for (int j = 0; j < 4; ++j) { const float g = acc[ai][0][m][n][j] * r, uu = acc[ai][1][m][n][j] * r;
                        hv[n][j] = g * __builtin_amdgcn_rcpf(1.0f + __builtin_amdgcn_exp2f(-1.4426950408889634f * g)) * uu; }
                *(u32x4*)(HB + (size_t)row * 2816 + col) = pk8h(hv[0], hv[1]); }
    }
};
struct EpiInB {
    static constexpr bool PERM = true, AFTER_DRAIN = false;
    const float* ss; const float* bias; bf16_t* QKV;
    __device__ __forceinline__ void operator()(const f32x4 (&acc)[2][2][4][2], const Unit& u, int wr, int wc, int fr, int fq) const {
        const int row0 = u.pm * BM + wr * 64 + fr;
#pragma unroll
        for (int ai = 0; ai < 2; ++ai)
#pragma unroll
            for (int m = 0; m < 4; ++m) { const int row = row0 + ai * HALF + m * 16; const float r = 1.0f / sqrtf(ss[row] * (1.0f / 1024.0f) + RMS_EPS);
#pragma unroll
                for (int bj = 0; bj < 2; ++bj) { const int col = u.pn * BM + bj * HALF + wc * 32 + 8 * fq;
                    const f32x4 v0 = acc[ai][bj][m][0] * r + *(const f32x4*)(bias + col), v1 = acc[ai][bj][m][1] * r + *(const f32x4*)(bias + col + 4);
                    *(u32x4*)(QKV + (size_t)row * 1280 + col) = pk8h(v0, v1); } }
    }
};

template <class Epi, class Sched, bool ALIGN_EPI = false, bool SP2 = false>
__device__ __forceinline__ void gemm_phase(PG8_LAS unsigned char* lds, const Gemm g, const Sched& S, const Epi& E) {
    const int tid = threadIdx.x, wid = __builtin_amdgcn_readfirstlane(tid >> 6), lane = tid & 63, wr = wid >> 2, wc = wid & 3, fr = lane & 15, fq = lane >> 4;
    const int K = g.K, nt = K / BK;
    unsigned voffA[2], voffB[2];
#pragma unroll
    for (int i = 0; i < 2; ++i) { int R, C; stage_rc(tid * 16 + i * 8192, R, C); const int Rb = Epi::PERM ? ((R & ~31) + perm32(R & 31)) : R;
        voffA[i] = (unsigned)(R * K + C) * 2u; voffB[i] = (unsigned)(Rb * K + C) * 2u; }
    const size_t kstep = (size_t)(BK * 2);
    const size_t hstep = (size_t)HALF * K * 2;
    const size_t tstep = 2 * hstep;
    const unsigned ldsw = (unsigned)wid * 1024u;
    const int aoff = lds_byte(wr * 64 + fr, fq * 8), boff = lds_byte(wc * 32 + fr, fq * 8);
#define PG8_SA(b, h) (((b) * 2 + (h)) * HTB)
#define PG8_SB(b, h) ((4 + (b) * 2 + (h)) * HTB)
#define PG8_STAGE(bufoff, gbase, voff) do { _Pragma("unroll") for (int _i = 0; _i < 2; ++_i) \
        __builtin_amdgcn_global_load_lds((const unsigned*)((const char*)(gbase) + (voff)[_i]), (PG8_LAS unsigned*)(lds + (bufoff) + ldsw + _i * 8192), 16, 0, 0); } while (0)
#define PG8_LDA(dst, b, h) do { _Pragma("unroll") for (int m = 0; m < 4; ++m) _Pragma("unroll") for (int k = 0; k < 2; ++k) dst[m][k] = *(const PG8_LAS bf16x8*)(lds + PG8_SA(b, h) + aoff + m * 2048 + k * 1024); } while (0)
#define PG8_LDB(dst, b, h) do { _Pragma("unroll") for (int n = 0; n < 2; ++n) _Pragma("unroll") for (int k = 0; k < 2; ++k) dst[n][k] = *(const PG8_LAS bf16x8*)(lds + PG8_SB(b, h) + boff + n * 2048 + k * 1024); } while (0)
#define PG8_MMA(ai, bj, At, Bt) do { __builtin_amdgcn_s_setprio(1); _Pragma("unroll") for (int m = 0; m < 4; ++m) _Pragma("unroll") for (int n = 0; n < 2; ++n) _Pragma("unroll") for (int k = 0; k < 2; ++k) \
        acc[ai][bj][m][n] = __builtin_amdgcn_mfma_f32_16x16x32_f16(__builtin_bit_cast(f16x8, Bt[n][k]), __builtin_bit_cast(f16x8, At[m][k]), acc[ai][bj][m][n], 0, 0, 0); __builtin_amdgcn_s_setprio(0); } while (0)
#define PG8_WAIT_V(n) asm volatile("s_waitcnt vmcnt(" #n ")" ::: "memory")
#define PG8_WAIT_L(n) asm volatile("s_waitcnt lgkmcnt(" #n ")" ::: "memory")
#define PG8_BAR __builtin_amdgcn_s_barrier()
#define PG8_SCHED __builtin_amdgcn_sched_barrier(0)
    Unit cur, nxt; int ui = 0;
    if (!S.next(0, cur)) return;
    f32x4 acc[2][2][4][2];
#pragma unroll
    for (int a = 0; a < 2; ++a)
#pragma unroll
        for (int b = 0; b < 2; ++b)
#pragma unroll
            for (int m = 0; m < 4; ++m)
#pragma unroll
                for (int n = 0; n < 2; ++n) acc[a][b][m][n] = (f32x4){0.f, 0.f, 0.f, 0.f};
    bf16x8 At[4][2], B0[2][2], B1[2][2];
    const char* cA = (const char*)g.A + (size_t)cur.pm * tstep; const char* cB = (const char*)g.Bt + (size_t)cur.pn * tstep;
    S.a_ready(cur);
    if constexpr (SP2) {
        PG8_STAGE(PG8_SB(0, 0), cB, voffB); PG8_STAGE(PG8_SB(0, 1), cB + hstep, voffB); PG8_STAGE(PG8_SA(0, 0), cA, voffA); PG8_STAGE(PG8_SA(0, 1), cA + hstep, voffA);
        if (wr == 1) PG8_BAR;
        PG8_WAIT_V(2); PG8_BAR;
        PG8_STAGE(PG8_SB(1, 0), cB + kstep, voffB); PG8_STAGE(PG8_SA(1, 0), cA + kstep, voffA); PG8_STAGE(PG8_SB(1, 1), cB + hstep + kstep, voffB);
        PG8_WAIT_V(6); PG8_BAR;
    } else {
        PG8_STAGE(PG8_SB(0, 0), cB, voffB); PG8_STAGE(PG8_SA(0, 0), cA, voffA); PG8_STAGE(PG8_SB(0, 1), cB + hstep, voffB); PG8_STAGE(PG8_SA(0, 1), cA + hstep, voffA);
        if (wr == 1) PG8_BAR;
        PG8_WAIT_V(4); PG8_BAR;
        PG8_STAGE(PG8_SB(1, 0), cB + kstep, voffB); PG8_STAGE(PG8_SA(1, 0), cA + kstep, voffA); PG8_STAGE(PG8_SB(1, 1), cB + hstep + kstep, voffB);
        PG8_WAIT_V(6); PG8_BAR;
    }
    for (;;) {
        const bool has_next = S.next(ui + 1, nxt);
        const char* nA = has_next ? (const char*)g.A + (size_t)nxt.pm * tstep : cA; const char* nB = has_next ? (const char*)g.Bt + (size_t)nxt.pn * tstep : cB;
        for (int t = 0; t < nt; t += 2) {
            const bool last = (t == nt - 2);
            const char* a1 = cA + (size_t)(t + 1) * kstep;
            const char* a2 = last ? nA : cA + (size_t)(t + 2) * kstep; const char* b2 = last ? nB : cB + (size_t)(t + 2) * kstep;
            const char* a3 = a2 + kstep; const char* b3 = b2 + kstep;
            if (last && has_next) S.a_ready(nxt);
            if constexpr (SP2) {
            PG8_LDB(B0, 0, 0); PG8_LDB(B1, 0, 1); PG8_SCHED; PG8_LDA(At, 0, 0); PG8_STAGE(PG8_SA(1, 1), a1 + hstep, voffA);
            PG8_WAIT_V(8); PG8_WAIT_L(0); PG8_BAR; PG8_MMA(0, 0, At, B0); PG8_MMA(0, 1, At, B1); PG8_BAR; PG8_SCHED;
            PG8_LDA(At, 0, 1); PG8_STAGE(PG8_SB(0, 0), b2, voffB); PG8_STAGE(PG8_SB(0, 1), b2 + hstep, voffB); PG8_STAGE(PG8_SA(0, 0), a2, voffA);
            PG8_WAIT_V(8); PG8_WAIT_L(0); PG8_BAR; PG8_MMA(1, 0, At, B0); PG8_MMA(1, 1, At, B1); PG8_BAR; PG8_SCHED;
            PG8_LDB(B0, 1, 0); PG8_LDB(B1, 1, 1); PG8_SCHED; PG8_LDA(At, 1, 0); PG8_STAGE(PG8_SA(0, 1), a2 + hstep, voffA);
            PG8_WAIT_V(8); PG8_WAIT_L(0); PG8_BAR; PG8_MMA(0, 0, At, B0); PG8_MMA(0, 1, At, B1); PG8_BAR; PG8_SCHED;
            PG8_LDA(At, 1, 1); PG8_STAGE(PG8_SB(1, 0), b3, voffB); PG8_STAGE(PG8_SB(1, 1), b3 + hstep, voffB); PG8_STAGE(PG8_SA(1, 0), a3, voffA);
            PG8_WAIT_V(8); PG8_WAIT_L(0); PG8_BAR; PG8_MMA(1, 0, At, B0); PG8_MMA(1, 1, At, B1); PG8_BAR; PG8_SCHED;
            } else {
            PG8_LDB(B0, 0, 0); PG8_SCHED; PG8_LDA(At, 0, 0); PG8_STAGE(PG8_SA(1, 1), a1 + hstep, voffA);
            PG8_WAIT_L(8); PG8_BAR; PG8_WAIT_L(0); PG8_MMA(0, 0, At, B0); PG8_BAR; PG8_SCHED;
            PG8_LDB(B1, 0, 1); PG8_STAGE(PG8_SB(0, 0), b2, voffB);
            PG8_BAR; PG8_WAIT_L(0); PG8_MMA(0, 1, At, B1); PG8_BAR;
            PG8_LDA(At, 0, 1); PG8_STAGE(PG8_SA(0, 0), a2, voffA);
            PG8_BAR; PG8_WAIT_L(0); PG8_MMA(1, 0, At, B0); PG8_BAR; PG8_SCHED;
            PG8_STAGE(PG8_SB(0, 1), b2 + hstep, voffB);
            PG8_WAIT_V(6); PG8_BAR; PG8_MMA(1, 1, At, B1); PG8_BAR;
            PG8_LDB(B0, 1, 0); PG8_SCHED; PG8_LDA(At, 1, 0); PG8_STAGE(PG8_SA(0, 1), a2 + hstep, voffA);
            PG8_WAIT_L(8); PG8_BAR; PG8_WAIT_L(0); PG8_MMA(0, 0, At, B0); PG8_BAR; PG8_SCHED;
            PG8_LDB(B1, 1, 1); PG8_STAGE(PG8_SB(1, 0), b3, voffB);
            PG8_BAR; PG8_WAIT_L(0); PG8_MMA(0, 1, At, B1); PG8_BAR;
            PG8_LDA(At, 1, 1); PG8_STAGE(PG8_SA(1, 0), a3, voffA);
            PG8_BAR; PG8_WAIT_L(0); PG8_MMA(1, 0, At, B0); PG8_BAR; PG8_SCHED;
            PG8_STAGE(PG8_SB(1, 1), b3 + hstep, voffB);
            PG8_WAIT_V(6); PG8_BAR; PG8_MMA(1, 1, At, B1); PG8_BAR;
            }
        }
        if constexpr (ALIGN_EPI) { if (wr == 0) PG8_BAR; }
        if constexpr (!Epi::AFTER_DRAIN) { E(acc, cur, wr, wc, fr, fq); S.done(cur); }
        if (!has_next) break;
#pragma unroll
        for (int a = 0; a < 2; ++a)
#pragma unroll
            for (int b = 0; b < 2; ++b)
#pragma unroll
                for (int m = 0; m < 4; ++m)
#pragma unroll
                    for (int n = 0; n < 2; ++n) acc[a][b][m][n] = (f32x4){0.f, 0.f, 0.f, 0.f};
        cur = nxt; cA = nA; cB = nB; ++ui;
        if constexpr (ALIGN_EPI) { if (wr == 1) PG8_BAR; }
    }
    PG8_WAIT_V(0);
    if constexpr (!ALIGN_EPI) { if (wr == 0) PG8_BAR; }
    PG8_BAR;
    if constexpr (Epi::AFTER_DRAIN) { E.fused(acc, cur, wr, wc, fr, fq, lds, wid, lane); S.done(cur); }
#undef PG8_SA
#undef PG8_SB
#undef PG8_STAGE
#undef PG8_LDA
#undef PG8_LDB
#undef PG8_MMA
#undef PG8_WAIT_V
#undef PG8_WAIT_L
#undef PG8_BAR
#undef PG8_SCHED
}
}

constexpr int NB = 8, T = 2048, D = 1024, M = NB * T, NH = 16, RL = 128, VH = 64, HI = 8, DI = 64, KSEL = 256;
constexpr int A_IN = 2760, A_PAD = 2816, B_IN = 1280, FF = 2816, WIN = 128;
constexpr int NWAVES = 8, NTHREADS = NWAVES * 64;
constexpr int N_PHASES = 13;
#ifndef MK_ONE_LAUNCH
#define MK_ONE_LAUNCH 1
#endif
constexpr size_t MiB = 1u << 20;
constexpr size_t WS_CTL = 0, CTL_ZERO_BYTES = 1 * MiB;
constexpr size_t WS_SS1 = 256 * 1024, WS_SS2 = 320 * 1024, WS_SS3 = 384 * 1024;
constexpr size_t WS_RS0 = 1 * MiB;
constexpr size_t WS_WA = 2 * MiB, WS_WUV = WS_WA + (size_t)A_PAD * D * 2, WS_WAO = 8 * MiB, WS_WGU0 = 10 * MiB, WS_WGU1 = 21 * MiB, WS_WD0 = 32 * MiB,
                 WS_WD1 = WS_WD0 + (size_t)D * FF * 2, WS_WB = 43 * MiB, WS_WBO = 46 * MiB;
constexpr size_t WS_XH = 50 * MiB;
constexpr size_t WS_QL = 82 * MiB, WS_CKV = 146 * MiB, WS_CKVN = 154 * MiB, WS_QI = 158 * MiB, WS_KI = 174 * MiB, WS_WI = 176 * MiB, WS_IDX = 178 * MiB, WS_OV = 186 * MiB;
constexpr size_t WS_HB = 82 * MiB, WS_QKV1 = 170 * MiB, WS_OB = 210 * MiB, WS_WCT = 242 * MiB, WS_END = 246 * MiB;
static_assert(WS_WUV + 16 * 64 * 128 * 2 <= WS_WAO && WS_WD1 + (size_t)D * FF * 2 <= WS_WB && WS_WB + (size_t)B_IN * D * 2 <= WS_WBO && WS_WBO + 2 * MiB <= WS_XH, "weights map");
static_assert(WS_HB + (size_t)M * FF * 2 <= WS_QKV1 && WS_QKV1 + (size_t)M * B_IN * 2 <= WS_OB && WS_OB + (size_t)M * D * 2 <= WS_WCT, "activation map");
constexpr int LDS_BYTES = 147456;

#define GAS __attribute__((address_space(1)))
#define LAS __attribute__((address_space(3)))
typedef unsigned v4u __attribute__((ext_vector_type(4)));
typedef float f32x4 __attribute__((ext_vector_type(4)));
typedef unsigned short hbits;
using pg8::pk2h;

__device__ const unsigned char BUCKET_TAB[129] = {0,1,2,3,4,5,6,7,8,9,10,11,12,13,14,15,16,16,16,17,17,18,18,18,19,19,19,20,20,20,20,21,21,21,21,22,22,22,22,22,23,23,23,23,23,23,24,24,24,24,24,24,25,25,25,25,25,25,25,26,26,26,26,26,26,26,26,27,27,27,27,27,27,27,27,27,27,28,28,28,28,28,28,28,28,28,28,29,29,29,29,29,29,29,29,29,29,29,29,30,30,30,30,30,30,30,30,30,30,30,30,30,30,31,31,31,31,31,31,31,31,31,31,31,31,31,31,31,31};

__device__ __forceinline__ float wave_sum(float v) {
#pragma unroll
    for (int o = 1; o < 64; o <<= 1) v += __shfl_xor(v, o);
    return v;
}
__device__ __forceinline__ float wave_max(float v) {
#pragma unroll
    for (int o = 1; o < 64; o <<= 1) v = fmaxf(v, __shfl_xor(v, o));
    return v;
}
#define LDS_WAIT() asm volatile("s_waitcnt lgkmcnt(0)" ::: "memory")

struct Frame {
    LAS unsigned char* lds;
    int tid, lane, wave, G, bid;
    const float* in[16]; float* out; unsigned char* ws;
};

__device__ __forceinline__ void tr_item(const float* W, int ldw, int nvalid, const float* gain, hbits* WT, int K, int k0, int n0s, int n0d, LAS float* scr, int lane) {
#pragma unroll 8
    for (int i = 0; i < 32; ++i) { const int kk = 2 * i + (lane >> 5), n = n0s + (lane & 31);
        float v = (n < nvalid) ? W[(size_t)(k0 + kk) * ldw + n] : 0.f; if (gain) v *= gain[k0 + kk]; scr[kk * 33 + (lane & 31)] = v; }
    LDS_WAIT(); asm volatile("" ::: "memory");
    const int c = lane & 7;
#pragma unroll
    for (int j = 0; j < 4; ++j) { const int n = (lane >> 3) + 8 * j; const LAS float* s = scr + (8 * c) * 33 + n;
        v4u o; o.x = pk2h(s[0 * 33], s[1 * 33]); o.y = pk2h(s[2 * 33], s[3 * 33]); o.z = pk2h(s[4 * 33], s[5 * 33]); o.w = pk2h(s[6 * 33], s[7 * 33]);
        *(GAS v4u*)(WT + (size_t)(n0d + n) * K + k0 + 8 * c) = o; }
    LDS_WAIT(); asm volatile("" ::: "memory");
}
__device__ __forceinline__ void p0_prologue(Frame& F) {
    LAS float* scr = (LAS float*)(F.lds + F.wave * 16384);
    const int gw = F.bid * NWAVES + F.wave, NGW = F.G * NWAVES;
    hbits* WA = (hbits*)(F.ws + WS_WA); hbits* WUV = (hbits*)(F.ws + WS_WUV); hbits* WAO = (hbits*)(F.ws + WS_WAO);
    hbits* WB = (hbits*)(F.ws + WS_WB); hbits* WBO = (hbits*)(F.ws + WS_WBO);
    constexpr int I_WA = 16 * (A_PAD / 32), I_UV = 64, I_SQ = 16 * 32, I_GU = 16 * (2 * FF / 32), I_D = (FF / 64) * 32, I_WB = 16 * (B_IN / 32);
    constexpr int NITEMS = I_WA + I_UV + I_SQ + 2 * I_GU + 2 * I_D + I_WB + I_SQ;
    for (int it = gw; it < NITEMS; it += NGW) {
        int r = it;
        if (r < I_WA) { const int nnb = A_PAD / 32, kb = r / nnb, nb = r % nnb; tr_item(F.in[5], A_IN, A_IN, F.in[2], WA, D, 64 * kb, 32 * nb, 32 * nb, scr, F.lane); continue; } r -= I_WA;
        if (r < I_UV) { const int h = r >> 2, kb = (r >> 1) & 1, nb = r & 1; tr_item(F.in[7] + (size_t)h * RL * VH, VH, VH, nullptr, WUV + (size_t)h * VH * RL, RL, 64 * kb, 32 * nb, 32 * nb, scr, F.lane); continue; } r -= I_UV;
        if (r < I_SQ) { const int kb = r / 32, nb = r % 32; tr_item(F.in[8], D, D, nullptr, WAO, D, 64 * kb, 32 * nb, 32 * nb, scr, F.lane); continue; } r -= I_SQ;
        if (r < 2 * I_GU) { const int l = r / I_GU; r -= l * I_GU; const int nnb = 2 * FF / 32, kb = r / nnb, nb = r % nnb; const int c = 32 * nb;
            const int nd = (c < FF) ? ((c / 128) * 256 + (c % 128)) : (((c - FF) / 128) * 256 + 128 + ((c - FF) % 128));
            tr_item(F.in[14] + (size_t)l * D * 2 * FF, 2 * FF, 2 * FF, F.in[3] + l * D, (hbits*)(F.ws + (l ? WS_WGU1 : WS_WGU0)), D, 64 * kb, c, nd, scr, F.lane); continue; } r -= 2 * I_GU;
        if (r < 2 * I_D) { const int l = r / I_D; r -= l * I_D; const int kb = r / 32, nb = r % 32;
            tr_item(F.in[15] + (size_t)l * FF * D, D, D, nullptr, (hbits*)(F.ws + (l ? WS_WD1 : WS_WD0)), FF, 64 * kb, 32 * nb, 32 * nb, scr, F.lane); continue; } r -= 2 * I_D;
        if (r < I_WB) { const int nnb = B_IN / 32, kb = r / nnb, nb = r % nnb; tr_item(F.in[9], B_IN, B_IN, F.in[2] + D, WB, D, 64 * kb, 32 * nb, 32 * nb, scr, F.lane); continue; } r -= I_WB;
        { const int kb = r / 32, nb = r % 32; tr_item(F.in[12], D, D, nullptr, WBO, D, 64 * kb, 32 * nb, 32 * nb, scr, F.lane); }
    }
    { const float* w_uv = F.in[7]; const float* w_out = F.in[8]; hbits* WCT = (hbits*)(F.ws + WS_WCT);
      for (int it = gw; it < 1024; it += NGW) { const int h = it >> 6, dblk = (it >> 2) & 15, rblk = it & 3, d = dblk * 64 + F.lane;
          float wo[64];
#pragma unroll
          for (int v = 0; v < 64; ++v) wo[v] = w_out[(size_t)(h * 64 + v) * D + d];
          for (int r8 = 0; r8 < 4; ++r8) { float acc[8];
#pragma unroll
              for (int rr = 0; rr < 8; ++rr) { const float* u = w_uv + (size_t)(h * RL + rblk * 32 + r8 * 8 + rr) * VH; float sacc = 0.f;
#pragma unroll
                  for (int v = 0; v < 64; ++v) sacc = fmaf(u[v], wo[v], sacc);
                  acc[rr] = sacc; }
              v4u o; o.x = pk2h(acc[0], acc[1]); o.y = pk2h(acc[2], acc[3]); o.z = pk2h(acc[4], acc[5]); o.w = pk2h(acc[6], acc[7]);
              *(GAS v4u*)(WCT + (size_t)d * (NH * RL) + h * RL + rblk * 32 + r8 * 8) = o; } } }
    const float* x = F.in[0]; hbits* XH = (hbits*)(F.ws + WS_XH); float* RS0 = (float*)(F.ws + WS_RS0);
    for (int m = gw; m < M; m += NGW) {
        const GAS f32x4* xr = (const GAS f32x4*)(x + (size_t)m * D) + F.lane;
        f32x4 v[4]; float s = 0.f;
#pragma unroll
        for (int j = 0; j < 4; ++j) { v[j] = xr[64 * j]; s += (v[j].x * v[j].x + v[j].y * v[j].y) + (v[j].z * v[j].z + v[j].w * v[j].w); }
        s = wave_sum(s);
        if (F.lane == 0) RS0[m] = 1.0f / sqrtf(s * (1.0f / D) + pg8::RMS_EPS);
        GAS unsigned long long* o8 = (GAS unsigned long long*)(XH + (size_t)m * D) + F.lane;
#pragma unroll
        for (int j = 0; j < 4; ++j) o8[64 * j] = (unsigned long long)pk2h(v[j].x, v[j].y) | ((unsigned long long)pk2h(v[j].z, v[j].w) << 32);
    }
}

__device__ __forceinline__ unsigned okey(float f) { const unsigned u = __builtin_bit_cast(unsigned, f); return (u & 0x80000000u) ? ~u : (u | 0x80000000u); }
__device__ __forceinline__ void p2_indexer(Frame& F) {
    const int gw = F.bid * NWAVES + F.wave, NGW = F.G * NWAVES, lane = F.lane;
    { const float* CKV = (const float*)(F.ws + WS_CKV); hbits* CKVN = (hbits*)(F.ws + WS_CKVN); const float* lg = F.in[6];
      for (int m = gw; m < M; m += NGW) { const float a = CKV[(size_t)m * RL + 2 * lane], b = CKV[(size_t)m * RL + 2 * lane + 1];
          const float s = wave_sum(a * a + b * b); const float r = 1.0f / sqrtf(s * (1.0f / RL) + pg8::RMS_EPS);
          *(unsigned*)(CKVN + (size_t)m * RL + 2 * lane) = pk2h(a * r * lg[2 * lane], b * r * lg[2 * lane + 1]); } }
    LAS float* qs = (LAS float*)(F.lds + F.wave * 16384);
    LAS float* sc = qs + 512;
    const hbits* QI = (const hbits*)(F.ws + WS_QI); const hbits* KI = (const hbits*)(F.ws + WS_KI); const float* WI = (const float*)(F.ws + WS_WI);
    unsigned short* IDX = (unsigned short*)(F.ws + WS_IDX);
    const unsigned long long lt_mask = (1ull << lane) - 1ull;
    for (int i = 0; i * NGW < M; ++i) {
        const int tok = i * NGW + ((i & 1) ? (NGW - 1 - gw) : gw); if (tok >= M) continue; const int b = tok >> 11, t = tok & (T - 1);
        if (t < KSEL) {
#pragma unroll
            for (int j = 0; j < 4; ++j) { const int k = 4 * lane + j; IDX[(size_t)tok * KSEL + k] = (unsigned short)((k < t) ? k : t); }
            continue; }
#pragma unroll
        for (int j = 0; j < 8; ++j) qs[lane + 64 * j] = (float)__builtin_bit_cast(f16, QI[(size_t)tok * 512 + lane + 64 * j]);
        float w[8];
#pragma unroll
        for (int j = 0; j < 8; ++j) w[j] = WI[(size_t)tok * 8 + j];
        LDS_WAIT(); asm volatile("" ::: "memory");
        for (int s0 = 0; s0 <= t; s0 += 64) { const int s = s0 + lane; float score = -INFINITY;
            if (s <= t) { const hbits* kr = KI + ((size_t)b * T + s) * DI; float d[8];
#pragma unroll
                for (int j = 0; j < 8; ++j) d[j] = 0.f;
#pragma unroll
                for (int c = 0; c < 8; ++c) { const f16x8 kv = __builtin_bit_cast(f16x8, *(const v4u*)(kr + 8 * c));
#pragma unroll
                    for (int e = 0; e < 8; ++e) { const float kf = (float)kv[e];
#pragma unroll
                        for (int j = 0; j < 8; ++j) d[j] = fmaf(qs[j * 64 + c * 8 + e], kf, d[j]); } }
                score = 0.f;
#pragma unroll
                for (int j = 0; j < 8; ++j) score = fmaf(w[j], fmaxf(d[j], 0.f), score); }
            sc[s] = score; }
        for (int s = ((t >> 6) + 1) * 64 + lane; s < T; s += 64) sc[s] = -INFINITY;
        LDS_WAIT(); asm volatile("" ::: "memory");
        unsigned key[32];
#pragma unroll
        for (int q = 0; q < 32; ++q) { const int s = lane + 64 * q; key[q] = (s <= t) ? okey(sc[s]) : 0u; }
        unsigned prefix = 0u;
        for (int bit = 31; bit >= 0; --bit) { const unsigned cand = prefix | (1u << bit); int cnt = 0;
#pragma unroll
            for (int q = 0; q < 32; ++q) cnt += __builtin_popcountll(__ballot(key[q] >= cand));
            if (cnt >= KSEL) prefix = cand; }
        int ngt = 0;
#pragma unroll
        for (int q = 0; q < 32; ++q) ngt += __builtin_popcountll(__ballot(key[q] > prefix));
        const int need = KSEL - ngt; int eq_seen = 0, pos = 0;
#pragma unroll
        for (int q = 0; q < 32; ++q) { const bool gt = key[q] > prefix, eq = key[q] == prefix;
            const unsigned long long meq = __ballot(eq); const bool take = eq && (eq_seen + __builtin_popcountll(meq & lt_mask) < need); eq_seen += __builtin_popcountll(meq);
            const bool sel = gt || take; const unsigned long long ms = __ballot(sel);
            if (sel) IDX[(size_t)tok * KSEL + pos + __builtin_popcountll(ms & lt_mask)] = (unsigned short)(lane + 64 * q);
            pos += __builtin_popcountll(ms); }
        LDS_WAIT(); asm volatile("" ::: "memory");
    }
}

typedef short v4i16_t __attribute__((ext_vector_type(4)));
__device__ __forceinline__ int swz_x(int row) { return ((row & 3) << 2) | ((row >> 2) & 3); }
__device__ __forceinline__ void p3_sparse_attn(Frame& F) {
    const int lane = F.lane, wave = F.wave, gw = F.bid * NWAVES + wave, NGW = F.G * NWAVES;
    const int a = lane & 15, q = lane >> 4, sq = ((q & 1) << 1) | (q >> 1);
    LAS unsigned char* kvb = F.lds + wave * 16384;
    LAS unsigned short* idl = (LAS unsigned short*)(F.lds + 131072 + wave * 512);
    LAS float* bt = (LAS float*)(F.lds + 135168);
    const float* rel_bias = F.in[1];
    hbits* QL = (hbits*)(F.ws + WS_QL); const hbits* CKVN = (const hbits*)(F.ws + WS_CKVN); const unsigned short* IDX = (const unsigned short*)(F.ws + WS_IDX);
    for (int i = F.tid; i < 129 * 16; i += NTHREADS) bt[i] = rel_bias[(int)BUCKET_TAB[i >> 4] * 16 + (i & 15)] * pg8::LOG2E;
    __syncthreads();
    const int arow = 4 * ((((a >> 2) & 1) << 1) | (a >> 3)) + (a & 3), xa = swz_x(arow);
    int aoff[4];
#pragma unroll
    for (int s = 0; s < 4; ++s) aoff[s] = 256 * arow + 16 * ((4 * s + q) ^ xa);
    const int trow = 4 * sq + (a >> 2), xt = swz_x(trow);
    int toff[8];
#pragma unroll
    for (int nt = 0; nt < 8; ++nt) toff[nt] = 256 * trow + 16 * ((2 * nt + ((a >> 1) & 1)) ^ xt) + 8 * (a & 1);
    const int drow = lane >> 4;
    for (int i = 0; i * NGW < M; ++i) {
        const int tok = gw + NGW * i; if (tok >= M) break;
        const int b = tok >> 11, t = tok & (T - 1); const int n = (t + 1 < KSEL) ? t + 1 : KSEL, nc = (n + 31) >> 5;
        { const unsigned long long v = *(const unsigned long long*)(IDX + (size_t)tok * KSEL + 4 * lane); *(LAS unsigned long long*)(idl + 4 * lane) = v; }
        f16x8 qf[4];
#pragma unroll
        for (int s = 0; s < 4; ++s) qf[s] = __builtin_bit_cast(f16x8, *(const v4u*)(QL + (size_t)tok * (NH * RL) + a * RL + 32 * s + 8 * q));
        LDS_WAIT(); asm volatile("" ::: "memory");
        const hbits* kvbase = CKVN + (size_t)b * T * RL;
#define P3_DMA(c, buf) do { _Pragma("unroll") for (int g = 0; g < 8; ++g) { const int row = 4 * g + drow; const int key = idl[32 * (c) + row]; \
            __builtin_amdgcn_global_load_lds((const unsigned*)(kvbase + (size_t)key * RL + 8 * ((lane & 15) ^ swz_x(row))), (LAS unsigned*)(kvb + (buf) * 8192 + g * 1024), 16, 0, 0); } } while (0)
        P3_DMA(0, 0);
        float m = -INFINITY, l = 0.f; f32x4 o[8];
#pragma unroll
        for (int nt = 0; nt < 8; ++nt) o[nt] = (f32x4){0.f, 0.f, 0.f, 0.f};
        for (int c = 0; c < nc; ++c) {
            LAS unsigned char* cur = kvb + (c & 1) * 8192;
            if (c + 1 < nc) { LDS_WAIT(); asm volatile("" ::: "memory"); P3_DMA(c + 1, (c + 1) & 1); asm volatile("s_waitcnt vmcnt(8)" ::: "memory"); }
            else { asm volatile("s_waitcnt vmcnt(0)" ::: "memory"); }
            f32x4 s0 = (f32x4){0.f, 0.f, 0.f, 0.f}, s1 = (f32x4){0.f, 0.f, 0.f, 0.f};
#pragma unroll
            for (int s = 0; s < 4; ++s) { const f16x8 k0 = __builtin_bit_cast(f16x8, *(const LAS v4u*)(cur + aoff[s])), k1 = __builtin_bit_cast(f16x8, *(const LAS v4u*)(cur + 4096 + aoff[s]));
                s0 = __builtin_amdgcn_mfma_f32_16x16x32_f16(k0, qf[s], s0, 0, 0, 0); s1 = __builtin_amdgcn_mfma_f32_16x16x32_f16(k1, qf[s], s1, 0, 0, 0); }
            { const unsigned long long i0 = *(const LAS unsigned long long*)(idl + 32 * c + 4 * sq), i1 = *(const LAS unsigned long long*)(idl + 32 * c + 16 + 4 * sq);
#pragma unroll
              for (int r = 0; r < 4; ++r) { const int k0 = (int)((i0 >> (16 * r)) & 0xffffu), k1 = (int)((i1 >> (16 * r)) & 0xffffu);
                  const int r0 = t - k0, r1 = t - k1;
                  s0[r] += bt[(((unsigned)r0 < 128u) ? r0 : 128) * 16 + a]; s1[r] += bt[(((unsigned)r1 < 128u) ? r1 : 128) * 16 + a];
                  if (32 * c + 4 * sq + r >= n) s0[r] = -INFINITY;
                  if (32 * c + 16 + 4 * sq + r >= n) s1[r] = -INFINITY; } }
            float cm = fmaxf(fmaxf(fmaxf(s0[0], s0[1]), fmaxf(s0[2], s0[3])), fmaxf(fmaxf(s1[0], s1[1]), fmaxf(s1[2], s1[3])));
            cm = fmaxf(cm, __shfl_xor(cm, 16)); cm = fmaxf(cm, __shfl_xor(cm, 32));
            const float mn = fmaxf(m, cm), alpha = __builtin_amdgcn_exp2f(m - mn); m = mn;
            float ps = 0.f;
#pragma unroll
            for (int r = 0; r < 4; ++r) { s0[r] = __builtin_amdgcn_exp2f(s0[r] - mn); s1[r] = __builtin_amdgcn_exp2f(s1[r] - mn); ps += s0[r] + s1[r]; }
            l = l * alpha + ps;
#pragma unroll
            for (int nt = 0; nt < 8; ++nt) o[nt] = o[nt] * alpha;
            v4u pw; pw.x = pk2h(s0[0], s0[1]); pw.y = pk2h(s0[2], s0[3]); pw.z = pk2h(s1[0], s1[1]); pw.w = pk2h(s1[2], s1[3]);
            const f16x8 pfr = __builtin_bit_cast(f16x8, pw);
#pragma unroll
            for (int nt = 0; nt < 8; ++nt) {
                const v4i16_t t0 = __builtin_amdgcn_ds_read_tr16_b64_v4i16((LAS v4i16_t*)(cur + toff[nt])), t1 = __builtin_amdgcn_ds_read_tr16_b64_v4i16((LAS v4i16_t*)(cur + 4096 + toff[nt]));
                typedef short v8i16_t __attribute__((ext_vector_type(8)));
                const v8i16_t tv = {t0[0], t0[1], t0[2], t0[3], t1[0], t1[1], t1[2], t1[3]};
                o[nt] = __builtin_amdgcn_mfma_f32_16x16x32_f16(__builtin_bit_cast(f16x8, tv), pfr, o[nt], 0, 0, 0); }
        }
        l += __shfl_xor(l, 16); l += __shfl_xor(l, 32);
        const float inv = 1.0f / l;
        hbits* orow = QL + (size_t)tok * (NH * RL) + a * RL + 4 * q;
#pragma unroll
        for (int nt = 0; nt < 8; ++nt) { const unsigned long long w = (unsigned long long)pk2h(o[nt][0] * inv, o[nt][1] * inv) | ((unsigned long long)pk2h(o[nt][2] * inv, o[nt][3] * inv) << 32);
            *(unsigned long long*)(orow + 16 * nt) = w; }
        LDS_WAIT(); asm volatile("" ::: "memory");
#undef P3_DMA
    }
}

__device__ __forceinline__ void p8_swa(Frame& F) {
    const int lane = F.lane, gw = F.bid * NWAVES + F.wave, NGW = F.G * NWAVES;
    LAS float* bt = (LAS float*)(F.lds + 16384);
    LAS float* qs = (LAS float*)(F.lds + F.wave * 1024);
    LAS float* ps = qs + 64;
    const float* rel_bias = F.in[1]; const float* sinks = F.in[11];
    const hbits* QKV = (const hbits*)(F.ws + WS_QKV1); hbits* OB = (hbits*)(F.ws + WS_OB);
    for (int i = F.tid; i < 128 * 16; i += NTHREADS) bt[i] = rel_bias[(int)BUCKET_TAB[i >> 4] * 16 + (i & 15)];
    __syncthreads();
    for (int item = gw; item < M * NH; item += NGW) {
        const int tok = item >> 4, h = item & 15, b = tok >> 11, t = tok & (T - 1), kvh = h >> 3;
        qs[lane] = (float)__builtin_bit_cast(f16, QKV[(size_t)tok * B_IN + h * 64 + lane]);
        LDS_WAIT(); asm volatile("" ::: "memory");
        float l[2];
#pragma unroll
        for (int jj = 0; jj < 2; ++jj) { const int j = lane + 64 * jj, s = t - (WIN - 1) + j; float v = -INFINITY;
            if (s >= 0) { const hbits* kr = QKV + ((size_t)b * T + s) * B_IN + 1024 + kvh * 64; float d = 0.f;
#pragma unroll
                for (int c = 0; c < 8; ++c) { const f16x8 k8 = __builtin_bit_cast(f16x8, *(const v4u*)(kr + 8 * c));
#pragma unroll
                    for (int e = 0; e < 8; ++e) d = fmaf((float)k8[e], qs[c * 8 + e], d); }
                v = d * 0.125f + bt[(WIN - 1 - j) * 16 + h]; }
            l[jj] = v; }
        const float sink = sinks[h];
        float mx = fmaxf(wave_max(fmaxf(l[0], l[1])), sink);
        const float p0 = (l[0] == -INFINITY) ? 0.f : __expf(l[0] - mx), p1 = (l[1] == -INFINITY) ? 0.f : __expf(l[1] - mx);
        const float den = wave_sum(p0 + p1) + __expf(sink - mx); const float inv = 1.0f / den;
        ps[lane] = p0 * inv; ps[lane + 64] = p1 * inv;
        LDS_WAIT(); asm volatile("" ::: "memory");
        float o = 0.f; const int j0 = (t >= WIN - 1) ? 0 : (WIN - 1 - t);
        for (int j = j0; j < WIN; ++j) { const int s = t - (WIN - 1) + j;
            o = fmaf(ps[j], (float)__builtin_bit_cast(f16, QKV[((size_t)b * T + s) * B_IN + 1152 + kvh * 64 + lane]), o); }
        OB[(size_t)tok * D + h * 64 + lane] = __builtin_bit_cast(hbits, (f16)o);
        LDS_WAIT(); asm volatile("" ::: "memory");
    }
}

__device__ __forceinline__ void p12_final(Frame& F) {
    const int gw = F.bid * NWAVES + F.wave, NGW = F.G * NWAVES; const float* g = F.in[4];
    for (int m = gw; m < M; m += NGW) {
        GAS f32x4* xr = (GAS f32x4*)(F.out + (size_t)m * D) + F.lane;
        f32x4 v[4]; float s = 0.f;
#pragma unroll
        for (int j = 0; j < 4; ++j) { v[j] = xr[64 * j]; s += (v[j].x * v[j].x + v[j].y * v[j].y) + (v[j].z * v[j].z + v[j].w * v[j].w); }
        const float r = 1.0f / sqrtf(wave_sum(s) * (1.0f / D) + pg8::RMS_EPS);
#pragma unroll
        for (int j = 0; j < 4; ++j) { const f32x4 gv = *((const f32x4*)g + F.lane + 64 * j); xr[64 * j] = v[j] * r * gv; }
    }
}

struct Args { const float* in[16]; float* out; unsigned char* ws; int ph_lo, ph_hi; };
template <bool COOP>
__global__ void __launch_bounds__(NTHREADS, 2) fwd(Args args) {
    extern __shared__ __attribute__((aligned(16))) unsigned char lds[];
    Frame F;
    F.lds = (LAS unsigned char*)lds; F.tid = threadIdx.x; F.lane = F.tid & 63; F.wave = __builtin_amdgcn_readfirstlane(F.tid >> 6);
    F.G = gridDim.x; F.bid = blockIdx.x;
#pragma unroll
    for (int i = 0; i < 16; ++i) F.in[i] = args.in[i];
    F.out = args.out; F.ws = args.ws;
    unsigned char* ws = args.ws;
    const int lo = args.ph_lo, hi = args.ph_hi;
#define IN(k) (lo <= (k) && (k) < hi)
#define SEAM(k) do { if constexpr (COOP) { if (IN(k) && IN((k) + 1)) cg::this_grid().sync(); } } while (0)
    typedef pg8::bf16_t hb;
    float* SS1 = (float*)(ws + WS_SS1); float* SS2 = (float*)(ws + WS_SS2); float* SS3 = (float*)(ws + WS_SS3);
    hb* XH = (hb*)(ws + WS_XH);

    if (IN(0)) { p0_prologue(F); } SEAM(0);
    if (IN(1)) {
        pg8::Gemm g{XH, (const hb*)(ws + WS_WA), M, A_PAD, D}; pg8::StaticOrder S; S.init(M, A_PAD, F.G, F.bid);
        pg8::EpiInA E{(const float*)(ws + WS_RS0), (hb*)(ws + WS_QL), (float*)(ws + WS_CKV), (hb*)(ws + WS_QI), (hb*)(ws + WS_KI), (float*)(ws + WS_WI)};
        pg8::gemm_phase<pg8::EpiInA, pg8::StaticOrder, true, true>(F.lds, g, S, E);
    } SEAM(1);
    if (IN(2)) { p2_indexer(F); } SEAM(2);
    if (IN(3)) { p3_sparse_attn(F); } SEAM(3);
    if (IN(4)) {
        pg8::Gemm g{(const hb*)(ws + WS_QL), (const hb*)(ws + WS_WCT), M, D, NH * RL}; pg8::StaticOrder S; S.init(M, D, F.G, F.bid);
        pg8::EpiRes E{F.in[0], F.out, XH, SS1, nullptr};
        pg8::gemm_phase<pg8::EpiRes, pg8::StaticOrder, true, true>(F.lds, g, S, E);
    } SEAM(4);
    if (IN(5)) {
        pg8::Gemm g{XH, (const hb*)(ws + WS_WGU0), M, 2 * FF, D}; pg8::StaticOrder S; S.init(M, 2 * FF, F.G, F.bid);
        pg8::EpiGU E{SS1, (hb*)(ws + WS_HB)};
        pg8::gemm_phase<pg8::EpiGU, pg8::StaticOrder, true, true>(F.lds, g, S, E);
    } SEAM(5);
    if (IN(6)) {
        pg8::Gemm g{(const hb*)(ws + WS_HB), (const hb*)(ws + WS_WD0), M, D, FF}; pg8::StaticOrder S; S.init(M, D, F.G, F.bid);
        pg8::EpiRes E{F.out, F.out, XH, SS2, nullptr};
        pg8::gemm_phase<pg8::EpiRes, pg8::StaticOrder, true, true>(F.lds, g, S, E);
    } SEAM(6);
    if (IN(7)) {
        pg8::Gemm g{XH, (const hb*)(ws + WS_WB), M, B_IN, D}; pg8::StaticOrder S; S.init(M, B_IN, F.G, F.bid);
        pg8::EpiInB E{SS2, F.in[10], (hb*)(ws + WS_QKV1)};
        pg8::gemm_phase<pg8::EpiInB, pg8::StaticOrder, true, true>(F.lds, g, S, E);
    } SEAM(7);
    if (IN(8)) { p8_swa(F); } SEAM(8);
    if (IN(9)) {
        pg8::Gemm g{(const hb*)(ws + WS_OB), (const hb*)(ws + WS_WBO), M, D, D}; pg8::StaticOrder S; S.init(M, D, F.G, F.bid);
        pg8::EpiRes E{F.out, F.out, XH, SS3, F.in[13]};
        pg8::gemm_phase<pg8::EpiRes, pg8::StaticOrder, true, true>(F.lds, g, S, E);
    } SEAM(9);
    if (IN(10)) {
        pg8::Gemm g{XH, (const hb*)(ws + WS_WGU1), M, 2 * FF, D}; pg8::StaticOrder S; S.init(M, 2 * FF, F.G, F.bid);
        pg8::EpiGU E{SS3, (hb*)(ws + WS_HB)};
        pg8::gemm_phase<pg8::EpiGU, pg8::StaticOrder, true, true>(F.lds, g, S, E);
    } SEAM(10);
    if (IN(11)) {
        pg8::Gemm g{(const hb*)(ws + WS_HB), (const hb*)(ws + WS_WD1), M, D, FF}; pg8::StaticOrder S; S.init(M, D, F.G, F.bid);
        pg8::EpiRes E{F.out, F.out, XH, SS1, nullptr};
        pg8::gemm_phase<pg8::EpiRes, pg8::StaticOrder, true, true>(F.lds, g, S, E);
    } SEAM(11);
    if (IN(12)) { p12_final(F); }
#undef IN
#undef SEAM
}

extern "C" void kernel_launch(void* const* d_in, const int* in_sizes, int n_in, void* d_out, int out_size, void* d_ws, size_t ws_size, hipStream_t stream) {
    static int grid = 0;
    if (grid == 0) {
        if (n_in != 16 || in_sizes[0] != M * D || out_size != M * D || ws_size < WS_END) { fprintf(stderr, "kernel_launch: unexpected shapes (n_in %d, in0 %d, out %d, ws %zu)\n", n_in, n_in > 0 ? in_sizes[0] : -1, out_size, ws_size); grid = -1; return; }
        int dev = 0, cus = 0, per_cu = 0;
        if (hipGetDevice(&dev) != hipSuccess || hipDeviceGetAttribute(&cus, hipDeviceAttributeMultiprocessorCount, dev) != hipSuccess) { grid = -1; return; }
        const void* fn = MK_ONE_LAUNCH ? (const void*)fwd<true> : (const void*)fwd<false>;
        if (hipFuncSetAttribute(fn, hipFuncAttributeMaxDynamicSharedMemorySize, LDS_BYTES) != hipSuccess) { fprintf(stderr, "kernel_launch: hipFuncSetAttribute failed\n"); grid = -1; return; }
        if (hipOccupancyMaxActiveBlocksPerMultiprocessor(&per_cu, fn, NTHREADS, LDS_BYTES) != hipSuccess || per_cu < 1) { fprintf(stderr, "kernel_launch: occupancy query says %d blocks per CU\n", per_cu); per_cu = 1; }
        (void)hipGetLastError();
        grid = cus;
    }
    if (grid < 0) return;
    (void)hipMemsetAsync((char*)d_ws + WS_CTL, 0, CTL_ZERO_BYTES, stream);
    Args a{};
    for (int i = 0; i < 16; ++i) a.in[i] = (const float*)d_in[i];
    a.out = (float*)d_out; a.ws = (unsigned char*)d_ws;
#if MK_ONE_LAUNCH
    a.ph_lo = 0; a.ph_hi = N_PHASES;
    void* kargs[] = {&a};
    hipError_t e = hipLaunchCooperativeKernel((const void*)fwd<true>, dim3(grid), dim3(NTHREADS), kargs, LDS_BYTES, stream);
    if (e != hipSuccess) fprintf(stderr, "cooperative launch failed: %s (grid %d)\n", hipGetErrorString(e), grid);
#else
    for (int p = 0; p < N_PHASES; ++p) { a.ph_lo = p; a.ph_hi = p + 1; hipLaunchKernelGGL(fwd<false>, dim3(grid), dim3(NTHREADS), LDS_BYTES, stream, a); }
#endif
}
```

```cpp
#include <hip/hip_runtime.h>
#include <hip/hip_cooperative_groups.h>
#include <cstdio>
#include <cstdint>
namespace cg = cooperative_groups;

typedef _Float16 f16x8 __attribute__((ext_vector_type(8)));
typedef _Float16 f16x2 __attribute__((ext_vector_type(2)));
typedef _Float16 f16;
namespace pg8 {
#define PG8_LAS __attribute__((address_space(3)))
typedef unsigned short bf16_t;
typedef short bf16x8 __attribute__((ext_vector_type(8)));
typedef float f32x4 __attribute__((ext_vector_type(4)));
typedef unsigned u32x4 __attribute__((ext_vector_type(4)));
constexpr int BM = 256, BK = 64, HALF = 128, HTB = HALF * BK * 2  , STAGE_BYTES = 8 * HTB, NXCD = 8, WGM = 8;

__host__ __device__ __forceinline__ int lds_byte(int r, int c) { const int st = (r >> 4) * 2 + (c >> 5), rr = r & 15, cc = c & 31, ob = rr * 64 + cc * 2; return st * 1024 + (ob ^ (((ob >> 9) & 1) << 5)); }
__host__ __device__ __forceinline__ void stage_rc(int b, int& R, int& C) { const int st = b / 1024, sb = b % 1024, swz = sb ^ (((sb >> 9) & 1) << 5); R = (st >> 1) * 16 + swz / 64; C = (st & 1) * 32 + (swz % 64) / 2; }
__host__ __device__ __forceinline__ int perm32(int rho) { const int n = rho >> 4, i = rho & 15; return 8 * (i >> 2) + 4 * n + (i & 3); }

struct Unit { int pm, pn; };
struct Gemm { const bf16_t* A; const bf16_t* Bt; int M, N, K; };

struct StaticOrder {
    int nM, nN, nwg, G, c;
    __host__ __device__ void init(int M, int N, int G_, int c_) { nM = M / BM; nN = N / BM; nwg = nM * nN; G = G_; c = c_; }
    __host__ __device__ bool next(int i, Unit& u) const {
        const long L = (long)i * G + c; if (L >= nwg) return false;
        int wgid = (int)L; { const int q = nwg / NXCD, r = nwg % NXCD, xcd = wgid % NXCD, off = wgid / NXCD; wgid = (xcd < r ? xcd * (q + 1) : r * (q + 1) + (xcd - r) * q) + off; }
        const int nig = WGM * nN, gid = wgid / nig, fm = gid * WGM, gsz = (nM - fm) < WGM ? (nM - fm) : WGM;
        u.pm = fm + ((wgid % nig) % gsz); u.pn = (wgid % nig) / gsz; return true;
    }
    __device__ __forceinline__ void a_ready(const Unit&) const {}
    __device__ __forceinline__ void done(const Unit&) const {}
};

__device__ __forceinline__ unsigned pk2h(float lo, float hi) { f16x2 v = {(_Float16)lo, (_Float16)hi}; return __builtin_bit_cast(unsigned, v); }
__device__ __forceinline__ u32x4 pk8h(f32x4 a, f32x4 b) { u32x4 w; w.x = pk2h(a[0], a[1]); w.y = pk2h(a[2], a[3]); w.z = pk2h(b[0], b[1]); w.w = pk2h(b[2], b[3]); return w; }
constexpr float RMS_EPS = 1e-6f;
constexpr float LOG2E = 1.4426950408889634f, QSCALE = 0.08838834764831845f * 1.4426950408889634f;

struct EpiInA {
    static constexpr bool PERM = true, AFTER_DRAIN = false;
    const float* rs; bf16_t* QL; float* CKV; bf16_t* QI; bf16_t* KI; float* WI;
    __device__ __forceinline__ void operator()(const f32x4 (&acc)[2][2][4][2], const Unit& u, int wr, int wc, int fr, int fq) const {
        const int row0 = u.pm * BM + wr * 64 + fr;
#pragma unroll
        for (int ai = 0; ai < 2; ++ai)
#pragma unroll
            for (int m = 0; m < 4; ++m) { const int row = row0 + ai * HALF + m * 16; const float r = rs[row];
#pragma unroll
                for (int bj = 0; bj < 2; ++bj) { const int col = u.pn * BM + bj * HALF + wc * 32 + 8 * fq;
                    f32x4 v0 = acc[ai][bj][m][0] * r, v1 = acc[ai][bj][m][1] * r;
                    if (col < 2048) { v0 = v0 * QSCALE; v1 = v1 * QSCALE; *(u32x4*)(QL + (size_t)row * 2048 + col) = pk8h(v0, v1); }
                    else if (col < 2176) { float* p = CKV + (size_t)row * 128 + (col - 2048); *(f32x4*)p = v0; *(f32x4*)(p + 4) = v1; }
                    else if (col < 2688) { v0 = v0 * 0.125f; v1 = v1 * 0.125f; *(u32x4*)(QI + (size_t)row * 512 + (col - 2176)) = pk8h(v0, v1); }
                    else if (col < 2752) { *(u32x4*)(KI + (size_t)row * 64 + (col - 2688)) = pk8h(v0, v1); }
                    else if (col < 2760) { const float s = 0.35355339059327373f; float* p = WI + (size_t)row * 8; *(f32x4*)p = v0 * s; *(f32x4*)(p + 4) = v1 * s; }
                } }
    }
};
struct EpiRes {
    static constexpr bool PERM = true, AFTER_DRAIN = false;
    const float* xold; float* xnew; bf16_t* xh; float* ss; const float* bias;
    __device__ __forceinline__ void operator()(const f32x4 (&acc)[2][2][4][2], const Unit& u, int wr, int wc, int fr, int fq) const {
        const int row0 = u.pm * BM + wr * 64 + fr;
#pragma unroll
        for (int ai = 0; ai < 2; ++ai)
#pragma unroll
            for (int m = 0; m < 4; ++m) { const int row = row0 + ai * HALF + m * 16; float sq = 0.f;
#pragma unroll
                for (int bj = 0; bj < 2; ++bj) { const int col = u.pn * BM + bj * HALF + wc * 32 + 8 * fq; const size_t off = (size_t)row * 1024 + col;
                    f32x4 v0 = acc[ai][bj][m][0] + *(const f32x4*)(xold + off), v1 = acc[ai][bj][m][1] + *(const f32x4*)(xold + off + 4);
                    if (bias) { v0 = v0 + *(const f32x4*)(bias + col); v1 = v1 + *(const f32x4*)(bias + col + 4); }
                    *(f32x4*)(xnew + off) = v0; *(f32x4*)(xnew + off + 4) = v1;
                    *(u32x4*)(xh + off) = pk8h(v0, v1);
                    sq += (v0[0] * v0[0] + v0[1] * v0[1]) + (v0[2] * v0[2] + v0[3] * v0[3]) + (v1[0] * v1[0] + v1[1] * v1[1]) + (v1[2] * v1[2] + v1[3] * v1[3]); }
                sq += __shfl_xor(sq, 16); sq += __shfl_xor(sq, 32);
                if (fq == 0) atomicAdd(ss + row, sq); }
    }
};
struct EpiGU {
    static constexpr bool PERM = true, AFTER_DRAIN = false;
    const float* ss; bf16_t* HB;
    __device__ __forceinline__ void operator()(const f32x4 (&acc)[2][2][4][2], const Unit& u, int wr, int wc, int fr, int fq) const {
        const int row0 = u.pm * BM + wr * 64 + fr; const int col = u.pn * HALF + wc * 32 + 8 * fq;
#pragma unroll
        for (int ai = 0; ai < 2; ++ai)
#pragma unroll
            for (int m = 0; m < 4; ++m) { const int row = row0 + ai * HALF + m * 16; const float r = 1.0f / sqrtf(ss[row] * (1.0f / 1024.0f) + RMS_EPS);
                f32x4 hv[2];
#pragma unroll
                for (int n = 0; n < 2; ++n)
#pragma unroll
                    for (int j = 0; j < 4; ++j) { const float g = acc[ai][0][m][n][j] * r, uu = acc[ai][1][m][n][j] * r;
                        hv[n][j] = g * __builtin_amdgcn_rcpf(1.0f + __builtin_amdgcn_exp2f(-1.4426950408889634f * g)) * uu; }
                *(u32x4*)(HB + (size_t)row * 2816 + col) = pk8h(hv[0], hv[1]); }
    }
};
struct EpiInB {
    static constexpr bool PERM = true, AFTER_DRAIN = false;
    const float* ss; const float* bias; bf16_t* QKV;
    __device__ __forceinline__ void operator()(const f32x4 (&acc)[2][2][4][2], const Unit& u, int wr, int wc, int fr, int fq) const {
        const int row0 = u.pm * BM + wr * 64 + fr;
#pragma unroll
        for (int ai = 0; ai < 2; ++ai)
#pragma unroll
            for (int m = 0; m < 4; ++m) { const int row = row0 + ai * HALF + m * 16; const float r = 1.0f / sqrtf(ss[row] * (1.0f / 1024.0f) + RMS_EPS);
#pragma unroll
                for (int bj = 0; bj < 2; ++bj) { const int col = u.pn * BM + bj * HALF + wc * 32 + 8 * fq;
                    f32x4 v0 = acc[ai][bj][m][0] * r + *(const f32x4*)(bias + col), v1 = acc[ai][bj][m][1] * r + *(const f32x4*)(bias + col + 4);
                    if (col < 1024) { v0 = v0 * (0.125f * LOG2E); v1 = v1 * (0.125f * LOG2E); }
                    *(u32x4*)(QKV + (size_t)row * 1280 + col) = pk8h(v0, v1); } }
    }
};

template <class Epi, class Sched, bool ALIGN_EPI = false, bool SP2 = false>
__device__ __forceinline__ void gemm_phase(PG8_LAS unsigned char* lds, const Gemm g, const Sched& S, const Epi& E) {
    const int tid = threadIdx.x, wid = __builtin_amdgcn_readfirstlane(tid >> 6), lane = tid & 63, wr = wid >> 2, wc = wid & 3, fr = lane & 15, fq = lane >> 4;
    const int K = g.K, nt = K / BK;
    unsigned voffA[2], voffB[2];
#pragma unroll
    for (int i = 0; i < 2; ++i) { int R, C; stage_rc(tid * 16 + i * 8192, R, C); const int Rb = Epi::PERM ? ((R & ~31) + perm32(R & 31)) : R;
        voffA[i] = (unsigned)(R * K + C) * 2u; voffB[i] = (unsigned)(Rb * K + C) * 2u; }
    const size_t kstep = (size_t)(BK * 2);
    const size_t hstep = (size_t)HALF * K * 2;
    const size_t tstep = 2 * hstep;
    const unsigned ldsw = (unsigned)wid * 1024u;
    const int aoff = lds_byte(wr * 64 + fr, fq * 8), boff = lds_byte(wc * 32 + fr, fq * 8);
#define PG8_SA(b, h) (((b) * 2 + (h)) * HTB)
#define PG8_SB(b, h) ((4 + (b) * 2 + (h)) * HTB)
#define PG8_STAGE(bufoff, gbase, voff) do { _Pragma("unroll") for (int _i = 0; _i < 2; ++_i) \
        __builtin_amdgcn_global_load_lds((const unsigned*)((const char*)(gbase) + (voff)[_i]), (PG8_LAS unsigned*)(lds + (bufoff) + ldsw + _i * 8192), 16, 0, 0); } while (0)
#define PG8_LDA(dst, b, h) do { _Pragma("unroll") for (int m = 0; m < 4; ++m) _Pragma("unroll") for (int k = 0; k < 2; ++k) dst[m][k] = *(const PG8_LAS bf16x8*)(lds + PG8_SA(b, h) + aoff + m * 2048 + k * 1024); } while (0)
#define PG8_LDB(dst, b, h) do { _Pragma("unroll") for (int n = 0; n < 2; ++n) _Pragma("unroll") for (int k = 0; k < 2; ++k) dst[n][k] = *(const PG8_LAS bf16x8*)(lds + PG8_SB(b, h) + boff + n * 2048 + k * 1024); } while (0)
#define PG8_MMA(ai, bj, At, Bt) do { __builtin_amdgcn_s_setprio(1); _Pragma("unroll") for (int m = 0; m < 4; ++m) _Pragma("unroll") for (int n = 0; n < 2; ++n) _Pragma("unroll") for (int k = 0; k < 2; ++k) \
        acc[ai][bj][m][n] = __builtin_amdgcn_mfma_f32_16x16x32_f16(__builtin_bit_cast(f16x8, Bt[n][k]), __builtin_bit_cast(f16x8, At[m][k]), acc[ai][bj][m][n], 0, 0, 0); __builtin_amdgcn_s_setprio(0); } while (0)
#define PG8_WAIT_V(n) asm volatile("s_waitcnt vmcnt(" #n ")" ::: "memory")
#define PG8_WAIT_L(n) asm volatile("s_waitcnt lgkmcnt(" #n ")" ::: "memory")
#define PG8_BAR __builtin_amdgcn_s_barrier()
#define PG8_SCHED __builtin_amdgcn_sched_barrier(0)
    Unit cur, nxt; int ui = 0;
    if (!S.next(0, cur)) return;
    f32x4 acc[2][2][4][2];
#pragma unroll
    for (int a = 0; a < 2; ++a)
#pragma unroll
        for (int b = 0; b < 2; ++b)
#pragma unroll
            for (int m = 0; m < 4; ++m)
#pragma unroll
                for (int n = 0; n < 2; ++n) acc[a][b][m][n] = (f32x4){0.f, 0.f, 0.f, 0.f};
    bf16x8 At[4][2], B0[2][2], B1[2][2];
    const char* cA = (const char*)g.A + (size_t)cur.pm * tstep; const char* cB = (const char*)g.Bt + (size_t)cur.pn * tstep;
    S.a_ready(cur);
    if constexpr (SP2) {
        PG8_STAGE(PG8_SB(0, 0), cB, voffB); PG8_STAGE(PG8_SB(0, 1), cB + hstep, voffB); PG8_STAGE(PG8_SA(0, 0), cA, voffA); PG8_STAGE(PG8_SA(0, 1), cA + hstep, voffA);
        if (wr == 1) PG8_BAR;
        PG8_WAIT_V(2); PG8_BAR;
        PG8_STAGE(PG8_SB(1, 0), cB + kstep, voffB); PG8_STAGE(PG8_SA(1, 0), cA + kstep, voffA); PG8_STAGE(PG8_SB(1, 1), cB + hstep + kstep, voffB);
        PG8_WAIT_V(6); PG8_BAR;
    } else {
        PG8_STAGE(PG8_SB(0, 0), cB, voffB); PG8_STAGE(PG8_SA(0, 0), cA, voffA); PG8_STAGE(PG8_SB(0, 1), cB + hstep, voffB); PG8_STAGE(PG8_SA(0, 1), cA + hstep, voffA);
        if (wr == 1) PG8_BAR;
        PG8_WAIT_V(4); PG8_BAR;
        PG8_STAGE(PG8_SB(1, 0), cB + kstep, voffB); PG8_STAGE(PG8_SA(1, 0), cA + kstep, voffA); PG8_STAGE(PG8_SB(1, 1), cB + hstep + kstep, voffB);
        PG8_WAIT_V(6); PG8_BAR;
    }
    for (;;) {
        const bool has_next = S.next(ui + 1, nxt);
        const char* nA = has_next ? (const char*)g.A + (size_t)nxt.pm * tstep : cA; const char* nB = has_next ? (const char*)g.Bt + (size_t)nxt.pn * tstep : cB;
        for (int t = 0; t < nt; t += 2) {
            const bool last = (t == nt - 2);
            const char* a1 = cA + (size_t)(t + 1) * kstep;
            const char* a2 = last ? nA : cA + (size_t)(t + 2) * kstep; const char* b2 = last ? nB : cB + (size_t)(t + 2) * kstep;
            const char* a3 = a2 + kstep; const char* b3 = b2 + kstep;
            if (last && has_next) S.a_ready(nxt);
            if constexpr (SP2) {
            PG8_LDB(B0, 0, 0); PG8_LDB(B1, 0, 1); PG8_SCHED; PG8_LDA(At, 0, 0); PG8_STAGE(PG8_SA(1, 1), a1 + hstep, voffA);
            PG8_WAIT_V(8); PG8_WAIT_L(0); PG8_BAR; PG8_MMA(0, 0, At, B0); PG8_MMA(0, 1, At, B1); PG8_BAR; PG8_SCHED;
            PG8_LDA(At, 0, 1); PG8_STAGE(PG8_SB(0, 0), b2, voffB); PG8_STAGE(PG8_SB(0, 1), b2 + hstep, voffB); PG8_STAGE(PG8_SA(0, 0), a2, voffA);
            PG8_WAIT_V(8); PG8_WAIT_L(0); PG8_BAR; PG8_MMA(1, 0, At, B0); PG8_MMA(1, 1, At, B1); PG8_BAR; PG8_SCHED;
            PG8_LDB(B0, 1, 0); PG8_LDB(B1, 1, 1); PG8_SCHED; PG8_LDA(At, 1, 0); PG8_STAGE(PG8_SA(0, 1), a2 + hstep, voffA);
            PG8_WAIT_V(8); PG8_WAIT_L(0); PG8_BAR; PG8_MMA(0, 0, At, B0); PG8_MMA(0, 1, At, B1); PG8_BAR; PG8_SCHED;
            PG8_LDA(At, 1, 1); PG8_STAGE(PG8_SB(1, 0), b3, voffB); PG8_STAGE(PG8_SB(1, 1), b3 + hstep, voffB); PG8_STAGE(PG8_SA(1, 0), a3, voffA);
            PG8_WAIT_V(8); PG8_WAIT_L(0); PG8_BAR; PG8_MMA(1, 0, At, B0); PG8_MMA(1, 1, At, B1); PG8_BAR; PG8_SCHED;
            } else {
            PG8_LDB(B0, 0, 0); PG8_SCHED; PG8_LDA(At, 0, 0); PG8_STAGE(PG8_SA(1, 1), a1 + hstep, voffA);
            PG8_WAIT_L(8); PG8_BAR; PG8_WAIT_L(0); PG8_MMA(0, 0, At, B0); PG8_BAR; PG8_SCHED;
            PG8_LDB(B1, 0, 1); PG8_STAGE(PG8_SB(0, 0), b2, voffB);
            PG8_BAR; PG8_WAIT_L(0); PG8_MMA(0, 1, At, B1); PG8_BAR;
            PG8_LDA(At, 0, 1); PG8_STAGE(PG8_SA(0, 0), a2, voffA);
            PG8_BAR; PG8_WAIT_L(0); PG8_MMA(1, 0, At, B0); PG8_BAR; PG8_SCHED;
            PG8_STAGE(PG8_SB(0, 1), b2 + hstep, voffB);
            PG8_WAIT_V(6); PG8_BAR; PG8_MMA(1, 1, At, B1); PG8_BAR;
            PG8_LDB(B0, 1, 0); PG8_SCHED; PG8_LDA(At, 1, 0); PG8_STAGE(PG8_SA(0, 1), a2 + hstep, voffA);
            PG8_WAIT_L(8); PG8_BAR; PG8_WAIT_L(0); PG8_MMA(0, 0, At, B0); PG8_BAR; PG8_SCHED;
            PG8_LDB(B1, 1, 1); PG8_STAGE(PG8_SB(1, 0), b3, voffB);
            PG8_BAR; PG8_WAIT_L(0); PG8_MMA(0, 1, At, B1); PG8_BAR;
            PG8_LDA(At, 1, 1); PG8_STAGE(PG8_SA(1, 0), a3, voffA);
            PG8_BAR; PG8_WAIT_L(0); PG8_MMA(1, 0, At, B0); PG8_BAR; PG8_SCHED;
            PG8_STAGE(PG8_SB(1, 1), b3 + hstep, voffB);
            PG8_WAIT_V(6); PG8_BAR; PG8_MMA(1, 1, At, B1); PG8_BAR;
            }
        }
        if constexpr (ALIGN_EPI) { if (wr == 0) PG8_BAR; }
        if constexpr (!Epi::AFTER_DRAIN) { E(acc, cur, wr, wc, fr, fq); S.done(cur); }
        if (!has_next) break;
#pragma unroll
        for (int a = 0; a < 2; ++a)
#pragma unroll
            for (int b = 0; b < 2; ++b)
#pragma unroll
                for (int m = 0; m < 4; ++m)
#pragma unroll
                    for (int n = 0; n < 2; ++n) acc[a][b][m][n] = (f32x4){0.f, 0.f, 0.f, 0.f};
        cur = nxt; cA = nA; cB = nB; ++ui;
        if constexpr (ALIGN_EPI) { if (wr == 1) PG8_BAR; }
    }
    PG8_WAIT_V(0);
    if constexpr (!ALIGN_EPI) { if (wr == 0) PG8_BAR; }
    PG8_BAR;
    if constexpr (Epi::AFTER_DRAIN) { E.fused(acc, cur, wr, wc, fr, fq, lds, wid, lane); S.done(cur); }
#undef PG8_SA
#undef PG8_SB
#undef PG8_STAGE
#undef PG8_LDA
#undef PG8_LDB
#undef PG8_MMA
#undef PG8_WAIT_V
#undef PG8_WAIT_L
#undef PG8_BAR
#undef PG8_SCHED
}
}

constexpr int NB = 8, T = 2048, D = 1024, M = NB * T, NH = 16, RL = 128, VH = 64, HI = 8, DI = 64, KSEL = 256;
constexpr int A_IN = 2760, A_PAD = 2816, B_IN = 1280, FF = 2816, WIN = 128;
constexpr int NWAVES = 8, NTHREADS = NWAVES * 64;
constexpr int N_PHASES = 13;
#ifndef MK_ONE_LAUNCH
#define MK_ONE_LAUNCH 1
#endif
constexpr size_t MiB = 1u << 20;
constexpr size_t WS_CTL = 0, CTL_ZERO_BYTES = 1 * MiB;
constexpr size_t WS_SS1 = 256 * 1024, WS_SS2 = 320 * 1024, WS_SS3 = 384 * 1024;
constexpr size_t WS_RS0 = 1 * MiB;
constexpr size_t WS_WA = 2 * MiB, WS_WUV = WS_WA + (size_t)A_PAD * D * 2, WS_WAO = 8 * MiB, WS_WGU0 = 10 * MiB, WS_WGU1 = 21 * MiB, WS_WD0 = 32 * MiB,
                 WS_WD1 = WS_WD0 + (size_t)D * FF * 2, WS_WB = 43 * MiB, WS_WBO = 46 * MiB;
constexpr size_t WS_XH = 50 * MiB;
constexpr size_t WS_QL = 82 * MiB, WS_CKV = 146 * MiB, WS_CKVN = 154 * MiB, WS_QI = 158 * MiB, WS_KI = 174 * MiB, WS_WI = 176 * MiB, WS_IDX = 178 * MiB, WS_OV = 186 * MiB;
constexpr size_t WS_HB = 82 * MiB, WS_QKV1 = 170 * MiB, WS_OB = 210 * MiB, WS_WCT = 242 * MiB, WS_END = 246 * MiB;
static_assert(WS_WUV + 16 * 64 * 128 * 2 <= WS_WAO && WS_WD1 + (size_t)D * FF * 2 <= WS_WB && WS_WB + (size_t)B_IN * D * 2 <= WS_WBO && WS_WBO + 2 * MiB <= WS_XH, "weights map");
static_assert(WS_HB + (size_t)M * FF * 2 <= WS_QKV1 && WS_QKV1 + (size_t)M * B_IN * 2 <= WS_OB && WS_OB + (size_t)M * D * 2 <= WS_WCT, "activation map");
constexpr int LDS_BYTES = 147456;

#define GAS __attribute__((address_space(1)))
#define LAS __attribute__((address_space(3)))
typedef unsigned v4u __attribute__((ext_vector_type(4)));
typedef float f32x4 __attribute__((ext_vector_type(4)));
typedef unsigned short hbits;
using pg8::pk2h;

__device__ const unsigned char BUCKET_TAB[129] = {0,1,2,3,4,5,6,7,8,9,10,11,12,13,14,15,16,16,16,17,17,18,18,18,19,19,19,20,20,20,20,21,21,21,21,22,22,22,22,22,23,23,23,23,23,23,24,24,24,24,24,24,25,25,25,25,25,25,25,26,26,26,26,26,26,26,26,27,27,27,27,27,27,27,27,27,27,28,28,28,28,28,28,28,28,28,28,29,29,29,29,29,29,29,29,29,29,29,29,30,30,30,30,30,30,30,30,30,30,30,30,30,30,31,31,31,31,31,31,31,31,31,31,31,31,31,31,31,31};

__device__ __forceinline__ float wave_sum(float v) {
#pragma unroll
    for (int o = 1; o < 64; o <<= 1) v += __shfl_xor(v, o);
    return v;
}
__device__ __forceinline__ float wave_max(float v) {
#pragma unroll
    for (int o = 1; o < 64; o <<= 1) v = fmaxf(v, __shfl_xor(v, o));
    return v;
}
#define LDS_WAIT() asm volatile("s_waitcnt lgkmcnt(0)" ::: "memory")

struct Frame {
    LAS unsigned char* lds;
    int tid, lane, wave, G, bid;
    const float* in[16]; float* out; unsigned char* ws;
};

__device__ __forceinline__ void tr_item(const float* W, int ldw, int nvalid, const float* gain, hbits* WT, int K, int k0, int n0s, int n0d, LAS float* scr, int lane) {
#pragma unroll 8
    for (int i = 0; i < 32; ++i) { const int kk = 2 * i + (lane >> 5), n = n0s + (lane & 31);
        float v = (n < nvalid) ? W[(size_t)(k0 + kk) * ldw + n] : 0.f; if (gain) v *= gain[k0 + kk]; scr[kk * 33 + (lane & 31)] = v; }
    LDS_WAIT(); asm volatile("" ::: "memory");
    const int c = lane & 7;
#pragma unroll
    for (int j = 0; j < 4; ++j) { const int n = (lane >> 3) + 8 * j; const LAS float* s = scr + (8 * c) * 33 + n;
        v4u o; o.x = pk2h(s[0 * 33], s[1 * 33]); o.y = pk2h(s[2 * 33], s[3 * 33]); o.z = pk2h(s[4 * 33], s[5 * 33]); o.w = pk2h(s[6 * 33], s[7 * 33]);
        *(GAS v4u*)(WT + (size_t)(n0d + n) * K + k0 + 8 * c) = o; }
    LDS_WAIT(); asm volatile("" ::: "memory");
}
__device__ __forceinline__ void p0_prologue(Frame& F) {
    LAS float* scr = (LAS float*)(F.lds + F.wave * 16384);
    const int gw = F.bid * NWAVES + F.wave, NGW = F.G * NWAVES;
    hbits* WA = (hbits*)(F.ws + WS_WA); hbits* WUV = (hbits*)(F.ws + WS_WUV); hbits* WAO = (hbits*)(F.ws + WS_WAO);
    hbits* WB = (hbits*)(F.ws + WS_WB); hbits* WBO = (hbits*)(F.ws + WS_WBO);
    constexpr int I_WA = 16 * (A_PAD / 32), I_UV = 64, I_SQ = 16 * 32, I_GU = 16 * (2 * FF / 32), I_D = (FF / 64) * 32, I_WB = 16 * (B_IN / 32);
    constexpr int NITEMS = I_WA + I_UV + I_SQ + 2 * I_GU + 2 * I_D + I_WB + I_SQ;
    for (int it = gw; it < NITEMS; it += NGW) {
        int r = it;
        if (r < I_WA) { const int nnb = A_PAD / 32, kb = r / nnb, nb = r % nnb; tr_item(F.in[5], A_IN, A_IN, F.in[2], WA, D, 64 * kb, 32 * nb, 32 * nb, scr, F.lane); continue; } r -= I_WA;
        if (r < I_UV) { const int h = r >> 2, kb = (r >> 1) & 1, nb = r & 1; tr_item(F.in[7] + (size_t)h * RL * VH, VH, VH, nullptr, WUV + (size_t)h * VH * RL, RL, 64 * kb, 32 * nb, 32 * nb, scr, F.lane); continue; } r -= I_UV;
        if (r < I_SQ) { const int kb = r / 32, nb = r % 32; tr_item(F.in[8], D, D, nullptr, WAO, D, 64 * kb, 32 * nb, 32 * nb, scr, F.lane); continue; } r -= I_SQ;
        if (r < 2 * I_GU) { const int l = r / I_GU; r -= l * I_GU; const int nnb = 2 * FF / 32, kb = r / nnb, nb = r % nnb; const int c = 32 * nb;
            const int nd = (c < FF) ? ((c / 128) * 256 + (c % 128)) : (((c - FF) / 128) * 256 + 128 + ((c - FF) % 128));
            tr_item(F.in[14] + (size_t)l * D * 2 * FF, 2 * FF, 2 * FF, F.in[3] + l * D, (hbits*)(F.ws + (l ? WS_WGU1 : WS_WGU0)), D, 64 * kb, c, nd, scr, F.lane); continue; } r -= 2 * I_GU;
        if (r < 2 * I_D) { const int l = r / I_D; r -= l * I_D; const int kb = r / 32, nb = r % 32;
            tr_item(F.in[15] + (size_t)l * FF * D, D, D, nullptr, (hbits*)(F.ws + (l ? WS_WD1 : WS_WD0)), FF, 64 * kb, 32 * nb, 32 * nb, scr, F.lane); continue; } r -= 2 * I_D;
        if (r < I_WB) { const int nnb = B_IN / 32, kb = r / nnb, nb = r % nnb; tr_item(F.in[9], B_IN, B_IN, F.in[2] + D, WB, D, 64 * kb, 32 * nb, 32 * nb, scr, F.lane); continue; } r -= I_WB;
        { const int kb = r / 32, nb = r % 32; tr_item(F.in[12], D, D, nullptr, WBO, D, 64 * kb, 32 * nb, 32 * nb, scr, F.lane); }
    }
    { const float* w_uv = F.in[7]; const float* w_out = F.in[8]; hbits* WCT = (hbits*)(F.ws + WS_WCT);
      for (int it = gw; it < 1024; it += NGW) { const int h = it >> 6, dblk = (it >> 2) & 15, rblk = it & 3, d = dblk * 64 + F.lane;
          float wo[64];
#pragma unroll
          for (int v = 0; v < 64; ++v) wo[v] = w_out[(size_t)(h * 64 + v) * D + d];
          for (int r8 = 0; r8 < 4; ++r8) { float acc[8];
#pragma unroll
              for (int rr = 0; rr < 8; ++rr) { const float* u = w_uv + (size_t)(h * RL + rblk * 32 + r8 * 8 + rr) * VH; float sacc = 0.f;
#pragma unroll
                  for (int v = 0; v < 64; ++v) sacc = fmaf(u[v], wo[v], sacc);
                  acc[rr] = sacc; }
              v4u o; o.x = pk2h(acc[0], acc[1]); o.y = pk2h(acc[2], acc[3]); o.z = pk2h(acc[4], acc[5]); o.w = pk2h(acc[6], acc[7]);
              *(GAS v4u*)(WCT + (size_t)d * (NH * RL) + h * RL + rblk * 32 + r8 * 8) = o; } } }
    const float* x = F.in[0]; hbits* XH = (hbits*)(F.ws + WS_XH); float* RS0 = (float*)(F.ws + WS_RS0);
    for (int m = gw; m < M; m += NGW) {
        const GAS f32x4* xr = (const GAS f32x4*)(x + (size_t)m * D) + F.lane;
        f32x4 v[4]; float s = 0.f;
#pragma unroll
        for (int j = 0; j < 4; ++j) { v[j] = xr[64 * j]; s += (v[j].x * v[j].x + v[j].y * v[j].y) + (v[j].z * v[j].z + v[j].w * v[j].w); }
        s = wave_sum(s);
        if (F.lane == 0) RS0[m] = 1.0f / sqrtf(s * (1.0f / D) + pg8::RMS_EPS);
        GAS unsigned long long* o8 = (GAS unsigned long long*)(XH + (size_t)m * D) + F.lane;
#pragma unroll
        for (int j = 0; j < 4; ++j) o8[64 * j] = (unsigned long long)pk2h(v[j].x, v[j].y) | ((unsigned long long)pk2h(v[j].z, v[j].w) << 32);
    }
}

__device__ __forceinline__ unsigned okey(float f) { const unsigned u = __builtin_bit_cast(unsigned, f); return (u & 0x80000000u) ? ~u : (u | 0x80000000u); }
__device__ __forceinline__ void p2_indexer(Frame& F) {
    const int gw = F.bid * NWAVES + F.wave, NGW = F.G * NWAVES, lane = F.lane;
    { const float* CKV = (const float*)(F.ws + WS_CKV); hbits* CKVN = (hbits*)(F.ws + WS_CKVN); const float* lg = F.in[6];
      for (int m = gw; m < M; m += NGW) { const float a = CKV[(size_t)m * RL + 2 * lane], b = CKV[(size_t)m * RL + 2 * lane + 1];
          const float s = wave_sum(a * a + b * b); const float r = 1.0f / sqrtf(s * (1.0f / RL) + pg8::RMS_EPS);
          *(unsigned*)(CKVN + (size_t)m * RL + 2 * lane) = pk2h(a * r * lg[2 * lane], b * r * lg[2 * lane + 1]); } }
    LAS float* qs = (LAS float*)(F.lds + F.wave * 16384);
    LAS float* sc = qs + 512;
    const hbits* QI = (const hbits*)(F.ws + WS_QI); const hbits* KI = (const hbits*)(F.ws + WS_KI); const float* WI = (const float*)(F.ws + WS_WI);
    unsigned short* IDX = (unsigned short*)(F.ws + WS_IDX);
    const unsigned long long lt_mask = (1ull << lane) - 1ull;
    for (int i = 0; i * NGW < M; ++i) {
        const int tok = i * NGW + ((i & 1) ? (NGW - 1 - gw) : gw); if (tok >= M) continue; const int b = tok >> 11, t = tok & (T - 1);
        if (t < KSEL) {
#pragma unroll
            for (int j = 0; j < 4; ++j) { const int k = 4 * lane + j; IDX[(size_t)tok * KSEL + k] = (unsigned short)((k < t) ? k : t); }
            continue; }
#pragma unroll
        for (int j = 0; j < 8; ++j) qs[lane + 64 * j] = (float)__builtin_bit_cast(f16, QI[(size_t)tok * 512 + lane + 64 * j]);
        float w[8];
#pragma unroll
        for (int j = 0; j < 8; ++j) w[j] = WI[(size_t)tok * 8 + j];
        LDS_WAIT(); asm volatile("" ::: "memory");
        for (int s0 = 0; s0 <= t; s0 += 64) { const int s = s0 + lane; float score = -INFINITY;
            if (s <= t) { const hbits* kr = KI + ((size_t)b * T + s) * DI; float d[8];
#pragma unroll
                for (int j = 0; j < 8; ++j) d[j] = 0.f;
#pragma unroll
                for (int c = 0; c < 8; ++c) { const f16x8 kv = __builtin_bit_cast(f16x8, *(const v4u*)(kr + 8 * c));
#pragma unroll
                    for (int e = 0; e < 8; ++e) { const float kf = (float)kv[e];
#pragma unroll
                        for (int j = 0; j < 8; ++j) d[j] = fmaf(qs[j * 64 + c * 8 + e], kf, d[j]); } }
                score = 0.f;
#pragma unroll
                for (int j = 0; j < 8; ++j) score = fmaf(w[j], fmaxf(d[j], 0.f), score); }
            sc[s] = score; }
        for (int s = ((t >> 6) + 1) * 64 + lane; s < T; s += 64) sc[s] = -INFINITY;
        LDS_WAIT(); asm volatile("" ::: "memory");
        unsigned key[32];
#pragma unroll
        for (int q = 0; q < 32; ++q) { const int s = lane + 64 * q; key[q] = (s <= t) ? okey(sc[s]) : 0u; }
        unsigned prefix = 0u;
        for (int bit = 31; bit >= 0; --bit) { const unsigned cand = prefix | (1u << bit); int cnt = 0;
#pragma unroll
            for (int q = 0; q < 32; ++q) cnt += __builtin_popcountll(__ballot(key[q] >= cand));
            if (cnt >= KSEL) prefix = cand; }
        int ngt = 0;
#pragma unroll
        for (int q = 0; q < 32; ++q) ngt += __builtin_popcountll(__ballot(key[q] > prefix));
        const int need = KSEL - ngt; int eq_seen = 0, pos = 0;
#pragma unroll
        for (int q = 0; q < 32; ++q) { const bool gt = key[q] > prefix, eq = key[q] == prefix;
            const unsigned long long meq = __ballot(eq); const bool take = eq && (eq_seen + __builtin_popcountll(meq & lt_mask) < need); eq_seen += __builtin_popcountll(meq);
            const bool sel = gt || take; const unsigned long long ms = __ballot(sel);
            if (sel) IDX[(size_t)tok * KSEL + pos + __builtin_popcountll(ms & lt_mask)] = (unsigned short)(lane + 64 * q);
            pos += __builtin_popcountll(ms); }
        LDS_WAIT(); asm volatile("" ::: "memory");
    }
}

typedef short v4i16_t __attribute__((ext_vector_type(4)));
__device__ __forceinline__ int swz_x(int row) { return ((row & 3) << 2) | ((row >> 2) & 3); }
__device__ __forceinline__ void p3_sparse_attn(Frame& F) {
    const int lane = F.lane, wave = F.wave, gw = F.bid * NWAVES + wave, NGW = F.G * NWAVES;
    const int a = lane & 15, q = lane >> 4, sq = ((q & 1) << 1) | (q >> 1);
    LAS unsigned char* kvb = F.lds + wave * 16384;
    LAS unsigned short* idl = (LAS unsigned short*)(F.lds + 131072 + wave * 512);
    LAS float* bt = (LAS float*)(F.lds + 135168);
    const float* rel_bias = F.in[1];
    hbits* QL = (hbits*)(F.ws + WS_QL); const hbits* CKVN = (const hbits*)(F.ws + WS_CKVN); const unsigned short* IDX = (const unsigned short*)(F.ws + WS_IDX);
    for (int i = F.tid; i < 129 * 16; i += NTHREADS) bt[i] = rel_bias[(int)BUCKET_TAB[i >> 4] * 16 + (i & 15)] * pg8::LOG2E;
    __syncthreads();
    const int arow = 4 * ((((a >> 2) & 1) << 1) | (a >> 3)) + (a & 3), xa = swz_x(arow);
    int aoff[4];
#pragma unroll
    for (int s = 0; s < 4; ++s) aoff[s] = 256 * arow + 16 * ((4 * s + q) ^ xa);
    const int trow = 4 * sq + (a >> 2), xt = swz_x(trow);
    int toff[8];
#pragma unroll
    for (int nt = 0; nt < 8; ++nt) toff[nt] = 256 * trow + 16 * ((2 * nt + ((a >> 1) & 1)) ^ xt) + 8 * (a & 1);
    const int drow = lane >> 4;
    for (int i = 0; i * NGW < M; ++i) {
        const int tok = gw + NGW * i; if (tok >= M) break;
        const int b = tok >> 11, t = tok & (T - 1); const int n = (t + 1 < KSEL) ? t + 1 : KSEL, nc = (n + 31) >> 5;
        { const unsigned long long v = *(const unsigned long long*)(IDX + (size_t)tok * KSEL + 4 * lane); *(LAS unsigned long long*)(idl + 4 * lane) = v; }
        f16x8 qf[4];
#pragma unroll
        for (int s = 0; s < 4; ++s) qf[s] = __builtin_bit_cast(f16x8, *(const v4u*)(QL + (size_t)tok * (NH * RL) + a * RL + 32 * s + 8 * q));
        LDS_WAIT(); asm volatile("" ::: "memory");
        const hbits* kvbase = CKVN + (size_t)b * T * RL;
#define P3_DMA(c, buf) do { _Pragma("unroll") for (int g = 0; g < 8; ++g) { const int row = 4 * g + drow; const int key = idl[32 * (c) + row]; \
            __builtin_amdgcn_global_load_lds((const unsigned*)(kvbase + (size_t)key * RL + 8 * ((lane & 15) ^ swz_x(row))), (LAS unsigned*)(kvb + (buf) * 8192 + g * 1024), 16, 0, 0); } } while (0)
        P3_DMA(0, 0);
        float m = -INFINITY, l = 0.f; f32x4 o[8];
#pragma unroll
        for (int nt = 0; nt < 8; ++nt) o[nt] = (f32x4){0.f, 0.f, 0.f, 0.f};
        for (int c = 0; c < nc; ++c) {
            LAS unsigned char* cur = kvb + (c & 1) * 8192;
            if (c + 1 < nc) { LDS_WAIT(); asm volatile("" ::: "memory"); P3_DMA(c + 1, (c + 1) & 1); asm volatile("s_waitcnt vmcnt(8)" ::: "memory"); }
            else { asm volatile("s_waitcnt vmcnt(0)" ::: "memory"); }
            f32x4 s0 = (f32x4){0.f, 0.f, 0.f, 0.f}, s1 = (f32x4){0.f, 0.f, 0.f, 0.f};
#pragma unroll
            for (int s = 0; s < 4; ++s) { const f16x8 k0 = __builtin_bit_cast(f16x8, *(const LAS v4u*)(cur + aoff[s])), k1 = __builtin_bit_cast(f16x8, *(const LAS v4u*)(cur + 4096 + aoff[s]));
                s0 = __builtin_amdgcn_mfma_f32_16x16x32_f16(k0, qf[s], s0, 0, 0, 0); s1 = __builtin_amdgcn_mfma_f32_16x16x32_f16(k1, qf[s], s1, 0, 0, 0); }
            { const unsigned long long i0 = *(const LAS unsigned long long*)(idl + 32 * c + 4 * sq), i1 = *(const LAS unsigned long long*)(idl + 32 * c + 16 + 4 * sq);
#pragma unroll
              for (int r = 0; r < 4; ++r) { const int k0 = (int)((i0 >> (16 * r)) & 0xffffu), k1 = (int)((i1 >> (16 * r)) & 0xffffu);
                  const int r0 = t - k0, r1 = t - k1;
                  s0[r] += bt[(((unsigned)r0 < 128u) ? r0 : 128) * 16 + a]; s1[r] += bt[(((unsigned)r1 < 128u) ? r1 : 128) * 16 + a];
                  if (32 * c + 4 * sq + r >= n) s0[r] = -INFINITY;
                  if (32 * c + 16 + 4 * sq + r >= n) s1[r] = -INFINITY; } }
            float cm = fmaxf(fmaxf(fmaxf(s0[0], s0[1]), fmaxf(s0[2], s0[3])), fmaxf(fmaxf(s1[0], s1[1]), fmaxf(s1[2], s1[3])));
            cm = fmaxf(cm, __shfl_xor(cm, 16)); cm = fmaxf(cm, __shfl_xor(cm, 32));
            const float mn = fmaxf(m, cm), alpha = __builtin_amdgcn_exp2f(m - mn); m = mn;
            float ps = 0.f;
#pragma unroll
            for (int r = 0; r < 4; ++r) { s0[r] = __builtin_amdgcn_exp2f(s0[r] - mn); s1[r] = __builtin_amdgcn_exp2f(s1[r] - mn); ps += s0[r] + s1[r]; }
            l = l * alpha + ps;
#pragma unroll
            for (int nt = 0; nt < 8; ++nt) o[nt] = o[nt] * alpha;
            v4u pw; pw.x = pk2h(s0[0], s0[1]); pw.y = pk2h(s0[2], s0[3]); pw.z = pk2h(s1[0], s1[1]); pw.w = pk2h(s1[2], s1[3]);
            const f16x8 pfr = __builtin_bit_cast(f16x8, pw);
#pragma unroll
            for (int nt = 0; nt < 8; ++nt) {
                const v4i16_t t0 = __builtin_amdgcn_ds_read_tr16_b64_v4i16((LAS v4i16_t*)(cur + toff[nt])), t1 = __builtin_amdgcn_ds_read_tr16_b64_v4i16((LAS v4i16_t*)(cur + 4096 + toff[nt]));
                typedef short v8i16_t __attribute__((ext_vector_type(8)));
                const v8i16_t tv = {t0[0], t0[1], t0[2], t0[3], t1[0], t1[1], t1[2], t1[3]};
                o[nt] = __builtin_amdgcn_mfma_f32_16x16x32_f16(__builtin_bit_cast(f16x8, tv), pfr, o[nt], 0, 0, 0); }
        }
        l += __shfl_xor(l, 16); l += __shfl_xor(l, 32);
        const float inv = 1.0f / l;
        hbits* orow = QL + (size_t)tok * (NH * RL) + a * RL + 4 * q;
#pragma unroll
        for (int nt = 0; nt < 8; ++nt) { const unsigned long long w = (unsigned long long)pk2h(o[nt][0] * inv, o[nt][1] * inv) | ((unsigned long long)pk2h(o[nt][2] * inv, o[nt][3] * inv) << 32);
            *(unsigned long long*)(orow + 16 * nt) = w; }
        LDS_WAIT(); asm volatile("" ::: "memory");
#undef P3_DMA
    }
}

typedef float f32x16 __attribute__((ext_vector_type(16)));
constexpr float SWA_QSCALE = 0.125f * 1.4426950408889634f;
__device__ __forceinline__ void p8_swa(Frame& F) {
    const int tid = F.tid, lane = F.lane, wave = F.wave, r32 = lane & 31, hh = lane >> 5;
    LAS unsigned char* Ks = F.lds;
    LAS unsigned char* Vs = F.lds + 20480;
    LAS float* btr = (LAS float*)(F.lds + 40960);
    const float* rel_bias = F.in[1]; const float* sinks = F.in[11];
    const hbits* QKV = (const hbits*)(F.ws + WS_QKV1); hbits* OB = (hbits*)(F.ws + WS_OB);
    for (int i = tid; i < 192 * 16; i += NTHREADS) { const int rel = 159 - (i >> 4); btr[i] = (rel >= 0 && rel < 128) ? rel_bias[(int)BUCKET_TAB[rel] * 16 + (i & 15)] * pg8::LOG2E : 0.f; }
    const int lrow = tid >> 3, lch = tid & 7;
    const int g = lane >> 4, dh = g & 1, ti = lane & 15, tr_r = ti >> 2, tr_p = ti & 3;
    int kbase[4], vbase[2];
#pragma unroll
    for (int s = 0; s < 4; ++s) kbase[s] = r32 * 128 + 16 * ((2 * s + hh) ^ ((r32 >> 1) & 7));
#pragma unroll
    for (int dt = 0; dt < 2; ++dt) vbase[dt] = (4 * hh + tr_r) * 128 + 16 * ((4 * dt + 2 * dh + (tr_p >> 1)) ^ (((tr_r >> 1) & 1) << 2)) + 8 * (tr_p & 1);
    for (int u = F.bid; u < NB * 2 * (T / 32); u += F.G) {
        const int qt = u & 63, kvh = (u >> 6) & 1, b = u >> 7, t0 = 32 * qt, head = kvh * 8 + wave;
        __syncthreads();
#pragma unroll
        for (int p = 0; p < 3; ++p) { const int row = lrow + 64 * p;
            if (row < 160) { const int key = t0 - 128 + row; v4u kv = (v4u){0u, 0u, 0u, 0u}, vv = (v4u){0u, 0u, 0u, 0u};
                if (key >= 0) { const hbits* base = QKV + ((size_t)b * T + key) * B_IN; kv = *(const v4u*)(base + 1024 + kvh * 64 + 8 * lch); vv = *(const v4u*)(base + 1152 + kvh * 64 + 8 * lch); }
                *(LAS v4u*)(Ks + row * 128 + 16 * (lch ^ ((row >> 1) & 7))) = kv; *(LAS v4u*)(Vs + row * 128 + 16 * (lch ^ (((row >> 1) & 1) << 2))) = vv; } }
        f16x8 qf[4];
#pragma unroll
        for (int s = 0; s < 4; ++s) qf[s] = __builtin_bit_cast(f16x8, *(const v4u*)(QKV + ((size_t)b * T + t0 + r32) * B_IN + head * 64 + 16 * s + 8 * hh));
        __syncthreads();
        f32x16 S[5];
#pragma unroll
        for (int kt = 0; kt < 5; ++kt) {
#pragma unroll
            for (int r = 0; r < 16; ++r) S[kt][r] = 0.f;
#pragma unroll
            for (int s = 0; s < 4; ++s) { const f16x8 kf = __builtin_bit_cast(f16x8, *(const LAS v4u*)(Ks + kbase[s] + kt * 4096));
                S[kt] = __builtin_amdgcn_mfma_f32_32x32x16_f16(kf, qf[s], S[kt], 0, 0, 0); } }
        const float sink2 = sinks[head] * pg8::LOG2E; float m = sink2;
        int base = 128 + r32 - 4 * hh; asm volatile("" : "+v"(base));
        const LAS float* btl = btr + (159 - base) * 16 + head;
        const int kmin = 128 - t0 - 4 * hh;
#pragma unroll
        for (int kt = 0; kt < 5; ++kt)
#pragma unroll
            for (int r = 0; r < 16; ++r) { const int c = 32 * kt + (r & 3) + 8 * (r >> 2); const int rel = base - c;
                const bool valid = ((unsigned)rel < 128u) && (c >= kmin);
                const float v = valid ? S[kt][r] + btl[c * 16] : -INFINITY; S[kt][r] = v; m = fmaxf(m, v); }
        m = fmaxf(m, __shfl_xor(m, 32));
        float l = 0.f;
#pragma unroll
        for (int kt = 0; kt < 5; ++kt)
#pragma unroll
            for (int r = 0; r < 16; ++r) { const float p = __builtin_amdgcn_exp2f(S[kt][r] - m); S[kt][r] = p; l += p; }
        l += __shfl_xor(l, 32); l += __builtin_amdgcn_exp2f(sink2 - m);
        const float inv = 1.0f / l;
        f32x16 O[2];
#pragma unroll
        for (int dt = 0; dt < 2; ++dt)
#pragma unroll
            for (int r = 0; r < 16; ++r) O[dt][r] = 0.f;
#pragma unroll
        for (int kt = 0; kt < 5; ++kt)
#pragma unroll
            for (int s = 0; s < 2; ++s) { v4u pw; pw.x = pk2h(S[kt][8 * s + 0], S[kt][8 * s + 1]); pw.y = pk2h(S[kt][8 * s + 2], S[kt][8 * s + 3]); pw.z = pk2h(S[kt][8 * s + 4], S[kt][8 * s + 5]); pw.w = pk2h(S[kt][8 * s + 6], S[kt][8 * s + 7]);
                const f16x8 pfr = __builtin_bit_cast(f16x8, pw);
#pragma unroll
                for (int dt = 0; dt < 2; ++dt) {
                    const v4i16_t t1 = __builtin_amdgcn_ds_read_tr16_b64_v4i16((LAS v4i16_t*)(Vs + vbase[dt] + (32 * kt + 16 * s) * 128));
                    const v4i16_t t2 = __builtin_amdgcn_ds_read_tr16_b64_v4i16((LAS v4i16_t*)(Vs + vbase[dt] + (32 * kt + 16 * s + 8) * 128));
                    typedef short v8i16_t __attribute__((ext_vector_type(8)));
                    const v8i16_t tv = {t1[0], t1[1], t1[2], t1[3], t2[0], t2[1], t2[2], t2[3]};
                    O[dt] = __builtin_amdgcn_mfma_f32_32x32x16_f16(__builtin_bit_cast(f16x8, tv), pfr, O[dt], 0, 0, 0); }
                __builtin_amdgcn_sched_barrier(0); }
        hbits* orow = OB + ((size_t)b * T + t0 + r32) * D + head * 64 + 4 * hh;
#pragma unroll
        for (int dt = 0; dt < 2; ++dt)
#pragma unroll
            for (int g4 = 0; g4 < 4; ++g4) { const unsigned long long w = (unsigned long long)pk2h(O[dt][4 * g4] * inv, O[dt][4 * g4 + 1] * inv) | ((unsigned long long)pk2h(O[dt][4 * g4 + 2] * inv, O[dt][4 * g4 + 3] * inv) << 32);
                *(unsigned long long*)(orow + 32 * dt + 8 * g4) = w; }
    }
}

__device__ __forceinline__ void p12_final(Frame& F) {
    const int gw = F.bid * NWAVES + F.wave, NGW = F.G * NWAVES; const float* g = F.in[4];
    for (int m = gw; m < M; m += NGW) {
        GAS f32x4* xr = (GAS f32x4*)(F.out + (size_t)m * D) + F.lane;
        f32x4 v[4]; float s = 0.f;
#pragma unroll
        for (int j = 0; j < 4; ++j) { v[j] = xr[64 * j]; s += (v[j].x * v[j].x + v[j].y * v[j].y) + (v[j].z * v[j].z + v[j].w * v[j].w); }
        const float r = 1.0f / sqrtf(wave_sum(s) * (1.0f / D) + pg8::RMS_EPS);
#pragma unroll
        for (int j = 0; j < 4; ++j) { const f32x4 gv = *((const f32x4*)g + F.lane + 64 * j); xr[64 * j] = v[j] * r * gv; }
    }
}

struct Args { const float* in[16]; float* out; unsigned char* ws; int ph_lo, ph_hi; };
template <bool COOP>
__global__ void __launch_bounds__(NTHREADS, 2) fwd(Args args) {
    extern __shared__ __attribute__((aligned(16))) unsigned char lds[];
    Frame F;
    F.lds = (LAS unsigned char*)lds; F.tid = threadIdx.x; F.lane = F.tid & 63; F.wave = __builtin_amdgcn_readfirstlane(F.tid >> 6);
    F.G = gridDim.x; F.bid = blockIdx.x;
#pragma unroll
    for (int i = 0; i < 16; ++i) F.in[i] = args.in[i];
    F.out = args.out; F.ws = args.ws;
    unsigned char* ws = args.ws;
    const int lo = args.ph_lo, hi = args.ph_hi;
#define IN(k) (lo <= (k) && (k) < hi)
#define SEAM(k) do { if constexpr (COOP) { if (IN(k) && IN((k) + 1)) cg::this_grid().sync(); } } while (0)
    typedef pg8::bf16_t hb;
    float* SS1 = (float*)(ws + WS_SS1); float* SS2 = (float*)(ws + WS_SS2); float* SS3 = (float*)(ws + WS_SS3);
    hb* XH = (hb*)(ws + WS_XH);

    if (IN(0)) { p0_prologue(F); } SEAM(0);
    if (IN(1)) {
        pg8::Gemm g{XH, (const hb*)(ws + WS_WA), M, A_PAD, D}; pg8::StaticOrder S; S.init(M, A_PAD, F.G, F.bid);
        pg8::EpiInA E{(const float*)(ws + WS_RS0), (hb*)(ws + WS_QL), (float*)(ws + WS_CKV), (hb*)(ws + WS_QI), (hb*)(ws + WS_KI), (float*)(ws + WS_WI)};
        pg8::gemm_phase<pg8::EpiInA, pg8::StaticOrder, true, true>(F.lds, g, S, E);
    } SEAM(1);
    if (IN(2)) { p2_indexer(F); } SEAM(2);
    if (IN(3)) { p3_sparse_attn(F); } SEAM(3);
    if (IN(4)) {
        pg8::Gemm g{(const hb*)(ws + WS_QL), (const hb*)(ws + WS_WCT), M, D, NH * RL}; pg8::StaticOrder S; S.init(M, D, F.G, F.bid);
        pg8::EpiRes E{F.in[0], F.out, XH, SS1, nullptr};
        pg8::gemm_phase<pg8::EpiRes, pg8::StaticOrder, true, true>(F.lds, g, S, E);
    } SEAM(4);
    if (IN(5)) {
        pg8::Gemm g{XH, (const hb*)(ws + WS_WGU0), M, 2 * FF, D}; pg8::StaticOrder S; S.init(M, 2 * FF, F.G, F.bid);
        pg8::EpiGU E{SS1, (hb*)(ws + WS_HB)};
        pg8::gemm_phase<pg8::EpiGU, pg8::StaticOrder, true, true>(F.lds, g, S, E);
    } SEAM(5);
    if (IN(6)) {
        pg8::Gemm g{(const hb*)(ws + WS_HB), (const hb*)(ws + WS_WD0), M, D, FF}; pg8::StaticOrder S; S.init(M, D, F.G, F.bid);
        pg8::EpiRes E{F.out, F.out, XH, SS2, nullptr};
        pg8::gemm_phase<pg8::EpiRes, pg8::StaticOrder, true, true>(F.lds, g, S, E);
    } SEAM(6);
    if (IN(7)) {
        pg8::Gemm g{XH, (const hb*)(ws + WS_WB), M, B_IN, D}; pg8::StaticOrder S; S.init(M, B_IN, F.G, F.bid);
        pg8::EpiInB E{SS2, F.in[10], (hb*)(ws + WS_QKV1)};
        pg8::gemm_phase<pg8::EpiInB, pg8::StaticOrder, true, true>(F.lds, g, S, E);
    } SEAM(7);
    if (IN(8)) { p8_swa(F); } SEAM(8);
    if (IN(9)) {
        pg8::Gemm g{(const hb*)(ws + WS_OB), (const hb*)(ws + WS_WBO), M, D, D}; pg8::StaticOrder S; S.init(M, D, F.G, F.bid);
        pg8::EpiRes E{F.out, F.out, XH, SS3, F.in[13]};
        pg8::gemm_phase<pg8::EpiRes, pg8::StaticOrder, true, true>(F.lds, g, S, E);
    } SEAM(9);
    if (IN(10)) {
        pg8::Gemm g{XH, (const hb*)(ws + WS_WGU1), M, 2 * FF, D}; pg8::StaticOrder S; S.init(M, 2 * FF, F.G, F.bid);
        pg8::EpiGU E{SS3, (hb*)(ws + WS_HB)};
        pg8::gemm_phase<pg8::EpiGU, pg8::StaticOrder, true, true>(F.lds, g, S, E);
    } SEAM(10);
    if (IN(11)) {
        pg8::Gemm g{(const hb*)(ws + WS_HB), (const hb*)(ws + WS_WD1), M, D, FF}; pg8::StaticOrder S; S.init(M, D, F.G, F.bid);
        pg8::EpiRes E{F.out, F.out, XH, SS1, nullptr};
        pg8::gemm_phase<pg8::EpiRes, pg8::StaticOrder, true, true>(F.lds, g, S, E);
    } SEAM(11);
    if (IN(12)) { p12_final(F); }
#undef IN
#undef SEAM
}

extern "C" void kernel_launch(void* const* d_in, const int* in_sizes, int n_in, void* d_out, int out_size, void* d_ws, size_t ws_size, hipStream_t stream) {
    static int grid = 0;
    if (grid == 0) {
        if (n_in != 16 || in_sizes[0] != M * D || out_size != M * D || ws_size < WS_END) { fprintf(stderr, "kernel_launch: unexpected shapes (n_in %d, in0 %d, out %d, ws %zu)\n", n_in, n_in > 0 ? in_sizes[0] : -1, out_size, ws_size); grid = -1; return; }
        int dev = 0, cus = 0, per_cu = 0;
        if (hipGetDevice(&dev) != hipSuccess || hipDeviceGetAttribute(&cus, hipDeviceAttributeMultiprocessorCount, dev) != hipSuccess) { grid = -1; return; }
        const void* fn = MK_ONE_LAUNCH ? (const void*)fwd<true> : (const void*)fwd<false>;
        if (hipFuncSetAttribute(fn, hipFuncAttributeMaxDynamicSharedMemorySize, LDS_BYTES) != hipSuccess) { fprintf(stderr, "kernel_launch: hipFuncSetAttribute failed\n"); grid = -1; return; }
        if (hipOccupancyMaxActiveBlocksPerMultiprocessor(&per_cu, fn, NTHREADS, LDS_BYTES) != hipSuccess || per_cu < 1) { fprintf(stderr, "kernel_launch: occupancy query says %d blocks per CU\n", per_cu); per_cu = 1; }
        (void)hipGetLastError();
        grid = cus;
    }
    if (grid < 0) return;
    (void)hipMemsetAsync((char*)d_ws + WS_CTL, 0, CTL_ZERO_BYTES, stream);
    Args a{};
    for (int i = 0; i < 16; ++i) a.in[i] = (const float*)d_in[i];
    a.out = (float*)d_out; a.ws = (unsigned char*)d_ws;
#if MK_ONE_LAUNCH
    a.ph_lo = 0; a.ph_hi = N_PHASES;
    void* kargs[] = {&a};
    hipError_t e = hipLaunchCooperativeKernel((const void*)fwd<true>, dim3(grid), dim3(NTHREADS), kargs, LDS_BYTES, stream);
    if (e != hipSuccess) fprintf(stderr, "cooperative launch failed: %s (grid %d)\n", hipGetErrorString(e), grid);
#else
    for (int p = 0; p < N_PHASES; ++p) { a.ph_lo = p; a.ph_hi = p + 1; hipLaunchKernelGGL(fwd<false>, dim3(grid), dim3(NTHREADS), LDS_BYTES, stream, a); }
#endif
}
```

```cpp
#include <hip/hip_runtime.h>
#include <hip/hip_cooperative_groups.h>
#include <cstdio>
#include <cstdint>
namespace cg = cooperative_groups;

typedef _Float16 f16x8 __attribute__((ext_vector_type(8)));
typedef _Float16 f16x2 __attribute__((ext_vector_type(2)));
typedef _Float16 f16;
namespace pg8 {
#define PG8_LAS __attribute__((address_space(3)))
typedef unsigned short bf16_t;
typedef short bf16x8 __attribute__((ext_vector_type(8)));
typedef float f32x4 __attribute__((ext_vector_type(4)));
typedef unsigned u32x4 __attribute__((ext_vector_type(4)));
constexpr int BM = 256, BK = 64, HALF = 128, HTB = HALF * BK * 2  , STAGE_BYTES = 8 * HTB, NXCD = 8, WGM = 8;

__host__ __device__ __forceinline__ int lds_byte(int r, int c) { const int st = (r >> 4) * 2 + (c >> 5), rr = r & 15, cc = c & 31, ob = rr * 64 + cc * 2; return st * 1024 + (ob ^ (((ob >> 9) & 1) << 5)); }
__host__ __device__ __forceinline__ void stage_rc(int b, int& R, int& C) { const int st = b / 1024, sb = b % 1024, swz = sb ^ (((sb >> 9) & 1) << 5); R = (st >> 1) * 16 + swz / 64; C = (st & 1) * 32 + (swz % 64) / 2; }
__host__ __device__ __forceinline__ int perm32(int rho) { const int n = rho >> 4, i = rho & 15; return 8 * (i >> 2) + 4 * n + (i & 3); }

struct Unit { int pm, pn; };
struct Gemm { const bf16_t* A; const bf16_t* Bt; int M, N, K; };

struct StaticOrder {
    int nM, nN, nwg, G, c;
    __host__ __device__ void init(int M, int N, int G_, int c_) { nM = M / BM; nN = N / BM; nwg = nM * nN; G = G_; c = c_; }
    __host__ __device__ bool next(int i, Unit& u) const {
        const long L = (long)i * G + c; if (L >= nwg) return false;
        int wgid = (int)L; { const int q = nwg / NXCD, r = nwg % NXCD, xcd = wgid % NXCD, off = wgid / NXCD; wgid = (xcd < r ? xcd * (q + 1) : r * (q + 1) + (xcd - r) * q) + off; }
        const int nig = WGM * nN, gid = wgid / nig, fm = gid * WGM, gsz = (nM - fm) < WGM ? (nM - fm) : WGM;
        u.pm = fm + ((wgid % nig) % gsz); u.pn = (wgid % nig) / gsz; return true;
    }
    __device__ __forceinline__ void a_ready(const Unit&) const {}
    __device__ __forceinline__ void done(const Unit&) const {}
};

__device__ __forceinline__ unsigned pk2h(float lo, float hi) { f16x2 v = {(_Float16)lo, (_Float16)hi}; return __builtin_bit_cast(unsigned, v); }
__device__ __forceinline__ u32x4 pk8h(f32x4 a, f32x4 b) { u32x4 w; w.x = pk2h(a[0], a[1]); w.y = pk2h(a[2], a[3]); w.z = pk2h(b[0], b[1]); w.w = pk2h(b[2], b[3]); return w; }
constexpr float RMS_EPS = 1e-6f;
constexpr float LOG2E = 1.4426950408889634f, QSCALE = 0.08838834764831845f * 1.4426950408889634f;

struct EpiInA {
    static constexpr bool PERM = true, AFTER_DRAIN = false;
    const float* rs; bf16_t* QL; float* CKV; bf16_t* QI; bf16_t* KI; float* WI;
    __device__ __forceinline__ void operator()(const f32x4 (&acc)[2][2][4][2], const Unit& u, int wr, int wc, int fr, int fq) const {
        const int row0 = u.pm * BM + wr * 64 + fr;
#pragma unroll
        for (int ai = 0; ai < 2; ++ai)
#pragma unroll
            for (int m = 0; m < 4; ++m) { const int row = row0 + ai * HALF + m * 16; const float r = rs[row];
#pragma unroll
                for (int bj = 0; bj < 2; ++bj) { const int col = u.pn * BM + bj * HALF + wc * 32 + 8 * fq;
                    f32x4 v0 = acc[ai][bj][m][0] * r, v1 = acc[ai][bj][m][1] * r;
                    if (col < 2048) { v0 = v0 * QSCALE; v1 = v1 * QSCALE; *(u32x4*)(QL + (size_t)row * 2048 + col) = pk8h(v0, v1); }
                    else if (col < 2176) { float* p = CKV + (size_t)row * 128 + (col - 2048); *(f32x4*)p = v0; *(f32x4*)(p + 4) = v1; }
                    else if (col < 2688) { v0 = v0 * 0.125f; v1 = v1 * 0.125f; *(u32x4*)(QI + (size_t)row * 512 + (col - 2176)) = pk8h(v0, v1); }
                    else if (col < 2752) { *(u32x4*)(KI + (size_t)row * 64 + (col - 2688)) = pk8h(v0, v1); }
                    else if (col < 2760) { const float s = 0.35355339059327373f; float* p = WI + (size_t)row * 8; *(f32x4*)p = v0 * s; *(f32x4*)(p + 4) = v1 * s; }
                } }
    }
};
struct EpiRes {
    static constexpr bool PERM = true, AFTER_DRAIN = false;
    const float* xold; float* xnew; bf16_t* xh; float* ss; const float* bias;
    __device__ __forceinline__ void operator()(const f32x4 (&acc)[2][2][4][2], const Unit& u, int wr, int wc, int fr, int fq) const {
        const int row0 = u.pm * BM + wr * 64 + fr;
#pragma unroll
        for (int ai = 0; ai < 2; ++ai)
#pragma unroll
            for (int m = 0; m < 4; ++m) { const int row = row0 + ai * HALF + m * 16; float sq = 0.f;
#pragma unroll
                for (int bj = 0; bj < 2; ++bj) { const int col = u.pn * BM + bj * HALF + wc * 32 + 8 * fq; const size_t off = (size_t)row * 1024 + col;
                    f32x4 v0 = acc[ai][bj][m][0] + *(const f32x4*)(xold + off), v1 = acc[ai][bj][m][1] + *(const f32x4*)(xold + off + 4);
                    if (bias) { v0 = v0 + *(const f32x4*)(bias + col); v1 = v1 + *(const f32x4*)(bias + col + 4); }
                    *(f32x4*)(xnew + off) = v0; *(f32x4*)(xnew + off + 4) = v1;
                    *(u32x4*)(xh + off) = pk8h(v0, v1);
                    sq += (v0[0] * v0[0] + v0[1] * v0[1]) + (v0[2] * v0[2] + v0[3] * v0[3]) + (v1[0] * v1[0] + v1[1] * v1[1]) + (v1[2] * v1[2] + v1[3] * v1[3]); }
                sq += __shfl_xor(sq, 16); sq += __shfl_xor(sq, 32);
                if (fq == 0) atomicAdd(ss + row, sq); }
    }
};
struct EpiGU {
    static constexpr bool PERM = true, AFTER_DRAIN = false;
    const float* ss; bf16_t* HB;
    __device__ __forceinline__ void operator()(const f32x4 (&acc)[2][2][4][2], const Unit& u, int wr, int wc, int fr, int fq) const {
        const int row0 = u.pm * BM + wr * 64 + fr; const int col = u.pn * HALF + wc * 32 + 8 * fq;
#pragma unroll
        for (int ai = 0; ai < 2; ++ai)
#pragma unroll
            for (int m = 0; m < 4; ++m) { const int row = row0 + ai * HALF + m * 16; const float r = 1.0f / sqrtf(ss[row] * (1.0f / 1024.0f) + RMS_EPS);
                f32x4 hv[2];
#pragma unroll
                for (int n = 0; n < 2; ++n)
#pragma unroll
                    for (int j = 0; j < 4; ++j) { const float g = acc[ai][0][m][n][j] * r, uu = acc[ai][1][m][n][j] * r;
                        hv[n][j] = g * __builtin_amdgcn_rcpf(1.0f + __builtin_amdgcn_exp2f(-1.4426950408889634f * g)) * uu; }
                *(u32x4*)(HB + (size_t)row * 2816 + col) = pk8h(hv[0], hv[1]); }
    }
};
struct EpiInB {
    static constexpr bool PERM = true, AFTER_DRAIN = false;
    const float* ss; const float* bias; bf16_t* QKV;
    __device__ __forceinline__ void operator()(const f32x4 (&acc)[2][2][4][2], const Unit& u, int wr, int wc, int fr, int fq) const {
        const int row0 = u.pm * BM + wr * 64 + fr;
#pragma unroll
        for (int ai = 0; ai < 2; ++ai)
#pragma unroll
            for (int m = 0; m < 4; ++m) { const int row = row0 + ai * HALF + m * 16; const float r = 1.0f / sqrtf(ss[row] * (1.0f / 1024.0f) + RMS_EPS);
#pragma unroll
                for (int bj = 0; bj < 2; ++bj) { const int col = u.pn * BM + bj * HALF + wc * 32 + 8 * fq;
                    f32x4 v0 = acc[ai][bj][m][0] * r + *(const f32x4*)(bias + col), v1 = acc[ai][bj][m][1] * r + *(const f32x4*)(bias + col + 4);
                    if (col < 1024) { v0 = v0 * (0.125f * LOG2E); v1 = v1 * (0.125f * LOG2E); }
                    *(u32x4*)(QKV + (size_t)row * 1280 + col) = pk8h(v0, v1); } }
    }
};

template <class Epi, class Sched, bool ALIGN_EPI = false, bool SP2 = false>
__device__ __forceinline__ void gemm_phase(PG8_LAS unsigned char* lds, const Gemm g, const Sched& S, const Epi& E) {
    const int tid = threadIdx.x, wid = __builtin_amdgcn_readfirstlane(tid >> 6), lane = tid & 63, wr = wid >> 2, wc = wid & 3, fr = lane & 15, fq = lane >> 4;
    const int K = g.K, nt = K / BK;
    unsigned voffA[2], voffB[2];
#pragma unroll
    for (int i = 0; i < 2; ++i) { int R, C; stage_rc(tid * 16 + i * 8192, R, C); const int Rb = Epi::PERM ? ((R & ~31) + perm32(R & 31)) : R;
        voffA[i] = (unsigned)(R * K + C) * 2u; voffB[i] = (unsigned)(Rb * K + C) * 2u; }
    const size_t kstep = (size_t)(BK * 2);
    const size_t hstep = (size_t)HALF * K * 2;
    const size_t tstep = 2 * hstep;
    const unsigned ldsw = (unsigned)wid * 1024u;
    const int aoff = lds_byte(wr * 64 + fr, fq * 8), boff = lds_byte(wc * 32 + fr, fq * 8);
#define PG8_SA(b, h) (((b) * 2 + (h)) * HTB)
#define PG8_SB(b, h) ((4 + (b) * 2 + (h)) * HTB)
#define PG8_STAGE(bufoff, gbase, voff) do { _Pragma("unroll") for (int _i = 0; _i < 2; ++_i) \
        __builtin_amdgcn_global_load_lds((const unsigned*)((const char*)(gbase) + (voff)[_i]), (PG8_LAS unsigned*)(lds + (bufoff) + ldsw + _i * 8192), 16, 0, 0); } while (0)
#define PG8_LDA(dst, b, h) do { _Pragma("unroll") for (int m = 0; m < 4; ++m) _Pragma("unroll") for (int k = 0; k < 2; ++k) dst[m][k] = *(const PG8_LAS bf16x8*)(lds + PG8_SA(b, h) + aoff + m * 2048 + k * 1024); } while (0)
#define PG8_LDB(dst, b, h) do { _Pragma("unroll") for (int n = 0; n < 2; ++n) _Pragma("unroll") for (int k = 0; k < 2; ++k) dst[n][k] = *(const PG8_LAS bf16x8*)(lds + PG8_SB(b, h) + boff + n * 2048 + k * 1024); } while (0)
#define PG8_MMA(ai, bj, At, Bt) do { __builtin_amdgcn_s_setprio(1); _Pragma("unroll") for (int m = 0; m < 4; ++m) _Pragma("unroll") for (int n = 0; n < 2; ++n) _Pragma("unroll") for (int k = 0; k < 2; ++k) \
        acc[ai][bj][m][n] = __builtin_amdgcn_mfma_f32_16x16x32_f16(__builtin_bit_cast(f16x8, Bt[n][k]), __builtin_bit_cast(f16x8, At[m][k]), acc[ai][bj][m][n], 0, 0, 0); __builtin_amdgcn_s_setprio(0); } while (0)
#define PG8_WAIT_V(n) asm volatile("s_waitcnt vmcnt(" #n ")" ::: "memory")
#define PG8_WAIT_L(n) asm volatile("s_waitcnt lgkmcnt(" #n ")" ::: "memory")
#define PG8_BAR __builtin_amdgcn_s_barrier()
#define PG8_SCHED __builtin_amdgcn_sched_barrier(0)
    Unit cur, nxt; int ui = 0;
    if (!S.next(0, cur)) return;
    f32x4 acc[2][2][4][2];
#pragma unroll
    for (int a = 0; a < 2; ++a)
#pragma unroll
        for (int b = 0; b < 2; ++b)
#pragma unroll
            for (int m = 0; m < 4; ++m)
#pragma unroll
                for (int n = 0; n < 2; ++n) acc[a][b][m][n] = (f32x4){0.f, 0.f, 0.f, 0.f};
    bf16x8 At[4][2], B0[2][2], B1[2][2];
    const char* cA = (const char*)g.A + (size_t)cur.pm * tstep; const char* cB = (const char*)g.Bt + (size_t)cur.pn * tstep;
    S.a_ready(cur);
    if constexpr (SP2) {
        PG8_STAGE(PG8_SB(0, 0), cB, voffB); PG8_STAGE(PG8_SB(0, 1), cB + hstep, voffB); PG8_STAGE(PG8_SA(0, 0), cA, voffA); PG8_STAGE(PG8_SA(0, 1), cA + hstep, voffA);
        if (wr == 1) PG8_BAR;
        PG8_WAIT_V(2); PG8_BAR;
        PG8_STAGE(PG8_SB(1, 0), cB + kstep, voffB); PG8_STAGE(PG8_SA(1, 0), cA + kstep, voffA); PG8_STAGE(PG8_SB(1, 1), cB + hstep + kstep, voffB);
        PG8_WAIT_V(6); PG8_BAR;
    } else {
        PG8_STAGE(PG8_SB(0, 0), cB, voffB); PG8_STAGE(PG8_SA(0, 0), cA, voffA); PG8_STAGE(PG8_SB(0, 1), cB + hstep, voffB); PG8_STAGE(PG8_SA(0, 1), cA + hstep, voffA);
        if (wr == 1) PG8_BAR;
        PG8_WAIT_V(4); PG8_BAR;
        PG8_STAGE(PG8_SB(1, 0), cB + kstep, voffB); PG8_STAGE(PG8_SA(1, 0), cA + kstep, voffA); PG8_STAGE(PG8_SB(1, 1), cB + hstep + kstep, voffB);
        PG8_WAIT_V(6); PG8_BAR;
    }
    for (;;) {
        const bool has_next = S.next(ui + 1, nxt);
        const char* nA = has_next ? (const char*)g.A + (size_t)nxt.pm * tstep : cA; const char* nB = has_next ? (const char*)g.Bt + (size_t)nxt.pn * tstep : cB;
        for (int t = 0; t < nt; t += 2) {
            const bool last = (t == nt - 2);
            const char* a1 = cA + (size_t)(t + 1) * kstep;
            const char* a2 = last ? nA : cA + (size_t)(t + 2) * kstep; const char* b2 = last ? nB : cB + (size_t)(t + 2) * kstep;
            const char* a3 = a2 + kstep; const char* b3 = b2 + kstep;
            if (last && has_next) S.a_ready(nxt);
            if constexpr (SP2) {
            PG8_LDB(B0, 0, 0); PG8_LDB(B1, 0, 1); PG8_SCHED; PG8_LDA(At, 0, 0); PG8_STAGE(PG8_SA(1, 1), a1 + hstep, voffA);
            PG8_WAIT_V(8); PG8_WAIT_L(0); PG8_BAR; PG8_MMA(0, 0, At, B0); PG8_MMA(0, 1, At, B1); PG8_BAR; PG8_SCHED;
            PG8_LDA(At, 0, 1); PG8_STAGE(PG8_SB(0, 0), b2, voffB); PG8_STAGE(PG8_SB(0, 1), b2 + hstep, voffB); PG8_STAGE(PG8_SA(0, 0), a2, voffA);
            PG8_WAIT_V(8); PG8_WAIT_L(0); PG8_BAR; PG8_MMA(1, 0, At, B0); PG8_MMA(1, 1, At, B1); PG8_BAR; PG8_SCHED;
            PG8_LDB(B0, 1, 0); PG8_LDB(B1, 1, 1); PG8_SCHED; PG8_LDA(At, 1, 0); PG8_STAGE(PG8_SA(0, 1), a2 + hstep, voffA);
            PG8_WAIT_V(8); PG8_WAIT_L(0); PG8_BAR; PG8_MMA(0, 0, At, B0); PG8_MMA(0, 1, At, B1); PG8_BAR; PG8_SCHED;
            PG8_LDA(At, 1, 1); PG8_STAGE(PG8_SB(1, 0), b3, voffB); PG8_STAGE(PG8_SB(1, 1), b3 + hstep, voffB); PG8_STAGE(PG8_SA(1, 0), a3, voffA);
            PG8_WAIT_V(8); PG8_WAIT_L(0); PG8_BAR; PG8_MMA(1, 0, At, B0); PG8_MMA(1, 1, At, B1); PG8_BAR; PG8_SCHED;
            } else {
            PG8_LDB(B0, 0, 0); PG8_SCHED; PG8_LDA(At, 0, 0); PG8_STAGE(PG8_SA(1, 1), a1 + hstep, voffA);
            PG8_WAIT_L(8); PG8_BAR; PG8_WAIT_L(0); PG8_MMA(0, 0, At, B0); PG8_BAR; PG8_SCHED;
            PG8_LDB(B1, 0, 1); PG8_STAGE(PG8_SB(0, 0), b2, voffB);
            PG8_BAR; PG8_WAIT_L(0); PG8_MMA(0, 1, At, B1); PG8_BAR;
            PG8_LDA(At, 0, 1); PG8_STAGE(PG8_SA(0, 0), a2, voffA);
            PG8_BAR; PG8_WAIT_L(0); PG8_MMA(1, 0, At, B0); PG8_BAR; PG8_SCHED;
            PG8_STAGE(PG8_SB(0, 1), b2 + hstep, voffB);
            PG8_WAIT_V(6); PG8_BAR; PG8_MMA(1, 1, At, B1); PG8_BAR;
            PG8_LDB(B0, 1, 0); PG8_SCHED; PG8_LDA(At, 1, 0); PG8_STAGE(PG8_SA(0, 1), a2 + hstep, voffA);
            PG8_WAIT_L(8); PG8_BAR; PG8_WAIT_L(0); PG8_MMA(0, 0, At, B0); PG8_BAR; PG8_SCHED;
            PG8_LDB(B1, 1, 1); PG8_STAGE(PG8_SB(1, 0), b3, voffB);
            PG8_BAR; PG8_WAIT_L(0); PG8_MMA(0, 1, At, B1); PG8_BAR;
            PG8_LDA(At, 1, 1); PG8_STAGE(PG8_SA(1, 0), a3, voffA);
            PG8_BAR; PG8_WAIT_L(0); PG8_MMA(1, 0, At, B0); PG8_BAR; PG8_SCHED;
            PG8_STAGE(PG8_SB(1, 1), b3 + hstep, voffB);
            PG8_WAIT_V(6); PG8_BAR; PG8_MMA(1, 1, At, B1); PG8_BAR;
            }
        }
        if constexpr (ALIGN_EPI) { if (wr == 0) PG8_BAR; }
        if constexpr (!Epi::AFTER_DRAIN) { E(acc, cur, wr, wc, fr, fq); S.done(cur); }
        if (!has_next) break;
#pragma unroll
        for (int a = 0; a < 2; ++a)
#pragma unroll
            for (int b = 0; b < 2; ++b)
#pragma unroll
                for (int m = 0; m < 4; ++m)
#pragma unroll
                    for (int n = 0; n < 2; ++n) acc[a][b][m][n] = (f32x4){0.f, 0.f, 0.f, 0.f};
        cur = nxt; cA = nA; cB = nB; ++ui;
        if constexpr (ALIGN_EPI) { if (wr == 1) PG8_BAR; }
    }
    PG8_WAIT_V(0);
    if constexpr (!ALIGN_EPI) { if (wr == 0) PG8_BAR; }
    PG8_BAR;
    if constexpr (Epi::AFTER_DRAIN) { E.fused(acc, cur, wr, wc, fr, fq, lds, wid, lane); S.done(cur); }
#undef PG8_SA
#undef PG8_SB
#undef PG8_STAGE
#undef PG8_LDA
#undef PG8_LDB
#undef PG8_MMA
#undef PG8_WAIT_V
#undef PG8_WAIT_L
#undef PG8_BAR
#undef PG8_SCHED
}
}

constexpr int NB = 8, T = 2048, D = 1024, M = NB * T, NH = 16, RL = 128, VH = 64, HI = 8, DI = 64, KSEL = 256;
constexpr int A_IN = 2760, A_PAD = 2816, B_IN = 1280, FF = 2816, WIN = 128;
constexpr int NWAVES = 8, NTHREADS = NWAVES * 64;
constexpr int N_PHASES = 13;
#ifndef MK_ONE_LAUNCH
#define MK_ONE_LAUNCH 1
#endif
constexpr size_t MiB = 1u << 20;
constexpr size_t WS_CTL = 0, CTL_ZERO_BYTES = 1 * MiB;
constexpr size_t WS_SS1 = 256 * 1024, WS_SS2 = 320 * 1024, WS_SS3 = 384 * 1024;
constexpr int CW_BAR = 4096;
constexpr size_t WS_RS0 = 1 * MiB;
constexpr size_t WS_WA = 2 * MiB, WS_WUV = WS_WA + (size_t)A_PAD * D * 2, WS_WAO = 8 * MiB, WS_WGU0 = 10 * MiB, WS_WGU1 = 21 * MiB, WS_WD0 = 32 * MiB,
                 WS_WD1 = WS_WD0 + (size_t)D * FF * 2, WS_WB = 43 * MiB, WS_WBO = 46 * MiB;
constexpr size_t WS_XH = 50 * MiB;
constexpr size_t WS_QL = 82 * MiB, WS_CKV = 146 * MiB, WS_CKVN = 154 * MiB, WS_QI = 158 * MiB, WS_KI = 174 * MiB, WS_WI = 176 * MiB, WS_IDX = 178 * MiB, WS_OV = 186 * MiB;
constexpr size_t WS_HB = 82 * MiB, WS_QKV1 = 170 * MiB, WS_OB = 210 * MiB, WS_WCT = 242 * MiB, WS_END = 246 * MiB;
static_assert(WS_WUV + 16 * 64 * 128 * 2 <= WS_WAO && WS_WD1 + (size_t)D * FF * 2 <= WS_WB && WS_WB + (size_t)B_IN * D * 2 <= WS_WBO && WS_WBO + 2 * MiB <= WS_XH, "weights map");
static_assert(WS_HB + (size_t)M * FF * 2 <= WS_QKV1 && WS_QKV1 + (size_t)M * B_IN * 2 <= WS_OB && WS_OB + (size_t)M * D * 2 <= WS_WCT, "activation map");
constexpr int LDS_MISC = 147456, LDS_BYTES = 147456 + 256;

#define GAS __attribute__((address_space(1)))
#define LAS __attribute__((address_space(3)))
typedef unsigned v4u __attribute__((ext_vector_type(4)));
typedef float f32x4 __attribute__((ext_vector_type(4)));
typedef unsigned short hbits;
using pg8::pk2h;

__device__ const unsigned char BUCKET_TAB[129] = {0,1,2,3,4,5,6,7,8,9,10,11,12,13,14,15,16,16,16,17,17,18,18,18,19,19,19,20,20,20,20,21,21,21,21,22,22,22,22,22,23,23,23,23,23,23,24,24,24,24,24,24,25,25,25,25,25,25,25,26,26,26,26,26,26,26,26,27,27,27,27,27,27,27,27,27,27,28,28,28,28,28,28,28,28,28,28,29,29,29,29,29,29,29,29,29,29,29,29,30,30,30,30,30,30,30,30,30,30,30,30,30,30,31,31,31,31,31,31,31,31,31,31,31,31,31,31,31,31};

__device__ __forceinline__ float wave_sum(float v) {
#pragma unroll
    for (int o = 1; o < 64; o <<= 1) v += __shfl_xor(v, o);
    return v;
}
__device__ __forceinline__ float wave_max(float v) {
#pragma unroll
    for (int o = 1; o < 64; o <<= 1) v = fmaxf(v, __shfl_xor(v, o));
    return v;
}
#define LDS_WAIT() asm volatile("s_waitcnt lgkmcnt(0)" ::: "memory")

#define XB_TMO      128
#define XB_XCNT(j)  (256  + 64 * (j))
#define XB_XSUB(j)  (1280 + 64 * (j))
#define XB_XGEN(j)  (2304 + 64 * (j))
#define XB_TOP      3328
#define XB_TOPGEN   3392
#define XCD_BAR_WORDS 3456
#define XB_SPIN_CAP (1u << 18)

__device__ __forceinline__ unsigned xb_ld(unsigned* p)              { return __hip_atomic_load(p, __ATOMIC_RELAXED, __HIP_MEMORY_SCOPE_AGENT); }
__device__ __forceinline__ unsigned xb_add(unsigned* p, unsigned v) { return __hip_atomic_fetch_add(p, v, __ATOMIC_RELAXED, __HIP_MEMORY_SCOPE_AGENT); }
__device__ __forceinline__ unsigned xb_xcc_id() { return (unsigned)__builtin_amdgcn_s_getreg((3 << 11) | 20) & 0xFu; }
#define XB_SPIN(cond, bar) do { unsigned _sp = 0; while (cond) { __builtin_amdgcn_s_sleep(1); \
    if ((++_sp & 255u) == 0u) { if (xb_ld(&(bar)[XB_TMO])) break; if (_sp > XB_SPIN_CAP) { atomicAdd(&(bar)[XB_TMO], 1u); break; } } } } while (0)

struct XcdBarrier {
    unsigned* bar; unsigned x;
    volatile LAS unsigned* st;
};

__device__ __forceinline__ XcdBarrier xcd_barrier_post(unsigned* bar, volatile LAS unsigned* st) {
    XcdBarrier b; b.bar = bar; b.x = xb_xcc_id(); b.st = st;
    if (threadIdx.x == 0) (void)xb_add(&bar[XB_XCNT(b.x)], 1u);
    return b;
}
__device__ __forceinline__ void xcd_barrier_complete(unsigned* bar, unsigned x, unsigned& nloc, unsigned& nx) {
    const unsigned G = gridDim.x * gridDim.y * gridDim.z;
    unsigned sum, cnt, mine, sp = 0u;
    for (;;) {
        sum = 0u; cnt = 0u; mine = 0u;
#pragma unroll
        for (unsigned j = 0; j < 16; ++j) { const unsigned c = xb_ld(&bar[XB_XCNT(j)]); sum += c; cnt += (c > 0u) ? 1u : 0u; mine = (j == x) ? c : mine; }
        if (sum == G) break;
        __builtin_amdgcn_s_sleep(1);
        if ((++sp & 255u) == 0u) { if (xb_ld(&bar[XB_TMO])) break; if (sp > XB_SPIN_CAP) { atomicAdd(&bar[XB_TMO], 1u); break; } }
    }
    nloc = mine > 0u ? mine : 1u; nx = cnt > 0u ? cnt : 1u;
}

__device__ __forceinline__ void xcd_barrier(const XcdBarrier& b) {
    asm volatile("s_waitcnt vmcnt(0)" ::: "memory");
    __syncthreads();
    if (threadIdx.x == 0) {
        unsigned* bar = b.bar;
        __builtin_amdgcn_s_waitcnt(0);
        unsigned nloc = b.st[0], nx = b.st[1];
        if (nloc == 0u) { xcd_barrier_complete(bar, b.x, nloc, nx); b.st[0] = nloc; b.st[1] = nx; }
        const unsigned old = xb_add(&bar[XB_XSUB(b.x)], 1u);
        const unsigned gen = old / nloc;
        if (old + 1u == (gen + 1u) * nloc) {
            __builtin_amdgcn_fence(__ATOMIC_RELEASE, "agent");
            asm volatile("s_waitcnt vmcnt(0)" ::: "memory");
            const unsigned og = xb_add(&bar[XB_TOP], 1u);
            const unsigned tg = og / nx;
            if (og + 1u == (tg + 1u) * nx) xb_add(&bar[XB_TOPGEN], 1u);
            else XB_SPIN(xb_ld(&bar[XB_TOPGEN]) == tg, bar);
            __builtin_amdgcn_fence(__ATOMIC_ACQUIRE, "agent");
            xb_add(&bar[XB_XGEN(b.x)], 1u);
            asm volatile("s_waitcnt vmcnt(0)" ::: "memory");
        } else {
            XB_SPIN(xb_ld(&bar[XB_XGEN(b.x)]) == gen, bar);
            __builtin_amdgcn_fence(__ATOMIC_ACQUIRE, "agent");
            asm volatile("s_waitcnt vmcnt(0)" ::: "memory");
        }
    }
    __syncthreads();
}

struct Frame {
    LAS unsigned char* lds;
    int tid, lane, wave, G, bid;
    const float* in[16]; float* out; unsigned char* ws;
};

__device__ __forceinline__ void tr_item(const float* W, int ldw, int nvalid, const float* gain, hbits* WT, int K, int k0, int n0s, int n0d, LAS float* scr, int lane) {
#pragma unroll 8
    for (int i = 0; i < 32; ++i) { const int kk = 2 * i + (lane >> 5), n = n0s + (lane & 31);
        float v = (n < nvalid) ? W[(size_t)(k0 + kk) * ldw + n] : 0.f; if (gain) v *= gain[k0 + kk]; scr[kk * 33 + (lane & 31)] = v; }
    LDS_WAIT(); asm volatile("" ::: "memory");
    const int c = lane & 7;
#pragma unroll
    for (int j = 0; j < 4; ++j) { const int n = (lane >> 3) + 8 * j; const LAS float* s = scr + (8 * c) * 33 + n;
        v4u o; o.x = pk2h(s[0 * 33], s[1 * 33]); o.y = pk2h(s[2 * 33], s[3 * 33]); o.z = pk2h(s[4 * 33], s[5 * 33]); o.w = pk2h(s[6 * 33], s[7 * 33]);
        *(GAS v4u*)(WT + (size_t)(n0d + n) * K + k0 + 8 * c) = o; }
    LDS_WAIT(); asm volatile("" ::: "memory");
}
__device__ __forceinline__ void p0_prologue(Frame& F) {
    LAS float* scr = (LAS float*)(F.lds + F.wave * 16384);
    const int gw = F.bid * NWAVES + F.wave, NGW = F.G * NWAVES;
    hbits* WA = (hbits*)(F.ws + WS_WA); hbits* WUV = (hbits*)(F.ws + WS_WUV); hbits* WAO = (hbits*)(F.ws + WS_WAO);
    hbits* WB = (hbits*)(F.ws + WS_WB); hbits* WBO = (hbits*)(F.ws + WS_WBO);
    constexpr int I_WA = 16 * (A_PAD / 32), I_UV = 64, I_SQ = 16 * 32, I_GU = 16 * (2 * FF / 32), I_D = (FF / 64) * 32, I_WB = 16 * (B_IN / 32);
    constexpr int NITEMS = I_WA + I_UV + I_SQ + 2 * I_GU + 2 * I_D + I_WB + I_SQ;
    for (int it = gw; it < NITEMS; it += NGW) {
        int r = it;
        if (r < I_WA) { const int nnb = A_PAD / 32, kb = r / nnb, nb = r % nnb; tr_item(F.in[5], A_IN, A_IN, F.in[2], WA, D, 64 * kb, 32 * nb, 32 * nb, scr, F.lane); continue; } r -= I_WA;
        if (r < I_UV) { const int h = r >> 2, kb = (r >> 1) & 1, nb = r & 1; tr_item(F.in[7] + (size_t)h * RL * VH, VH, VH, nullptr, WUV + (size_t)h * VH * RL, RL, 64 * kb, 32 * nb, 32 * nb, scr, F.lane); continue; } r -= I_UV;
        if (r < I_SQ) { const int kb = r / 32, nb = r % 32; tr_item(F.in[8], D, D, nullptr, WAO, D, 64 * kb, 32 * nb, 32 * nb, scr, F.lane); continue; } r -= I_SQ;
        if (r < 2 * I_GU) { const int l = r / I_GU; r -= l * I_GU; const int nnb = 2 * FF / 32, kb = r / nnb, nb = r % nnb; const int c = 32 * nb;
            const int nd = (c < FF) ? ((c / 128) * 256 + (c % 128)) : (((c - FF) / 128) * 256 + 128 + ((c - FF) % 128));
            tr_item(F.in[14] + (size_t)l * D * 2 * FF, 2 * FF, 2 * FF, F.in[3] + l * D, (hbits*)(F.ws + (l ? WS_WGU1 : WS_WGU0)), D, 64 * kb, c, nd, scr, F.lane); continue; } r -= 2 * I_GU;
        if (r < 2 * I_D) { const int l = r / I_D; r -= l * I_D; const int kb = r / 32, nb = r % 32;
            tr_item(F.in[15] + (size_t)l * FF * D, D, D, nullptr, (hbits*)(F.ws + (l ? WS_WD1 : WS_WD0)), FF, 64 * kb, 32 * nb, 32 * nb, scr, F.lane); continue; } r -= 2 * I_D;
        if (r < I_WB) { const int nnb = B_IN / 32, kb = r / nnb, nb = r % nnb; tr_item(F.in[9], B_IN, B_IN, F.in[2] + D, WB, D, 64 * kb, 32 * nb, 32 * nb, scr, F.lane); continue; } r -= I_WB;
        { const int kb = r / 32, nb = r % 32; tr_item(F.in[12], D, D, nullptr, WBO, D, 64 * kb, 32 * nb, 32 * nb, scr, F.lane); }
    }
    { const float* w_uv = F.in[7]; const float* w_out = F.in[8]; hbits* WCT = (hbits*)(F.ws + WS_WCT);
      for (int it = gw; it < 1024; it += NGW) { const int h = it >> 6, dblk = (it >> 2) & 15, rblk = it & 3, d = dblk * 64 + F.lane;
          float wo[64];
#pragma unroll
          for (int v = 0; v < 64; ++v) wo[v] = w_out[(size_t)(h * 64 + v) * D + d];
          for (int r8 = 0; r8 < 4; ++r8) { float acc[8];
#pragma unroll
              for (int rr = 0; rr < 8; ++rr) { const float* u = w_uv + (size_t)(h * RL + rblk * 32 + r8 * 8 + rr) * VH; float sacc = 0.f;
#pragma unroll
                  for (int v = 0; v < 64; ++v) sacc = fmaf(u[v], wo[v], sacc);
                  acc[rr] = sacc; }
              v4u o; o.x = pk2h(acc[0], acc[1]); o.y = pk2h(acc[2], acc[3]); o.z = pk2h(acc[4], acc[5]); o.w = pk2h(acc[6], acc[7]);
              *(GAS v4u*)(WCT + (size_t)d * (NH * RL) + h * RL + rblk * 32 + r8 * 8) = o; } } }
    const float* x = F.in[0]; hbits* XH = (hbits*)(F.ws + WS_XH); float* RS0 = (float*)(F.ws + WS_RS0);
    for (int m = gw; m < M; m += NGW) {
        const GAS f32x4* xr = (const GAS f32x4*)(x + (size_t)m * D) + F.lane;
        f32x4 v[4]; float s = 0.f;
#pragma unroll
        for (int j = 0; j < 4; ++j) { v[j] = xr[64 * j]; s += (v[j].x * v[j].x + v[j].y * v[j].y) + (v[j].z * v[j].z + v[j].w * v[j].w); }
        s = wave_sum(s);
        if (F.lane == 0) RS0[m] = 1.0f / sqrtf(s * (1.0f / D) + pg8::RMS_EPS);
        GAS unsigned long long* o8 = (GAS unsigned long long*)(XH + (size_t)m * D) + F.lane;
#pragma unroll
        for (int j = 0; j < 4; ++j) o8[64 * j] = (unsigned long long)pk2h(v[j].x, v[j].y) | ((unsigned long long)pk2h(v[j].z, v[j].w) << 32);
    }
}

__device__ __forceinline__ unsigned okey(float f) { const unsigned u = __builtin_bit_cast(unsigned, f); return (u & 0x80000000u) ? ~u : (u | 0x80000000u); }
__device__ __forceinline__ void select_topk(const LAS float* sc, int t, unsigned short* idxrow, int lane) {
    const unsigned long long lt_mask = (1ull << lane) - 1ull;
    unsigned key[32];
#pragma unroll
    for (int q = 0; q < 32; ++q) { const int s = lane + 64 * q; key[q] = (s <= t) ? okey(sc[s]) : 0u; }
    unsigned prefix = 0u;
    for (int bit = 31; bit >= 0; --bit) { const unsigned cand = prefix | (1u << bit); int cnt = 0;
#pragma unroll
        for (int q = 0; q < 32; ++q) cnt += __builtin_popcountll(__ballot(key[q] >= cand));
        if (cnt >= KSEL) prefix = cand; }
    int ngt = 0;
#pragma unroll
    for (int q = 0; q < 32; ++q) ngt += __builtin_popcountll(__ballot(key[q] > prefix));
    const int need = KSEL - ngt; int eq_seen = 0, pos = 0;
#pragma unroll
    for (int q = 0; q < 32; ++q) { const bool gt = key[q] > prefix, eq = key[q] == prefix;
        const unsigned long long meq = __ballot(eq); const bool take = eq && (eq_seen + __builtin_popcountll(meq & lt_mask) < need); eq_seen += __builtin_popcountll(meq);
        const bool sel = gt || take; const unsigned long long ms = __ballot(sel);
        if (sel) idxrow[pos + __builtin_popcountll(ms & lt_mask)] = (unsigned short)(lane + 64 * q);
        pos += __builtin_popcountll(ms); }
}
__device__ __forceinline__ void p2_indexer(Frame& F) {
    const int gw = F.bid * NWAVES + F.wave, NGW = F.G * NWAVES, lane = F.lane, tid = F.tid, wave = F.wave;
    { const float* CKV = (const float*)(F.ws + WS_CKV); hbits* CKVN = (hbits*)(F.ws + WS_CKVN); const float* lg = F.in[6];
      for (int m = gw; m < M; m += NGW) { const float a = CKV[(size_t)m * RL + 2 * lane], b = CKV[(size_t)m * RL + 2 * lane + 1];
          const float s = wave_sum(a * a + b * b); const float r = 1.0f / sqrtf(s * (1.0f / RL) + pg8::RMS_EPS);
          *(unsigned*)(CKVN + (size_t)m * RL + 2 * lane) = pk2h(a * r * lg[2 * lane], b * r * lg[2 * lane + 1]); } }
    LAS float* scb = (LAS float*)F.lds;
    LAS unsigned char* kst = F.lds + 131072;
    const hbits* QI = (const hbits*)(F.ws + WS_QI); const hbits* KI = (const hbits*)(F.ws + WS_KI); const float* WI = (const float*)(F.ws + WS_WI);
    unsigned short* IDX = (unsigned short*)(F.ws + WS_IDX);
    const int a = lane & 15, q = lane >> 4, lrow = tid >> 3, lch = tid & 7;
    int boff[2];
#pragma unroll
    for (int s = 0; s < 2; ++s) boff[s] = a * 128 + 16 * ((4 * s + q) ^ ((a >> 1) & 7));
    const int wst = lrow * 128 + 16 * (lch ^ ((lrow >> 1) & 7));
    for (int pu = 0; pu < 2 * ((NB * 64 - F.bid + F.G - 1) / F.G); ++pu) {
        const int p = F.bid + F.G * (pu >> 1), b = p >> 6, j = (pu & 1) ? 127 - (p & 63) : (p & 63), t0 = 16 * j; const size_t tokbase = (size_t)b * T + t0;
        if (t0 < KSEL) {
#pragma unroll
            for (int tt = 0; tt < 2; ++tt) { const int t = t0 + 2 * wave + tt;
#pragma unroll
                for (int jj = 0; jj < 4; ++jj) { const int k = 4 * lane + jj; IDX[(tokbase + 2 * wave + tt) * KSEL + k] = (unsigned short)((k < t) ? k : t); } }
            continue; }
        const int ns = (t0 + 16 + 63) >> 6;
        f16x8 af[2];
#pragma unroll
        for (int s = 0; s < 2; ++s) af[s] = __builtin_bit_cast(f16x8, *(const v4u*)(QI + (tokbase + 2 * wave + (a >> 3)) * 512 + (a & 7) * 64 + 32 * s + 8 * q));
        const f32x4 w4 = *(const f32x4*)(WI + (tokbase + 2 * wave + (q >> 1)) * 8 + 4 * (q & 1));
        LAS float* myrow = scb + (2 * wave + (q >> 1)) * 2048 + a;
        v4u stg = *(const v4u*)(KI + ((size_t)b * T + lrow) * DI + 8 * lch);
        for (int st = 0; st < ns; ++st) {
            LAS unsigned char* buf = kst + (st & 1) * 8192;
            *(LAS v4u*)(buf + wst) = stg;
            __syncthreads();
            if (st + 1 < ns) stg = *(const v4u*)(KI + ((size_t)b * T + 64 * (st + 1) + lrow) * DI + 8 * lch);
#pragma unroll
            for (int kt = 0; kt < 4; ++kt) { f32x4 acc = (f32x4){0.f, 0.f, 0.f, 0.f};
#pragma unroll
                for (int s = 0; s < 2; ++s) { const f16x8 bf = __builtin_bit_cast(f16x8, *(const LAS v4u*)(buf + boff[s] + 2048 * kt));
                    acc = __builtin_amdgcn_mfma_f32_16x16x32_f16(af[s], bf, acc, 0, 0, 0); }
                float part = w4[0] * fmaxf(acc[0], 0.f); part = fmaf(w4[1], fmaxf(acc[1], 0.f), part); part = fmaf(w4[2], fmaxf(acc[2], 0.f), part); part = fmaf(w4[3], fmaxf(acc[3], 0.f), part);
                const float full = part + __shfl_xor(part, 16);
                if ((q & 1) == 0) myrow[64 * st + 16 * kt] = full; }
        }
        LDS_WAIT(); asm volatile("" ::: "memory");
#pragma unroll 1
        for (int tt = 0; tt < 2; ++tt) select_topk(scb + (2 * wave + tt) * 2048, t0 + 2 * wave + tt, IDX + (tokbase + 2 * wave + tt) * KSEL, lane);
        __syncthreads();
    }
}

typedef short v4i16_t __attribute__((ext_vector_type(4)));
__device__ __forceinline__ int swz_x(int row) { return ((row & 3) << 2) | ((row >> 2) & 3); }
__device__ __forceinline__ void p3_sparse_attn(Frame& F) {
    const int lane = F.lane, wave = F.wave, gw = F.bid * NWAVES + wave, NGW = F.G * NWAVES;
    const int a = lane & 15, q = lane >> 4, sq = ((q & 1) << 1) | (q >> 1);
    LAS unsigned char* kvb = F.lds + wave * 16384;
    LAS unsigned short* idl = (LAS unsigned short*)(F.lds + 131072 + wave * 512);
    LAS float* bt = (LAS float*)(F.lds + 135168);
    const float* rel_bias = F.in[1];
    hbits* QL = (hbits*)(F.ws + WS_QL); const hbits* CKVN = (const hbits*)(F.ws + WS_CKVN); const unsigned short* IDX = (const unsigned short*)(F.ws + WS_IDX);
    for (int i = F.tid; i < 129 * 16; i += NTHREADS) bt[i] = rel_bias[(int)BUCKET_TAB[i >> 4] * 16 + (i & 15)] * pg8::LOG2E;
    __syncthreads();
    const int arow = 4 * ((((a >> 2) & 1) << 1) | (a >> 3)) + (a & 3), xa = swz_x(arow);
    int aoff[4];
#pragma unroll
    for (int s = 0; s < 4; ++s) aoff[s] = 256 * arow + 16 * ((4 * s + q) ^ xa);
    const int trow = 4 * sq + (a >> 2), xt = swz_x(trow);
    int toff[8];
#pragma unroll
    for (int nt = 0; nt < 8; ++nt) toff[nt] = 256 * trow + 16 * ((2 * nt + ((a >> 1) & 1)) ^ xt) + 8 * (a & 1);
    const int drow = lane >> 4;
    for (int i = 0; i * NGW < M; ++i) {
        const int tok = gw + NGW * i; if (tok >= M) break;
        const int b = tok >> 11, t = tok & (T - 1); const int n = (t + 1 < KSEL) ? t + 1 : KSEL, nc = (n + 31) >> 5;
        { const unsigned long long v = *(const unsigned long long*)(IDX + (size_t)tok * KSEL + 4 * lane); *(LAS unsigned long long*)(idl + 4 * lane) = v; }
        f16x8 qf[4];
#pragma unroll
        for (int s = 0; s < 4; ++s) qf[s] = __builtin_bit_cast(f16x8, *(const v4u*)(QL + (size_t)tok * (NH * RL) + a * RL + 32 * s + 8 * q));
        LDS_WAIT(); asm volatile("" ::: "memory");
        const hbits* kvbase = CKVN + (size_t)b * T * RL;
#define P3_DMA(c, buf) do { _Pragma("unroll") for (int g = 0; g < 8; ++g) { const int row = 4 * g + drow; const int key = idl[32 * (c) + row]; \
            __builtin_amdgcn_global_load_lds((const unsigned*)(kvbase + (size_t)key * RL + 8 * ((lane & 15) ^ swz_x(row))), (LAS unsigned*)(kvb + (buf) * 8192 + g * 1024), 16, 0, 0); } } while (0)
        P3_DMA(0, 0);
        float m = -INFINITY, l = 0.f; f32x4 o[8];
#pragma unroll
        for (int nt = 0; nt < 8; ++nt) o[nt] = (f32x4){0.f, 0.f, 0.f, 0.f};
        for (int c = 0; c < nc; ++c) {
            LAS unsigned char* cur = kvb + (c & 1) * 8192;
            if (c + 1 < nc) { LDS_WAIT(); asm volatile("" ::: "memory"); P3_DMA(c + 1, (c + 1) & 1); asm volatile("s_waitcnt vmcnt(8)" ::: "memory"); }
            else { asm volatile("s_waitcnt vmcnt(0)" ::: "memory"); }
            f32x4 s0 = (f32x4){0.f, 0.f, 0.f, 0.f}, s1 = (f32x4){0.f, 0.f, 0.f, 0.f};
#pragma unroll
            for (int s = 0; s < 4; ++s) { const f16x8 k0 = __builtin_bit_cast(f16x8, *(const LAS v4u*)(cur + aoff[s])), k1 = __builtin_bit_cast(f16x8, *(const LAS v4u*)(cur + 4096 + aoff[s]));
                s0 = __builtin_amdgcn_mfma_f32_16x16x32_f16(k0, qf[s], s0, 0, 0, 0); s1 = __builtin_amdgcn_mfma_f32_16x16x32_f16(k1, qf[s], s1, 0, 0, 0); }
            { const unsigned long long i0 = *(const LAS unsigned long long*)(idl + 32 * c + 4 * sq), i1 = *(const LAS unsigned long long*)(idl + 32 * c + 16 + 4 * sq);
#pragma unroll
              for (int r = 0; r < 4; ++r) { const int k0 = (int)((i0 >> (16 * r)) & 0xffffu), k1 = (int)((i1 >> (16 * r)) & 0xffffu);
                  const int r0 = t - k0, r1 = t - k1;
                  s0[r] += bt[(((unsigned)r0 < 128u) ? r0 : 128) * 16 + a]; s1[r] += bt[(((unsigned)r1 < 128u) ? r1 : 128) * 16 + a];
                  if (32 * c + 4 * sq + r >= n) s0[r] = -INFINITY;
                  if (32 * c + 16 + 4 * sq + r >= n) s1[r] = -INFINITY; } }
            float cm = fmaxf(fmaxf(fmaxf(s0[0], s0[1]), fmaxf(s0[2], s0[3])), fmaxf(fmaxf(s1[0], s1[1]), fmaxf(s1[2], s1[3])));
            cm = fmaxf(cm, __shfl_xor(cm, 16)); cm = fmaxf(cm, __shfl_xor(cm, 32));
            const float mn = fmaxf(m, cm), alpha = __builtin_amdgcn_exp2f(m - mn); m = mn;
            float ps = 0.f;
#pragma unroll
            for (int r = 0; r < 4; ++r) { s0[r] = __builtin_amdgcn_exp2f(s0[r] - mn); s1[r] = __builtin_amdgcn_exp2f(s1[r] - mn); ps += s0[r] + s1[r]; }
            l = l * alpha + ps;
#pragma unroll
            for (int nt = 0; nt < 8; ++nt) o[nt] = o[nt] * alpha;
            v4u pw; pw.x = pk2h(s0[0], s0[1]); pw.y = pk2h(s0[2], s0[3]); pw.z = pk2h(s1[0], s1[1]); pw.w = pk2h(s1[2], s1[3]);
            const f16x8 pfr = __builtin_bit_cast(f16x8, pw);
#pragma unroll
            for (int nt = 0; nt < 8; ++nt) {
                const v4i16_t t0 = __builtin_amdgcn_ds_read_tr16_b64_v4i16((LAS v4i16_t*)(cur + toff[nt])), t1 = __builtin_amdgcn_ds_read_tr16_b64_v4i16((LAS v4i16_t*)(cur + 4096 + toff[nt]));
                typedef short v8i16_t __attribute__((ext_vector_type(8)));
                const v8i16_t tv = {t0[0], t0[1], t0[2], t0[3], t1[0], t1[1], t1[2], t1[3]};
                o[nt] = __builtin_amdgcn_mfma_f32_16x16x32_f16(__builtin_bit_cast(f16x8, tv), pfr, o[nt], 0, 0, 0); }
        }
        l += __shfl_xor(l, 16); l += __shfl_xor(l, 32);
        const float inv = 1.0f / l;
        hbits* orow = QL + (size_t)tok * (NH * RL) + a * RL + 4 * q;
#pragma unroll
        for (int nt = 0; nt < 8; ++nt) { const unsigned long long w = (unsigned long long)pk2h(o[nt][0] * inv, o[nt][1] * inv) | ((unsigned long long)pk2h(o[nt][2] * inv, o[nt][3] * inv) << 32);
            *(unsigned long long*)(orow + 16 * nt) = w; }
        LDS_WAIT(); asm volatile("" ::: "memory");
#undef P3_DMA
    }
}

typedef float f32x16 __attribute__((ext_vector_type(16)));
constexpr float SWA_QSCALE = 0.125f * 1.4426950408889634f;
__device__ __forceinline__ void p8_swa(Frame& F) {
    const int tid = F.tid, lane = F.lane, wave = F.wave, r32 = lane & 31, hh = lane >> 5;
    LAS unsigned char* Ks = F.lds;
    LAS unsigned char* Vs = F.lds + 20480;
    LAS float* btr = (LAS float*)(F.lds + 40960);
    const float* rel_bias = F.in[1]; const float* sinks = F.in[11];
    const hbits* QKV = (const hbits*)(F.ws + WS_QKV1); hbits* OB = (hbits*)(F.ws + WS_OB);
    for (int i = tid; i < 192 * 16; i += NTHREADS) { const int rel = 159 - (i >> 4); btr[i] = (rel >= 0 && rel < 128) ? rel_bias[(int)BUCKET_TAB[rel] * 16 + (i & 15)] * pg8::LOG2E : 0.f; }
    const int lrow = tid >> 3, lch = tid & 7;
    const int g = lane >> 4, dh = g & 1, ti = lane & 15, tr_r = ti >> 2, tr_p = ti & 3;
    int kbase[4], vbase[2];
#pragma unroll
    for (int s = 0; s < 4; ++s) kbase[s] = r32 * 128 + 16 * ((2 * s + hh) ^ ((r32 >> 1) & 7));
#pragma unroll
    for (int dt = 0; dt < 2; ++dt) vbase[dt] = (4 * hh + tr_r) * 128 + 16 * ((4 * dt + 2 * dh + (tr_p >> 1)) ^ (((tr_r >> 1) & 1) << 2)) + 8 * (tr_p & 1);
    for (int u = F.bid; u < NB * 2 * (T / 32); u += F.G) {
        const int qt = u & 63, kvh = (u >> 6) & 1, b = u >> 7, t0 = 32 * qt, head = kvh * 8 + wave;
        __syncthreads();
#pragma unroll
        for (int p = 0; p < 3; ++p) { const int row = lrow + 64 * p;
            if (row < 160) { const int key = t0 - 128 + row; v4u kv = (v4u){0u, 0u, 0u, 0u}, vv = (v4u){0u, 0u, 0u, 0u};
                if (key >= 0) { const hbits* base = QKV + ((size_t)b * T + key) * B_IN; kv = *(const v4u*)(base + 1024 + kvh * 64 + 8 * lch); vv = *(const v4u*)(base + 1152 + kvh * 64 + 8 * lch); }
                *(LAS v4u*)(Ks + row * 128 + 16 * (lch ^ ((row >> 1) & 7))) = kv; *(LAS v4u*)(Vs + row * 128 + 16 * (lch ^ (((row >> 1) & 1) << 2))) = vv; } }
        f16x8 qf[4];
#pragma unroll
        for (int s = 0; s < 4; ++s) qf[s] = __builtin_bit_cast(f16x8, *(const v4u*)(QKV + ((size_t)b * T + t0 + r32) * B_IN + head * 64 + 16 * s + 8 * hh));
        __syncthreads();
        f32x16 S[5];
#pragma unroll
        for (int kt = 0; kt < 5; ++kt) {
#pragma unroll
            for (int r = 0; r < 16; ++r) S[kt][r] = 0.f;
#pragma unroll
            for (int s = 0; s < 4; ++s) { const f16x8 kf = __builtin_bit_cast(f16x8, *(const LAS v4u*)(Ks + kbase[s] + kt * 4096));
                S[kt] = __builtin_amdgcn_mfma_f32_32x32x16_f16(kf, qf[s], S[kt], 0, 0, 0); } }
        const float sink2 = sinks[head] * pg8::LOG2E; float m = sink2;
        int base = 128 + r32 - 4 * hh; asm volatile("" : "+v"(base));
        const LAS float* btl = btr + (159 - base) * 16 + head;
        const int kmin = 128 - t0 - 4 * hh;
#pragma unroll
        for (int kt = 0; kt < 5; ++kt)
#pragma unroll
            for (int r = 0; r < 16; ++r) { const int c = 32 * kt + (r & 3) + 8 * (r >> 2); const int rel = base - c;
                const bool valid = ((unsigned)rel < 128u) && (c >= kmin);
                const float v = valid ? S[kt][r] + btl[c * 16] : -INFINITY; S[kt][r] = v; m = fmaxf(m, v); }
        m = fmaxf(m, __shfl_xor(m, 32));
        float l = 0.f;
#pragma unroll
        for (int kt = 0; kt < 5; ++kt)
#pragma unroll
            for (int r = 0; r < 16; ++r) { const float p = __builtin_amdgcn_exp2f(S[kt][r] - m); S[kt][r] = p; l += p; }
        l += __shfl_xor(l, 32); l += __builtin_amdgcn_exp2f(sink2 - m);
        const float inv = 1.0f / l;
        f32x16 O[2];
#pragma unroll
        for (int dt = 0; dt < 2; ++dt)
#pragma unroll
            for (int r = 0; r < 16; ++r) O[dt][r] = 0.f;
#pragma unroll
        for (int kt = 0; kt < 5; ++kt)
#pragma unroll
            for (int s = 0; s < 2; ++s) { v4u pw; pw.x = pk2h(S[kt][8 * s + 0], S[kt][8 * s + 1]); pw.y = pk2h(S[kt][8 * s + 2], S[kt][8 * s + 3]); pw.z = pk2h(S[kt][8 * s + 4], S[kt][8 * s + 5]); pw.w = pk2h(S[kt][8 * s + 6], S[kt][8 * s + 7]);
                const f16x8 pfr = __builtin_bit_cast(f16x8, pw);
#pragma unroll
                for (int dt = 0; dt < 2; ++dt) {
                    const v4i16_t t1 = __builtin_amdgcn_ds_read_tr16_b64_v4i16((LAS v4i16_t*)(Vs + vbase[dt] + (32 * kt + 16 * s) * 128));
                    const v4i16_t t2 = __builtin_amdgcn_ds_read_tr16_b64_v4i16((LAS v4i16_t*)(Vs + vbase[dt] + (32 * kt + 16 * s + 8) * 128));
                    typedef short v8i16_t __attribute__((ext_vector_type(8)));
                    const v8i16_t tv = {t1[0], t1[1], t1[2], t1[3], t2[0], t2[1], t2[2], t2[3]};
                    O[dt] = __builtin_amdgcn_mfma_f32_32x32x16_f16(__builtin_bit_cast(f16x8, tv), pfr, O[dt], 0, 0, 0); }
                __builtin_amdgcn_sched_barrier(0); }
        hbits* orow = OB + ((size_t)b * T + t0 + r32) * D + head * 64 + 4 * hh;
#pragma unroll
        for (int dt = 0; dt < 2; ++dt)
#pragma unroll
            for (int g4 = 0; g4 < 4; ++g4) { const unsigned long long w = (unsigned long long)pk2h(O[dt][4 * g4] * inv, O[dt][4 * g4 + 1] * inv) | ((unsigned long long)pk2h(O[dt][4 * g4 + 2] * inv, O[dt][4 * g4 + 3] * inv) << 32);
                *(unsigned long long*)(orow + 32 * dt + 8 * g4) = w; }
    }
}

__device__ __forceinline__ void p12_final(Frame& F) {
    const int gw = F.bid * NWAVES + F.wave, NGW = F.G * NWAVES; const float* g = F.in[4];
    for (int m = gw; m < M; m += NGW) {
        GAS f32x4* xr = (GAS f32x4*)(F.out + (size_t)m * D) + F.lane;
        f32x4 v[4]; float s = 0.f;
#pragma unroll
        for (int j = 0; j < 4; ++j) { v[j] = xr[64 * j]; s += (v[j].x * v[j].x + v[j].y * v[j].y) + (v[j].z * v[j].z + v[j].w * v[j].w); }
        const float r = 1.0f / sqrtf(wave_sum(s) * (1.0f / D) + pg8::RMS_EPS);
#pragma unroll
        for (int j = 0; j < 4; ++j) { const f32x4 gv = *((const f32x4*)g + F.lane + 64 * j); xr[64 * j] = v[j] * r * gv; }
    }
}

struct Args { const float* in[16]; float* out; unsigned char* ws; int ph_lo, ph_hi; };
template <bool COOP>
__global__ void __launch_bounds__(NTHREADS, 2) fwd(Args args) {
    extern __shared__ __attribute__((aligned(16))) unsigned char lds[];
    Frame F;
    F.lds = (LAS unsigned char*)lds; F.tid = threadIdx.x; F.lane = F.tid & 63; F.wave = __builtin_amdgcn_readfirstlane(F.tid >> 6);
    F.G = gridDim.x; F.bid = blockIdx.x;
#pragma unroll
    for (int i = 0; i < 16; ++i) F.in[i] = args.in[i];
    F.out = args.out; F.ws = args.ws;
    unsigned char* ws = args.ws;
    const int lo = args.ph_lo, hi = args.ph_hi;
#define IN(k) (lo <= (k) && (k) < hi)
    XcdBarrier bar; bar.bar = (unsigned*)(ws + WS_CTL) + CW_BAR; bar.x = 0; bar.st = nullptr;
    if constexpr (COOP) {
        volatile LAS unsigned* misc = (volatile LAS unsigned*)(F.lds + LDS_MISC);
        if (F.tid < 64) misc[F.tid] = 0u;
        __syncthreads();
        bar = xcd_barrier_post((unsigned*)(ws + WS_CTL) + CW_BAR, misc);
    }
#define SEAM(k) do { if constexpr (COOP) { if (IN(k) && IN((k) + 1)) xcd_barrier(bar); } } while (0)
    typedef pg8::bf16_t hb;
    float* SS1 = (float*)(ws + WS_SS1); float* SS2 = (float*)(ws + WS_SS2); float* SS3 = (float*)(ws + WS_SS3);
    hb* XH = (hb*)(ws + WS_XH);

    if (IN(0)) { p0_prologue(F); } SEAM(0);
    if (IN(1)) {
        pg8::Gemm g{XH, (const hb*)(ws + WS_WA), M, A_PAD, D}; pg8::StaticOrder S; S.init(M, A_PAD, F.G, F.bid);
        pg8::EpiInA E{(const float*)(ws + WS_RS0), (hb*)(ws + WS_QL), (float*)(ws + WS_CKV), (hb*)(ws + WS_QI), (hb*)(ws + WS_KI), (float*)(ws + WS_WI)};
        pg8::gemm_phase<pg8::EpiInA, pg8::StaticOrder, true, true>(F.lds, g, S, E);
    } SEAM(1);
    if (IN(2)) { p2_indexer(F); } SEAM(2);
    if (IN(3)) { p3_sparse_attn(F); } SEAM(3);
    if (IN(4)) {
        pg8::Gemm g{(const hb*)(ws + WS_QL), (const hb*)(ws + WS_WCT), M, D, NH * RL}; pg8::StaticOrder S; S.init(M, D, F.G, F.bid);
        pg8::EpiRes E{F.in[0], F.out, XH, SS1, nullptr};
        pg8::gemm_phase<pg8::EpiRes, pg8::StaticOrder, true, true>(F.lds, g, S, E);
    } SEAM(4);
    if (IN(5)) {
        pg8::Gemm g{XH, (const hb*)(ws + WS_WGU0), M, 2 * FF, D}; pg8::StaticOrder S; S.init(M, 2 * FF, F.G, F.bid);
        pg8::EpiGU E{SS1, (hb*)(ws + WS_HB)};
        pg8::gemm_phase<pg8::EpiGU, pg8::StaticOrder, true, true>(F.lds, g, S, E);
    } SEAM(5);
    if (IN(6)) {
        pg8::Gemm g{(const hb*)(ws + WS_HB), (const hb*)(ws + WS_WD0), M, D, FF}; pg8::StaticOrder S; S.init(M, D, F.G, F.bid);
        pg8::EpiRes E{F.out, F.out, XH, SS2, nullptr};
        pg8::gemm_phase<pg8::EpiRes, pg8::StaticOrder, true, true>(F.lds, g, S, E);
    } SEAM(6);
    if (IN(7)) {
        pg8::Gemm g{XH, (const hb*)(ws + WS_WB), M, B_IN, D}; pg8::StaticOrder S; S.init(M, B_IN, F.G, F.bid);
        pg8::EpiInB E{SS2, F.in[10], (hb*)(ws + WS_QKV1)};
        pg8::gemm_phase<pg8::EpiInB, pg8::StaticOrder, true, true>(F.lds, g, S, E);
    } SEAM(7);
    if (IN(8)) { p8_swa(F); } SEAM(8);
    if (IN(9)) {
        pg8::Gemm g{(const hb*)(ws + WS_OB), (const hb*)(ws + WS_WBO), M, D, D}; pg8::StaticOrder S; S.init(M, D, F.G, F.bid);
        pg8::EpiRes E{F.out, F.out, XH, SS3, F.in[13]};
        pg8::gemm_phase<pg8::EpiRes, pg8::StaticOrder, true, true>(F.lds, g, S, E);
    } SEAM(9);
    if (IN(10)) {
        pg8::Gemm g{XH, (const hb*)(ws + WS_WGU1), M, 2 * FF, D}; pg8::StaticOrder S; S.init(M, 2 * FF, F.G, F.bid);
        pg8::EpiGU E{SS3, (hb*)(ws + WS_HB)};
        pg8::gemm_phase<pg8::EpiGU, pg8::StaticOrder, true, true>(F.lds, g, S, E);
    } SEAM(10);
    if (IN(11)) {
        pg8::Gemm g{(const hb*)(ws + WS_HB), (const hb*)(ws + WS_WD1), M, D, FF}; pg8::StaticOrder S; S.init(M, D, F.G, F.bid);
        pg8::EpiRes E{F.out, F.out, XH, SS1, nullptr};
        pg8::gemm_phase<pg8::EpiRes, pg8::StaticOrder, true, true>(F.lds, g, S, E);
    } SEAM(11);
    if (IN(12)) { p12_final(F); }
#undef IN
#undef SEAM
}

extern "C" void kernel_launch(void* const* d_in, const int* in_sizes, int n_in, void* d_out, int out_size, void* d_ws, size_t ws_size, hipStream_t stream) {
    static int grid = 0;
    if (grid == 0) {
        if (n_in != 16 || in_sizes[0] != M * D || out_size != M * D || ws_size < WS_END) { fprintf(stderr, "kernel_launch: unexpected shapes (n_in %d, in0 %d, out %d, ws %zu)\n", n_in, n_in > 0 ? in_sizes[0] : -1, out_size, ws_size); grid = -1; return; }
        int dev = 0, cus = 0, per_cu = 0;
        if (hipGetDevice(&dev) != hipSuccess || hipDeviceGetAttribute(&cus, hipDeviceAttributeMultiprocessorCount, dev) != hipSuccess) { grid = -1; return; }
        const void* fn = MK_ONE_LAUNCH ? (const void*)fwd<true> : (const void*)fwd<false>;
        if (hipFuncSetAttribute(fn, hipFuncAttributeMaxDynamicSharedMemorySize, LDS_BYTES) != hipSuccess) { fprintf(stderr, "kernel_launch: hipFuncSetAttribute failed\n"); grid = -1; return; }
        if (hipOccupancyMaxActiveBlocksPerMultiprocessor(&per_cu, fn, NTHREADS, LDS_BYTES) != hipSuccess || per_cu < 1) { fprintf(stderr, "kernel_launch: occupancy query says %d blocks per CU\n", per_cu); per_cu = 1; }
        (void)hipGetLastError();
        grid = cus;
    }
    if (grid < 0) return;
    (void)hipMemsetAsync((char*)d_ws + WS_CTL, 0, CTL_ZERO_BYTES, stream);
    Args a{};
    for (int i = 0; i < 16; ++i) a.in[i] = (const float*)d_in[i];
    a.out = (float*)d_out; a.ws = (unsigned char*)d_ws;
#if MK_ONE_LAUNCH
    a.ph_lo = 0; a.ph_hi = N_PHASES;
    hipLaunchKernelGGL(fwd<true>, dim3(grid), dim3(NTHREADS), LDS_BYTES, stream, a);
#else
    for (int p = 0; p < N_PHASES; ++p) { a.ph_lo = p; a.ph_hi = p + 1; hipLaunchKernelGGL(fwd<false>, dim3(grid), dim3(NTHREADS), LDS_BYTES, stream, a); }
#endif
}
```

```cpp
#include <hip/hip_runtime.h>
#include <hip/hip_cooperative_groups.h>
#include <cstdio>
#include <cstdint>
namespace cg = cooperative_groups;

typedef _Float16 f16x8 __attribute__((ext_vector_type(8)));
typedef _Float16 f16x2 __attribute__((ext_vector_type(2)));
typedef _Float16 f16;
namespace pg8 {
#define PG8_LAS __attribute__((address_space(3)))
typedef unsigned short bf16_t;
typedef short bf16x8 __attribute__((ext_vector_type(8)));
typedef float f32x4 __attribute__((ext_vector_type(4)));
typedef unsigned u32x4 __attribute__((ext_vector_type(4)));
constexpr int BM = 256, BK = 64, HALF = 128, HTB = HALF * BK * 2  , STAGE_BYTES = 8 * HTB, NXCD = 8, WGM = 8;

__host__ __device__ __forceinline__ int lds_byte(int r, int c) { const int st = (r >> 4) * 2 + (c >> 5), rr = r & 15, cc = c & 31, ob = rr * 64 + cc * 2; return st * 1024 + (ob ^ (((ob >> 9) & 1) << 5)); }
__host__ __device__ __forceinline__ void stage_rc(int b, int& R, int& C) { const int st = b / 1024, sb = b % 1024, swz = sb ^ (((sb >> 9) & 1) << 5); R = (st >> 1) * 16 + swz / 64; C = (st & 1) * 32 + (swz % 64) / 2; }
__host__ __device__ __forceinline__ int perm32(int rho) { const int n = rho >> 4, i = rho & 15; return 8 * (i >> 2) + 4 * n + (i & 3); }

struct Unit { int pm, pn; };
struct Gemm { const bf16_t* A; const bf16_t* Bt; int M, N, K; };

struct StaticOrder {
    int nM, nN, nwg, G, c;
    __host__ __device__ void init(int M, int N, int G_, int c_) { nM = M / BM; nN = N / BM; nwg = nM * nN; G = G_; c = c_; }
    __host__ __device__ bool next(int i, Unit& u) const {
        const long L = (long)i * G + c; if (L >= nwg) return false;
        int wgid = (int)L; { const int q = nwg / NXCD, r = nwg % NXCD, xcd = wgid % NXCD, off = wgid / NXCD; wgid = (xcd < r ? xcd * (q + 1) : r * (q + 1) + (xcd - r) * q) + off; }
        const int nig = WGM * nN, gid = wgid / nig, fm = gid * WGM, gsz = (nM - fm) < WGM ? (nM - fm) : WGM;
        u.pm = fm + ((wgid % nig) % gsz); u.pn = (wgid % nig) / gsz; return true;
    }
    __device__ __forceinline__ void a_ready(const Unit&) const {}
    __device__ __forceinline__ void done(const Unit&) const {}
};

__device__ __forceinline__ unsigned pk2h(float lo, float hi) { f16x2 v = {(_Float16)lo, (_Float16)hi}; return __builtin_bit_cast(unsigned, v); }
__device__ __forceinline__ u32x4 pk8h(f32x4 a, f32x4 b) { u32x4 w; w.x = pk2h(a[0], a[1]); w.y = pk2h(a[2], a[3]); w.z = pk2h(b[0], b[1]); w.w = pk2h(b[2], b[3]); return w; }
constexpr float RMS_EPS = 1e-6f;
constexpr float LOG2E = 1.4426950408889634f, QSCALE = 0.08838834764831845f * 1.4426950408889634f;

struct EpiInA {
    static constexpr bool PERM = true, AFTER_DRAIN = false;
    const float* rs; bf16_t* QL; float* CKV; bf16_t* QI; bf16_t* KI; float* WI;
    __device__ __forceinline__ void operator()(const f32x4 (&acc)[2][2][4][2], const Unit& u, int wr, int wc, int fr, int fq) const {
        const int row0 = u.pm * BM + wr * 64 + fr;
#pragma unroll
        for (int ai = 0; ai < 2; ++ai)
#pragma unroll
            for (int m = 0; m < 4; ++m) { const int row = row0 + ai * HALF + m * 16; const float r = rs[row];
#pragma unroll
                for (int bj = 0; bj < 2; ++bj) { const int col = u.pn * BM + bj * HALF + wc * 32 + 8 * fq;
                    f32x4 v0 = acc[ai][bj][m][0] * r, v1 = acc[ai][bj][m][1] * r;
                    if (col < 2048) { v0 = v0 * QSCALE; v1 = v1 * QSCALE; *(u32x4*)(QL + (size_t)row * 2048 + col) = pk8h(v0, v1); }
                    else if (col < 2176) { float* p = CKV + (size_t)row * 128 + (col - 2048); *(f32x4*)p = v0; *(f32x4*)(p + 4) = v1; }
                    else if (col < 2688) { v0 = v0 * 0.125f; v1 = v1 * 0.125f; *(u32x4*)(QI + (size_t)row * 512 + (col - 2176)) = pk8h(v0, v1); }
                    else if (col < 2752) { *(u32x4*)(KI + (size_t)row * 64 + (col - 2688)) = pk8h(v0, v1); }
                    else if (col < 2760) { const float s = 0.35355339059327373f; float* p = WI + (size_t)row * 8; *(f32x4*)p = v0 * s; *(f32x4*)(p + 4) = v1 * s; }
                } }
    }
};
struct EpiRes {
    static constexpr bool PERM = true, AFTER_DRAIN = false;
    const float* xold; float* xnew; bf16_t* xh; float* ss; const float* bias;
    __device__ __forceinline__ void operator()(const f32x4 (&acc)[2][2][4][2], const Unit& u, int wr, int wc, int fr, int fq) const {
        const int row0 = u.pm * BM + wr * 64 + fr;
#pragma unroll
        for (int ai = 0; ai < 2; ++ai)
#pragma unroll
            for (int m = 0; m < 4; ++m) { const int row = row0 + ai * HALF + m * 16; float sq = 0.f;
#pragma unroll
                for (int bj = 0; bj < 2; ++bj) { const int col = u.pn * BM + bj * HALF + wc * 32 + 8 * fq; const size_t off = (size_t)row * 1024 + col;
                    f32x4 v0 = acc[ai][bj][m][0] + *(const f32x4*)(xold + off), v1 = acc[ai][bj][m][1] + *(const f32x4*)(xold + off + 4);
                    if (bias) { v0 = v0 + *(const f32x4*)(bias + col); v1 = v1 + *(const f32x4*)(bias + col + 4); }
                    *(f32x4*)(xnew + off) = v0; *(f32x4*)(xnew + off + 4) = v1;
                    *(u32x4*)(xh + off) = pk8h(v0, v1);
                    sq += (v0[0] * v0[0] + v0[1] * v0[1]) + (v0[2] * v0[2] + v0[3] * v0[3]) + (v1[0] * v1[0] + v1[1] * v1[1]) + (v1[2] * v1[2] + v1[3] * v1[3]); }
                sq += __shfl_xor(sq, 16); sq += __shfl_xor(sq, 32);
                if (fq == 0) atomicAdd(ss + row, sq); }
    }
};
struct EpiGU {
    static constexpr bool PERM = true, AFTER_DRAIN = false;
    const float* ss; bf16_t* HB;
    __device__ __forceinline__ void operator()(const f32x4 (&acc)[2][2][4][2], const Unit& u, int wr, int wc, int fr, int fq) const {
        const int row0 = u.pm * BM + wr * 64 + fr; const int col = u.pn * HALF + wc * 32 + 8 * fq;
#pragma unroll
        for (int ai = 0; ai < 2; ++ai)
#pragma unroll
            for (int m = 0; m < 4; ++m) { const int row = row0 + ai * HALF + m * 16; const float r = 1.0f / sqrtf(ss[row] * (1.0f / 1024.0f) + RMS_EPS);
                f32x4 hv[2];
#pragma unroll
                for (int n = 0; n < 2; ++n)
#pragma unroll
                    for (int j = 0; j < 4; ++j) { const float g = acc[ai][0][m][n][j] * r, uu = acc[ai][1][m][n][j] * r;
                        hv[n][j] = g * __builtin_amdgcn_rcpf(1.0f + __builtin_amdgcn_exp2f(-1.4426950408889634f * g)) * uu; }
                *(u32x4*)(HB + (size_t)row * 2816 + col) = pk8h(hv[0], hv[1]); }
    }
};
struct EpiInB {
    static constexpr bool PERM = true, AFTER_DRAIN = false;
    const float* ss; const float* bias; bf16_t* QKV;
    __device__ __forceinline__ void operator()(const f32x4 (&acc)[2][2][4][2], const Unit& u, int wr, int wc, int fr, int fq) const {
        const int row0 = u.pm * BM + wr * 64 + fr;
#pragma unroll
        for (int ai = 0; ai < 2; ++ai)
#pragma unroll
            for (int m = 0; m < 4; ++m) { const int row = row0 + ai * HALF + m * 16; const float r = 1.0f / sqrtf(ss[row] * (1.0f / 1024.0f) + RMS_EPS);
#pragma unroll
                for (int bj = 0; bj < 2; ++bj) { const int col = u.pn * BM + bj * HALF + wc * 32 + 8 * fq;
                    f32x4 v0 = acc[ai][bj][m][0] * r + *(const f32x4*)(bias + col), v1 = acc[ai][bj][m][1] * r + *(const f32x4*)(bias + col + 4);
                    if (col < 1024) { v0 = v0 * (0.125f * LOG2E); v1 = v1 * (0.125f * LOG2E); }
                    *(u32x4*)(QKV + (size_t)row * 1280 + col) = pk8h(v0, v1); } }
    }
};

template <class Epi, class Sched, bool ALIGN_EPI = false, bool SP2 = false>
__device__ __forceinline__ void gemm_phase(PG8_LAS unsigned char* lds, const Gemm g, const Sched& S, const Epi& E) {
    const int tid = threadIdx.x, wid = __builtin_amdgcn_readfirstlane(tid >> 6), lane = tid & 63, wr = wid >> 2, wc = wid & 3, fr = lane & 15, fq = lane >> 4;
    const int K = g.K, nt = K / BK;
    unsigned voffA[2], voffB[2];
#pragma unroll
    for (int i = 0; i < 2; ++i) { int R, C; stage_rc(tid * 16 + i * 8192, R, C); const int Rb = Epi::PERM ? ((R & ~31) + perm32(R & 31)) : R;
        voffA[i] = (unsigned)(R * K + C) * 2u; voffB[i] = (unsigned)(Rb * K + C) * 2u; }
    const size_t kstep = (size_t)(BK * 2);
    const size_t hstep = (size_t)HALF * K * 2;
    const size_t tstep = 2 * hstep;
    const unsigned ldsw = (unsigned)wid * 1024u;
    const int aoff = lds_byte(wr * 64 + fr, fq * 8), boff = lds_byte(wc * 32 + fr, fq * 8);
#define PG8_SA(b, h) (((b) * 2 + (h)) * HTB)
#define PG8_SB(b, h) ((4 + (b) * 2 + (h)) * HTB)
#define PG8_STAGE(bufoff, gbase, voff) do { _Pragma("unroll") for (int _i = 0; _i < 2; ++_i) \
        __builtin_amdgcn_global_load_lds((const unsigned*)((const char*)(gbase) + (voff)[_i]), (PG8_LAS unsigned*)(lds + (bufoff) + ldsw + _i * 8192), 16, 0, 0); } while (0)
#define PG8_LDA(dst, b, h) do { _Pragma("unroll") for (int m = 0; m < 4; ++m) _Pragma("unroll") for (int k = 0; k < 2; ++k) dst[m][k] = *(const PG8_LAS bf16x8*)(lds + PG8_SA(b, h) + aoff + m * 2048 + k * 1024); } while (0)
#define PG8_LDB(dst, b, h) do { _Pragma("unroll") for (int n = 0; n < 2; ++n) _Pragma("unroll") for (int k = 0; k < 2; ++k) dst[n][k] = *(const PG8_LAS bf16x8*)(lds + PG8_SB(b, h) + boff + n * 2048 + k * 1024); } while (0)
#define PG8_MMA(ai, bj, At, Bt) do { __builtin_amdgcn_s_setprio(1); _Pragma("unroll") for (int m = 0; m < 4; ++m) _Pragma("unroll") for (int n = 0; n < 2; ++n) _Pragma("unroll") for (int k = 0; k < 2; ++k) \
        acc[ai][bj][m][n] = __builtin_amdgcn_mfma_f32_16x16x32_f16(__builtin_bit_cast(f16x8, Bt[n][k]), __builtin_bit_cast(f16x8, At[m][k]), acc[ai][bj][m][n], 0, 0, 0); __builtin_amdgcn_s_setprio(0); } while (0)
#define PG8_WAIT_V(n) asm volatile("s_waitcnt vmcnt(" #n ")" ::: "memory")
#define PG8_WAIT_L(n) asm volatile("s_waitcnt lgkmcnt(" #n ")" ::: "memory")
#define PG8_BAR __builtin_amdgcn_s_barrier()
#define PG8_SCHED __builtin_amdgcn_sched_barrier(0)
    Unit cur, nxt; int ui = 0;
    if (!S.next(0, cur)) return;
    f32x4 acc[2][2][4][2];
#pragma unroll
    for (int a = 0; a < 2; ++a)
#pragma unroll
        for (int b = 0; b < 2; ++b)
#pragma unroll
            for (int m = 0; m < 4; ++m)
#pragma unroll
                for (int n = 0; n < 2; ++n) acc[a][b][m][n] = (f32x4){0.f, 0.f, 0.f, 0.f};
    bf16x8 At[4][2], B0[2][2], B1[2][2];
    const char* cA = (const char*)g.A + (size_t)cur.pm * tstep; const char* cB = (const char*)g.Bt + (size_t)cur.pn * tstep;
    S.a_ready(cur);
    if constexpr (SP2) {
        PG8_STAGE(PG8_SB(0, 0), cB, voffB); PG8_STAGE(PG8_SB(0, 1), cB + hstep, voffB); PG8_STAGE(PG8_SA(0, 0), cA, voffA); PG8_STAGE(PG8_SA(0, 1), cA + hstep, voffA);
        if (wr == 1) PG8_BAR;
        PG8_WAIT_V(2); PG8_BAR;
        PG8_STAGE(PG8_SB(1, 0), cB + kstep, voffB); PG8_STAGE(PG8_SA(1, 0), cA + kstep, voffA); PG8_STAGE(PG8_SB(1, 1), cB + hstep + kstep, voffB);
        PG8_WAIT_V(6); PG8_BAR;
    } else {
        PG8_STAGE(PG8_SB(0, 0), cB, voffB); PG8_STAGE(PG8_SA(0, 0), cA, voffA); PG8_STAGE(PG8_SB(0, 1), cB + hstep, voffB); PG8_STAGE(PG8_SA(0, 1), cA + hstep, voffA);
        if (wr == 1) PG8_BAR;
        PG8_WAIT_V(4); PG8_BAR;
        PG8_STAGE(PG8_SB(1, 0), cB + kstep, voffB); PG8_STAGE(PG8_SA(1, 0), cA + kstep, voffA); PG8_STAGE(PG8_SB(1, 1), cB + hstep + kstep, voffB);
        PG8_WAIT_V(6); PG8_BAR;
    }
    for (;;) {
        const bool has_next = S.next(ui + 1, nxt);
        const char* nA = has_next ? (const char*)g.A + (size_t)nxt.pm * tstep : cA; const char* nB = has_next ? (const char*)g.Bt + (size_t)nxt.pn * tstep : cB;
        for (int t = 0; t < nt; t += 2) {
            const bool last = (t == nt - 2);
            const char* a1 = cA + (size_t)(t + 1) * kstep;
            const char* a2 = last ? nA : cA + (size_t)(t + 2) * kstep; const char* b2 = last ? nB : cB + (size_t)(t + 2) * kstep;
            const char* a3 = a2 + kstep; const char* b3 = b2 + kstep;
            if (last && has_next) S.a_ready(nxt);
            if constexpr (SP2) {
            PG8_LDB(B0, 0, 0); PG8_LDB(B1, 0, 1); PG8_SCHED; PG8_LDA(At, 0, 0); PG8_STAGE(PG8_SA(1, 1), a1 + hstep, voffA);
            PG8_WAIT_V(8); PG8_WAIT_L(0); PG8_BAR; PG8_MMA(0, 0, At, B0); PG8_MMA(0, 1, At, B1); PG8_BAR; PG8_SCHED;
            PG8_LDA(At, 0, 1); PG8_STAGE(PG8_SB(0, 0), b2, voffB); PG8_STAGE(PG8_SB(0, 1), b2 + hstep, voffB); PG8_STAGE(PG8_SA(0, 0), a2, voffA);
            PG8_WAIT_V(8); PG8_WAIT_L(0); PG8_BAR; PG8_MMA(1, 0, At, B0); PG8_MMA(1, 1, At, B1); PG8_BAR; PG8_SCHED;
            PG8_LDB(B0, 1, 0); PG8_LDB(B1, 1, 1); PG8_SCHED; PG8_LDA(At, 1, 0); PG8_STAGE(PG8_SA(0, 1), a2 + hstep, voffA);
            PG8_WAIT_V(8); PG8_WAIT_L(0); PG8_BAR; PG8_MMA(0, 0, At, B0); PG8_MMA(0, 1, At, B1); PG8_BAR; PG8_SCHED;
            PG8_LDA(At, 1, 1); PG8_STAGE(PG8_SB(1, 0), b3, voffB); PG8_STAGE(PG8_SB(1, 1), b3 + hstep, voffB); PG8_STAGE(PG8_SA(1, 0), a3, voffA);
            PG8_WAIT_V(8); PG8_WAIT_L(0); PG8_BAR; PG8_MMA(1, 0, At, B0); PG8_MMA(1, 1, At, B1); PG8_BAR; PG8_SCHED;
            } else {
            PG8_LDB(B0, 0, 0); PG8_SCHED; PG8_LDA(At, 0, 0); PG8_STAGE(PG8_SA(1, 1), a1 + hstep, voffA);
            PG8_WAIT_L(8); PG8_BAR; PG8_WAIT_L(0); PG8_MMA(0, 0, At, B0); PG8_BAR; PG8_SCHED;
            PG8_LDB(B1, 0, 1); PG8_STAGE(PG8_SB(0, 0), b2, voffB);
            PG8_BAR; PG8_WAIT_L(0); PG8_MMA(0, 1, At, B1); PG8_BAR;
            PG8_LDA(At, 0, 1); PG8_STAGE(PG8_SA(0, 0), a2, voffA);
            PG8_BAR; PG8_WAIT_L(0); PG8_MMA(1, 0, At, B0); PG8_BAR; PG8_SCHED;
            PG8_STAGE(PG8_SB(0, 1), b2 + hstep, voffB);
            PG8_WAIT_V(6); PG8_BAR; PG8_MMA(1, 1, At, B1); PG8_BAR;
            PG8_LDB(B0, 1, 0); PG8_SCHED; PG8_LDA(At, 1, 0); PG8_STAGE(PG8_SA(0, 1), a2 + hstep, voffA);
            PG8_WAIT_L(8); PG8_BAR; PG8_WAIT_L(0); PG8_MMA(0, 0, At, B0); PG8_BAR; PG8_SCHED;
            PG8_LDB(B1, 1, 1); PG8_STAGE(PG8_SB(1, 0), b3, voffB);
            PG8_BAR; PG8_WAIT_L(0); PG8_MMA(0, 1, At, B1); PG8_BAR;
            PG8_LDA(At, 1, 1); PG8_STAGE(PG8_SA(1, 0), a3, voffA);
            PG8_BAR; PG8_WAIT_L(0); PG8_MMA(1, 0, At, B0); PG8_BAR; PG8_SCHED;
            PG8_STAGE(PG8_SB(1, 1), b3 + hstep, voffB);
            PG8_WAIT_V(6); PG8_BAR; PG8_MMA(1, 1, At, B1); PG8_BAR;
            }
        }
        if constexpr (ALIGN_EPI) { if (wr == 0) PG8_BAR; }
        if constexpr (!Epi::AFTER_DRAIN) { E(acc, cur, wr, wc, fr, fq); S.done(cur); }
        if (!has_next) break;
#pragma unroll
        for (int a = 0; a < 2; ++a)
#pragma unroll
            for (int b = 0; b < 2; ++b)
#pragma unroll
                for (int m = 0; m < 4; ++m)
#pragma unroll
                    for (int n = 0; n < 2; ++n) acc[a][b][m][n] = (f32x4){0.f, 0.f, 0.f, 0.f};
        cur = nxt; cA = nA; cB = nB; ++ui;
        if constexpr (ALIGN_EPI) { if (wr == 1) PG8_BAR; }
    }
    PG8_WAIT_V(0);
    if constexpr (!ALIGN_EPI) { if (wr == 0) PG8_BAR; }
    PG8_BAR;
    if constexpr (Epi::AFTER_DRAIN) { E.fused(acc, cur, wr, wc, fr, fq, lds, wid, lane); S.done(cur); }
#undef PG8_SA
#undef PG8_SB
#undef PG8_STAGE
#undef PG8_LDA
#undef PG8_LDB
#undef PG8_MMA
#undef PG8_WAIT_V
#undef PG8_WAIT_L
#undef PG8_BAR
#undef PG8_SCHED
}
}

constexpr int NB = 8, T = 2048, D = 1024, M = NB * T, NH = 16, RL = 128, VH = 64, HI = 8, DI = 64, KSEL = 256;
constexpr int A_IN = 2760, A_PAD = 2816, B_IN = 1280, FF = 2816, WIN = 128;
constexpr int NWAVES = 8, NTHREADS = NWAVES * 64;
constexpr int N_PHASES = 13;
#ifndef PROBE_REPEAT
#define PROBE_REPEAT (-1)
#endif
#ifndef MK_ONE_LAUNCH
#define MK_ONE_LAUNCH 1
#endif
constexpr size_t MiB = 1u << 20;
constexpr size_t WS_CTL = 0, CTL_ZERO_BYTES = 1 * MiB;
constexpr size_t WS_SS1 = 256 * 1024, WS_SS2 = 320 * 1024, WS_SS3 = 384 * 1024;
constexpr int CW_BAR = 4096;
constexpr size_t WS_RS0 = 1 * MiB;
constexpr size_t WS_WA = 2 * MiB, WS_WUV = WS_WA + (size_t)A_PAD * D * 2, WS_WAO = 8 * MiB, WS_WGU0 = 10 * MiB, WS_WGU1 = 21 * MiB, WS_WD0 = 32 * MiB,
                 WS_WD1 = WS_WD0 + (size_t)D * FF * 2, WS_WB = 43 * MiB, WS_WBO = 46 * MiB;
constexpr size_t WS_XH = 50 * MiB;
constexpr size_t WS_QL = 82 * MiB, WS_CKV = 146 * MiB, WS_CKVN = 154 * MiB, WS_QI = 158 * MiB, WS_KI = 174 * MiB, WS_WI = 176 * MiB, WS_IDX = 178 * MiB, WS_OV = 186 * MiB;
constexpr size_t WS_HB = 82 * MiB, WS_QKV1 = 170 * MiB, WS_OB = 210 * MiB, WS_WCT = 242 * MiB, WS_END = 246 * MiB;
static_assert(WS_WUV + 16 * 64 * 128 * 2 <= WS_WAO && WS_WD1 + (size_t)D * FF * 2 <= WS_WB && WS_WB + (size_t)B_IN * D * 2 <= WS_WBO && WS_WBO + 2 * MiB <= WS_XH, "weights map");
static_assert(WS_HB + (size_t)M * FF * 2 <= WS_QKV1 && WS_QKV1 + (size_t)M * B_IN * 2 <= WS_OB && WS_OB + (size_t)M * D * 2 <= WS_WCT, "activation map");
constexpr int LDS_MISC = 147456, LDS_BYTES = 147456 + 256;

#define GAS __attribute__((address_space(1)))
#define LAS __attribute__((address_space(3)))
typedef unsigned v4u __attribute__((ext_vector_type(4)));
typedef float f32x4 __attribute__((ext_vector_type(4)));
typedef unsigned short hbits;
using pg8::pk2h;

__device__ const unsigned char BUCKET_TAB[129] = {0,1,2,3,4,5,6,7,8,9,10,11,12,13,14,15,16,16,16,17,17,18,18,18,19,19,19,20,20,20,20,21,21,21,21,22,22,22,22,22,23,23,23,23,23,23,24,24,24,24,24,24,25,25,25,25,25,25,25,26,26,26,26,26,26,26,26,27,27,27,27,27,27,27,27,27,27,28,28,28,28,28,28,28,28,28,28,29,29,29,29,29,29,29,29,29,29,29,29,30,30,30,30,30,30,30,30,30,30,30,30,30,30,31,31,31,31,31,31,31,31,31,31,31,31,31,31,31,31};

__device__ __forceinline__ float wave_sum(float v) {
#pragma unroll
    for (int o = 1; o < 64; o <<= 1) v += __shfl_xor(v, o);
    return v;
}
__device__ __forceinline__ float wave_max(float v) {
#pragma unroll
    for (int o = 1; o < 64; o <<= 1) v = fmaxf(v, __shfl_xor(v, o));
    return v;
}
#define LDS_WAIT() asm volatile("s_waitcnt lgkmcnt(0)" ::: "memory")

#define XB_TMO      128
#define XB_XCNT(j)  (256  + 64 * (j))
#define XB_XSUB(j)  (1280 + 64 * (j))
#define XB_XGEN(j)  (2304 + 64 * (j))
#define XB_TOP      3328
#define XB_TOPGEN   3392
#define XCD_BAR_WORDS 3456
#define XB_SPIN_CAP (1u << 18)

__device__ __forceinline__ unsigned xb_ld(unsigned* p)              { return __hip_atomic_load(p, __ATOMIC_RELAXED, __HIP_MEMORY_SCOPE_AGENT); }
__device__ __forceinline__ unsigned xb_add(unsigned* p, unsigned v) { return __hip_atomic_fetch_add(p, v, __ATOMIC_RELAXED, __HIP_MEMORY_SCOPE_AGENT); }
__device__ __forceinline__ unsigned xb_xcc_id() { return (unsigned)__builtin_amdgcn_s_getreg((3 << 11) | 20) & 0xFu; }
#define XB_SPIN(cond, bar) do { unsigned _sp = 0; while (cond) { __builtin_amdgcn_s_sleep(1); \
    if ((++_sp & 255u) == 0u) { if (xb_ld(&(bar)[XB_TMO])) break; if (_sp > XB_SPIN_CAP) { atomicAdd(&(bar)[XB_TMO], 1u); break; } } } } while (0)

struct XcdBarrier {
    unsigned* bar; unsigned x;
    volatile LAS unsigned* st;
};

__device__ __forceinline__ XcdBarrier xcd_barrier_post(unsigned* bar, volatile LAS unsigned* st) {
    XcdBarrier b; b.bar = bar; b.x = xb_xcc_id(); b.st = st;
    if (threadIdx.x == 0) (void)xb_add(&bar[XB_XCNT(b.x)], 1u);
    return b;
}
__device__ __forceinline__ void xcd_barrier_complete(unsigned* bar, unsigned x, unsigned& nloc, unsigned& nx) {
    const unsigned G = gridDim.x * gridDim.y * gridDim.z;
    unsigned sum, cnt, mine, sp = 0u;
    for (;;) {
        sum = 0u; cnt = 0u; mine = 0u;
#pragma unroll
        for (unsigned j = 0; j < 16; ++j) { const unsigned c = xb_ld(&bar[XB_XCNT(j)]); sum += c; cnt += (c > 0u) ? 1u : 0u; mine = (j == x) ? c : mine; }
        if (sum == G) break;
        __builtin_amdgcn_s_sleep(1);
        if ((++sp & 255u) == 0u) { if (xb_ld(&bar[XB_TMO])) break; if (sp > XB_SPIN_CAP) { atomicAdd(&bar[XB_TMO], 1u); break; } }
    }
    nloc = mine > 0u ? mine : 1u; nx = cnt > 0u ? cnt : 1u;
}

__device__ __forceinline__ void xcd_barrier(const XcdBarrier& b) {
    asm volatile("s_waitcnt vmcnt(0)" ::: "memory");
    __syncthreads();
    if (threadIdx.x == 0) {
        unsigned* bar = b.bar;
        __builtin_amdgcn_s_waitcnt(0);
        unsigned nloc = b.st[0], nx = b.st[1];
        if (nloc == 0u) { xcd_barrier_complete(bar, b.x, nloc, nx); b.st[0] = nloc; b.st[1] = nx; }
        const unsigned old = xb_add(&bar[XB_XSUB(b.x)], 1u);
        const unsigned gen = old / nloc;
        if (old + 1u == (gen + 1u) * nloc) {
            __builtin_amdgcn_fence(__ATOMIC_RELEASE, "agent");
            asm volatile("s_waitcnt vmcnt(0)" ::: "memory");
            const unsigned og = xb_add(&bar[XB_TOP], 1u);
            const unsigned tg = og / nx;
            if (og + 1u == (tg + 1u) * nx) xb_add(&bar[XB_TOPGEN], 1u);
            else XB_SPIN(xb_ld(&bar[XB_TOPGEN]) == tg, bar);
            __builtin_amdgcn_fence(__ATOMIC_ACQUIRE, "agent");
            xb_add(&bar[XB_XGEN(b.x)], 1u);
            asm volatile("s_waitcnt vmcnt(0)" ::: "memory");
        } else {
            XB_SPIN(xb_ld(&bar[XB_XGEN(b.x)]) == gen, bar);
            __builtin_amdgcn_fence(__ATOMIC_ACQUIRE, "agent");
            asm volatile("s_waitcnt vmcnt(0)" ::: "memory");
        }
    }
    __syncthreads();
}

struct Frame {
    LAS unsigned char* lds;
    int tid, lane, wave, G, bid;
    const float* in[16]; float* out; unsigned char* ws;
};

__device__ __forceinline__ void tr_item(const float* W, int ldw, int nvalid, const float* gain, hbits* WT, int K, int k0, int n0s, int n0d, LAS float* scr, int lane) {
#pragma unroll 8
    for (int i = 0; i < 32; ++i) { const int kk = 2 * i + (lane >> 5), n = n0s + (lane & 31);
        float v = (n < nvalid) ? W[(size_t)(k0 + kk) * ldw + n] : 0.f; if (gain) v *= gain[k0 + kk]; scr[kk * 33 + (lane & 31)] = v; }
    LDS_WAIT(); asm volatile("" ::: "memory");
    const int c = lane & 7;
#pragma unroll
    for (int j = 0; j < 4; ++j) { const int n = (lane >> 3) + 8 * j; const LAS float* s = scr + (8 * c) * 33 + n;
        v4u o; o.x = pk2h(s[0 * 33], s[1 * 33]); o.y = pk2h(s[2 * 33], s[3 * 33]); o.z = pk2h(s[4 * 33], s[5 * 33]); o.w = pk2h(s[6 * 33], s[7 * 33]);
        *(GAS v4u*)(WT + (size_t)(n0d + n) * K + k0 + 8 * c) = o; }
    LDS_WAIT(); asm volatile("" ::: "memory");
}
__device__ __forceinline__ void p0_prologue(Frame& F) {
    LAS float* scr = (LAS float*)(F.lds + F.wave * 16384);
    const int gw = F.bid * NWAVES + F.wave, NGW = F.G * NWAVES;
    hbits* WA = (hbits*)(F.ws + WS_WA); hbits* WUV = (hbits*)(F.ws + WS_WUV); hbits* WAO = (hbits*)(F.ws + WS_WAO);
    hbits* WB = (hbits*)(F.ws + WS_WB); hbits* WBO = (hbits*)(F.ws + WS_WBO);
    constexpr int I_WA = 16 * (A_PAD / 32), I_UV = 64, I_SQ = 16 * 32, I_GU = 16 * (2 * FF / 32), I_D = (FF / 64) * 32, I_WB = 16 * (B_IN / 32);
    constexpr int NITEMS = I_WA + I_UV + I_SQ + 2 * I_GU + 2 * I_D + I_WB + I_SQ;
    for (int it = gw; it < NITEMS; it += NGW) {
        int r = it;
        if (r < I_WA) { const int nnb = A_PAD / 32, kb = r / nnb, nb = r % nnb; tr_item(F.in[5], A_IN, A_IN, F.in[2], WA, D, 64 * kb, 32 * nb, 32 * nb, scr, F.lane); continue; } r -= I_WA;
        if (r < I_UV) { const int h = r >> 2, kb = (r >> 1) & 1, nb = r & 1; tr_item(F.in[7] + (size_t)h * RL * VH, VH, VH, nullptr, WUV + (size_t)h * VH * RL, RL, 64 * kb, 32 * nb, 32 * nb, scr, F.lane); continue; } r -= I_UV;
        if (r < I_SQ) { const int kb = r / 32, nb = r % 32; tr_item(F.in[8], D, D, nullptr, WAO, D, 64 * kb, 32 * nb, 32 * nb, scr, F.lane); continue; } r -= I_SQ;
        if (r < 2 * I_GU) { const int l = r / I_GU; r -= l * I_GU; const int nnb = 2 * FF / 32, kb = r / nnb, nb = r % nnb; const int c = 32 * nb;
            const int nd = (c < FF) ? ((c / 128) * 256 + (c % 128)) : (((c - FF) / 128) * 256 + 128 + ((c - FF) % 128));
            tr_item(F.in[14] + (size_t)l * D * 2 * FF, 2 * FF, 2 * FF, F.in[3] + l * D, (hbits*)(F.ws + (l ? WS_WGU1 : WS_WGU0)), D, 64 * kb, c, nd, scr, F.lane); continue; } r -= 2 * I_GU;
        if (r < 2 * I_D) { const int l = r / I_D; r -= l * I_D; const int kb = r / 32, nb = r % 32;
            tr_item(F.in[15] + (size_t)l * FF * D, D, D, nullptr, (hbits*)(F.ws + (l ? WS_WD1 : WS_WD0)), FF, 64 * kb, 32 * nb, 32 * nb, scr, F.lane); continue; } r -= 2 * I_D;
        if (r < I_WB) { const int nnb = B_IN / 32, kb = r / nnb, nb = r % nnb; tr_item(F.in[9], B_IN, B_IN, F.in[2] + D, WB, D, 64 * kb, 32 * nb, 32 * nb, scr, F.lane); continue; } r -= I_WB;
        { const int kb = r / 32, nb = r % 32; tr_item(F.in[12], D, D, nullptr, WBO, D, 64 * kb, 32 * nb, 32 * nb, scr, F.lane); }
    }
    { const float* w_uv = F.in[7]; const float* w_out = F.in[8]; hbits* WCT = (hbits*)(F.ws + WS_WCT);
      for (int it = gw; it < 1024; it += NGW) { const int h = it >> 6, dblk = (it >> 2) & 15, rblk = it & 3, d = dblk * 64 + F.lane;
          float wo[64];
#pragma unroll
          for (int v = 0; v < 64; ++v) wo[v] = w_out[(size_t)(h * 64 + v) * D + d];
          for (int r8 = 0; r8 < 4; ++r8) { float acc[8];
#pragma unroll
              for (int rr = 0; rr < 8; ++rr) { const float* u = w_uv + (size_t)(h * RL + rblk * 32 + r8 * 8 + rr) * VH; float sacc = 0.f;
#pragma unroll
                  for (int v = 0; v < 64; ++v) sacc = fmaf(u[v], wo[v], sacc);
                  acc[rr] = sacc; }
              v4u o; o.x = pk2h(acc[0], acc[1]); o.y = pk2h(acc[2], acc[3]); o.z = pk2h(acc[4], acc[5]); o.w = pk2h(acc[6], acc[7]);
              *(GAS v4u*)(WCT + (size_t)d * (NH * RL) + h * RL + rblk * 32 + r8 * 8) = o; } } }
    const float* x = F.in[0]; hbits* XH = (hbits*)(F.ws + WS_XH); float* RS0 = (float*)(F.ws + WS_RS0);
    for (int m = gw; m < M; m += NGW) {
        const GAS f32x4* xr = (const GAS f32x4*)(x + (size_t)m * D) + F.lane;
        f32x4 v[4]; float s = 0.f;
#pragma unroll
        for (int j = 0; j < 4; ++j) { v[j] = xr[64 * j]; s += (v[j].x * v[j].x + v[j].y * v[j].y) + (v[j].z * v[j].z + v[j].w * v[j].w); }
        s = wave_sum(s);
        if (F.lane == 0) RS0[m] = 1.0f / sqrtf(s * (1.0f / D) + pg8::RMS_EPS);
        GAS unsigned long long* o8 = (GAS unsigned long long*)(XH + (size_t)m * D) + F.lane;
#pragma unroll
        for (int j = 0; j < 4; ++j) o8[64 * j] = (unsigned long long)pk2h(v[j].x, v[j].y) | ((unsigned long long)pk2h(v[j].z, v[j].w) << 32);
    }
}

__device__ __forceinline__ unsigned okey(float f) { const unsigned u = __builtin_bit_cast(unsigned, f); return (u & 0x80000000u) ? ~u : (u | 0x80000000u); }
__device__ __forceinline__ int wave_sum_i(int v) {
    v += __builtin_amdgcn_update_dpp(0, v, 0x128, 0xf, 0xf, false);
    v += __builtin_amdgcn_update_dpp(0, v, 0x124, 0xf, 0xf, false);
    v += __builtin_amdgcn_update_dpp(0, v, 0x122, 0xf, 0xf, false);
    v += __builtin_amdgcn_update_dpp(0, v, 0x121, 0xf, 0xf, false);
    return (__builtin_amdgcn_readlane(v, 0) + __builtin_amdgcn_readlane(v, 16)) + (__builtin_amdgcn_readlane(v, 32) + __builtin_amdgcn_readlane(v, 48));
}
__device__ __forceinline__ int lanes_below(unsigned long long m) { return (int)__builtin_amdgcn_mbcnt_hi((unsigned)(m >> 32), __builtin_amdgcn_mbcnt_lo((unsigned)m, 0u)); }
__device__ __forceinline__ void select_topk(const LAS float* sc, int t, unsigned short* idxrow, int lane) {
    unsigned x[32];
#pragma unroll
    for (int q = 0; q < 32; ++q) { const int s = lane + 64 * q; x[q] = (s <= t) ? okey(sc[s]) : 0u; }
#pragma unroll
    for (int jj = 0; jj < 5; ++jj) { const int j = 16 >> jj; const unsigned m = (jj == 0) ? 0x0000FFFFu : (jj == 1) ? 0x00FF00FFu : (jj == 2) ? 0x0F0F0F0Fu : (jj == 3) ? 0x33333333u : 0x55555555u;
#pragma unroll
        for (int k = 0; k < 32; ++k) if ((k & j) == 0) { const unsigned tt = (x[k] ^ (x[k + j] >> j)) & m; x[k] ^= tt; x[k + j] ^= (tt << j); } }
    unsigned alive = 0xFFFFFFFFu, sel = 0u; int need = KSEL;
#pragma unroll
    for (int i = 0; i < 32; ++i) { const unsigned ones = alive & x[i]; const int c = wave_sum_i(__builtin_popcount(ones));
        if (c >= need) alive = ones; else { need -= c; sel |= ones; alive &= ~x[i]; } }
    const int tot = wave_sum_i(__builtin_popcount(alive));
    if (tot == need) sel |= alive;
    else { const unsigned long long lt_mask = (1ull << lane) - 1ull;
        for (int p = 31; p >= 0 && need > 0; --p) { const bool bit = (alive >> p) & 1u; const unsigned long long mb = __ballot(bit); const int c = __builtin_popcountll(mb);
            if (c <= need) { if (bit) sel |= 1u << p; need -= c; } else { if (bit && __builtin_popcountll(mb & lt_mask) < need) sel |= 1u << p; need = 0; } } }
    const int cl = __builtin_popcount(sel); int pos = 0;
#pragma unroll
    for (int bb = 0; bb < 6; ++bb) pos += lanes_below(__ballot((cl >> bb) & 1)) << bb;
    unsigned m = sel;
    while (m) { const int p = __builtin_ctz(m); m &= m - 1u; idxrow[pos++] = (unsigned short)(lane + 64 * (31 - p)); }
}
__device__ __forceinline__ void p2_indexer(Frame& F) {
    const int gw = F.bid * NWAVES + F.wave, NGW = F.G * NWAVES, lane = F.lane, tid = F.tid, wave = F.wave;
    { const float* CKV = (const float*)(F.ws + WS_CKV); hbits* CKVN = (hbits*)(F.ws + WS_CKVN); const float* lg = F.in[6];
      for (int m = gw; m < M; m += NGW) { const float a = CKV[(size_t)m * RL + 2 * lane], b = CKV[(size_t)m * RL + 2 * lane + 1];
          const float s = wave_sum(a * a + b * b); const float r = 1.0f / sqrtf(s * (1.0f / RL) + pg8::RMS_EPS);
          *(unsigned*)(CKVN + (size_t)m * RL + 2 * lane) = pk2h(a * r * lg[2 * lane], b * r * lg[2 * lane + 1]); } }
    LAS float* scb = (LAS float*)F.lds;
    LAS unsigned char* kst = F.lds + 131072;
    const hbits* QI = (const hbits*)(F.ws + WS_QI); const hbits* KI = (const hbits*)(F.ws + WS_KI); const float* WI = (const float*)(F.ws + WS_WI);
    unsigned short* IDX = (unsigned short*)(F.ws + WS_IDX);
    const int a = lane & 15, q = lane >> 4, lrow = tid >> 3, lch = tid & 7, tg = wave & 3, kh = wave >> 2;
    int boff[2];
#pragma unroll
    for (int s = 0; s < 2; ++s) boff[s] = a * 128 + 16 * ((4 * s + q) ^ ((a >> 1) & 7)) + 4096 * kh;
    const int wst = lrow * 128 + 16 * (lch ^ ((lrow >> 1) & 7));
    for (int pu = 0; pu < 2 * ((NB * 64 - F.bid + F.G - 1) / F.G); ++pu) {
        const int p = F.bid + F.G * (pu >> 1), b = p >> 6, j = (pu & 1) ? 127 - (p & 63) : (p & 63), t0 = 16 * j; const size_t tokbase = (size_t)b * T + t0;
        if (t0 < KSEL) {
#pragma unroll
            for (int tt = 0; tt < 2; ++tt) { const int t = t0 + 2 * wave + tt;
#pragma unroll
                for (int jj = 0; jj < 4; ++jj) { const int k = 4 * lane + jj; IDX[(tokbase + 2 * wave + tt) * KSEL + k] = (unsigned short)((k < t) ? k : t); } }
            continue; }
        const int ns = (t0 + 16 + 63) >> 6;
        f16x8 af[2][2];
#pragma unroll
        for (int tl = 0; tl < 2; ++tl)
#pragma unroll
            for (int s = 0; s < 2; ++s) af[tl][s] = __builtin_bit_cast(f16x8, *(const v4u*)(QI + (tokbase + 4 * tg + (a >> 2)) * 512 + ((a & 3) + 4 * tl) * 64 + 32 * s + 8 * q));
        const f32x4 wlo = *(const f32x4*)(WI + (tokbase + 4 * tg + q) * 8), whi = *(const f32x4*)(WI + (tokbase + 4 * tg + q) * 8 + 4);
        LAS float* myrow = scb + (4 * tg + q) * 2048 + 32 * kh + a;
        const hbits* ksrc = KI + ((size_t)b * T + lrow) * DI + 8 * lch;
        v4u r0 = *(const v4u*)(ksrc), r1 = *(const v4u*)(ksrc + 64 * DI);
        *(LAS v4u*)(kst + wst) = r0;
        r0 = *(const v4u*)(ksrc + 2 * 64 * DI);
        for (int st = 0; st < ns; ++st) {
            __syncthreads();
            if (st + 1 < ns) { *(LAS v4u*)(kst + ((st + 1) & 1) * 8192 + wst) = (st & 1) ? r0 : r1; }
            if (st + 3 < ns) { const v4u nx = *(const v4u*)(ksrc + (size_t)(st + 3) * 64 * DI); if (st & 1) r0 = nx; else r1 = nx; }
            const LAS unsigned char* buf = kst + (st & 1) * 8192;
#pragma unroll
            for (int kt = 0; kt < 2; ++kt) { f32x4 au = (f32x4){0.f, 0.f, 0.f, 0.f}, av = (f32x4){0.f, 0.f, 0.f, 0.f};
#pragma unroll
                for (int s = 0; s < 2; ++s) { const f16x8 bf = __builtin_bit_cast(f16x8, *(const LAS v4u*)(buf + boff[s] + 2048 * kt));
                    au = __builtin_amdgcn_mfma_f32_16x16x32_f16(af[0][s], bf, au, 0, 0, 0); av = __builtin_amdgcn_mfma_f32_16x16x32_f16(af[1][s], bf, av, 0, 0, 0); }
                float sc = wlo[0] * fmaxf(au[0], 0.f); sc = fmaf(wlo[1], fmaxf(au[1], 0.f), sc); sc = fmaf(wlo[2], fmaxf(au[2], 0.f), sc); sc = fmaf(wlo[3], fmaxf(au[3], 0.f), sc);
                sc = fmaf(whi[0], fmaxf(av[0], 0.f), sc); sc = fmaf(whi[1], fmaxf(av[1], 0.f), sc); sc = fmaf(whi[2], fmaxf(av[2], 0.f), sc); sc = fmaf(whi[3], fmaxf(av[3], 0.f), sc);
                myrow[64 * st + 16 * kt] = sc; }
        }
        __syncthreads();
#pragma unroll 1
        for (int tt = 0; tt < (PROBE_REPEAT == 21 ? 4 : 2); ++tt) select_topk(scb + (2 * wave + (tt & 1)) * 2048, t0 + 2 * wave + (tt & 1), IDX + (tokbase + 2 * wave + (tt & 1)) * KSEL, lane);
        __syncthreads();
    }
}

typedef short v4i16_t __attribute__((ext_vector_type(4)));
__device__ __forceinline__ int swz_x(int row) { return ((row & 3) << 2) | ((row >> 2) & 3); }
__device__ __forceinline__ void p3_sparse_attn(Frame& F, hbits* Oout) {
    const int lane = F.lane, wave = F.wave, gw = F.bid * NWAVES + wave, NGW = F.G * NWAVES;
    const int a = lane & 15, q = lane >> 4, sq = ((q & 1) << 1) | (q >> 1);
    LAS unsigned char* kvb = F.lds + wave * 16384;
    LAS unsigned short* idl = (LAS unsigned short*)(F.lds + 131072 + wave * 512);
    LAS float* bt = (LAS float*)(F.lds + 135168);
    const float* rel_bias = F.in[1];
    hbits* QL = (hbits*)(F.ws + WS_QL); const hbits* CKVN = (const hbits*)(F.ws + WS_CKVN); const unsigned short* IDX = (const unsigned short*)(F.ws + WS_IDX);
    for (int i = F.tid; i < 129 * 16; i += NTHREADS) bt[i] = rel_bias[(int)BUCKET_TAB[i >> 4] * 16 + (i & 15)] * pg8::LOG2E;
    __syncthreads();
    const int arow = 4 * ((((a >> 2) & 1) << 1) | (a >> 3)) + (a & 3), xa = swz_x(arow);
    int aoff[4];
#pragma unroll
    for (int s = 0; s < 4; ++s) aoff[s] = 256 * arow + 16 * ((4 * s + q) ^ xa);
    const int trow = 4 * sq + (a >> 2), xt = swz_x(trow);
    int toff[8];
#pragma unroll
    for (int nt = 0; nt < 8; ++nt) toff[nt] = 256 * trow + 16 * ((2 * nt + ((a >> 1) & 1)) ^ xt) + 8 * (a & 1);
    const int drow = lane >> 4;
    for (int i = 0; i * NGW < M; ++i) {
        const int tok = gw + NGW * i; if (tok >= M) break;
        const int b = tok >> 11, t = tok & (T - 1); const int n = (t + 1 < KSEL) ? t + 1 : KSEL, nc = (n + 31) >> 5;
        { const unsigned long long v = *(const unsigned long long*)(IDX + (size_t)tok * KSEL + 4 * lane); *(LAS unsigned long long*)(idl + 4 * lane) = v; }
        f16x8 qf[4];
#pragma unroll
        for (int s = 0; s < 4; ++s) qf[s] = __builtin_bit_cast(f16x8, *(const v4u*)(QL + (size_t)tok * (NH * RL) + a * RL + 32 * s + 8 * q));
        LDS_WAIT(); asm volatile("" ::: "memory");
        const hbits* kvbase = CKVN + (size_t)b * T * RL;
#define P3_DMA(c, buf) do { _Pragma("unroll") for (int g = 0; g < 8; ++g) { const int row = 4 * g + drow; const int key = idl[32 * (c) + row]; \
            __builtin_amdgcn_global_load_lds((const unsigned*)(kvbase + (size_t)key * RL + 8 * ((lane & 15) ^ swz_x(row))), (LAS unsigned*)(kvb + (buf) * 8192 + g * 1024), 16, 0, 0); } } while (0)
        P3_DMA(0, 0);
        float m = -INFINITY, l = 0.f; f32x4 o[8];
#pragma unroll
        for (int nt = 0; nt < 8; ++nt) o[nt] = (f32x4){0.f, 0.f, 0.f, 0.f};
        for (int c = 0; c < nc; ++c) {
            LAS unsigned char* cur = kvb + (c & 1) * 8192;
            if (c + 1 < nc) { LDS_WAIT(); asm volatile("" ::: "memory"); P3_DMA(c + 1, (c + 1) & 1); asm volatile("s_waitcnt vmcnt(8)" ::: "memory"); }
            else { asm volatile("s_waitcnt vmcnt(0)" ::: "memory"); }
            f32x4 s0 = (f32x4){0.f, 0.f, 0.f, 0.f}, s1 = (f32x4){0.f, 0.f, 0.f, 0.f};
#pragma unroll
            for (int s = 0; s < 4; ++s) { const f16x8 k0 = __builtin_bit_cast(f16x8, *(const LAS v4u*)(cur + aoff[s])), k1 = __builtin_bit_cast(f16x8, *(const LAS v4u*)(cur + 4096 + aoff[s]));
                s0 = __builtin_amdgcn_mfma_f32_16x16x32_f16(k0, qf[s], s0, 0, 0, 0); s1 = __builtin_amdgcn_mfma_f32_16x16x32_f16(k1, qf[s], s1, 0, 0, 0); }
            { const unsigned long long i0 = *(const LAS unsigned long long*)(idl + 32 * c + 4 * sq), i1 = *(const LAS unsigned long long*)(idl + 32 * c + 16 + 4 * sq);
#pragma unroll
              for (int r = 0; r < 4; ++r) { const int k0 = (int)((i0 >> (16 * r)) & 0xffffu), k1 = (int)((i1 >> (16 * r)) & 0xffffu);
                  const int r0 = t - k0, r1 = t - k1;
                  s0[r] += bt[(((unsigned)r0 < 128u) ? r0 : 128) * 16 + a]; s1[r] += bt[(((unsigned)r1 < 128u) ? r1 : 128) * 16 + a];
                  if (32 * c + 4 * sq + r >= n) s0[r] = -INFINITY;
                  if (32 * c + 16 + 4 * sq + r >= n) s1[r] = -INFINITY; } }
            float cm = fmaxf(fmaxf(fmaxf(s0[0], s0[1]), fmaxf(s0[2], s0[3])), fmaxf(fmaxf(s1[0], s1[1]), fmaxf(s1[2], s1[3])));
            cm = fmaxf(cm, __shfl_xor(cm, 16)); cm = fmaxf(cm, __shfl_xor(cm, 32));
            const float mn = fmaxf(m, cm), alpha = __builtin_amdgcn_exp2f(m - mn); m = mn;
            float ps = 0.f;
#pragma unroll
            for (int r = 0; r < 4; ++r) { s0[r] = __builtin_amdgcn_exp2f(s0[r] - mn); s1[r] = __builtin_amdgcn_exp2f(s1[r] - mn); ps += s0[r] + s1[r]; }
            l = l * alpha + ps;
#pragma unroll
            for (int nt = 0; nt < 8; ++nt) o[nt] = o[nt] * alpha;
            v4u pw; pw.x = pk2h(s0[0], s0[1]); pw.y = pk2h(s0[2], s0[3]); pw.z = pk2h(s1[0], s1[1]); pw.w = pk2h(s1[2], s1[3]);
            const f16x8 pfr = __builtin_bit_cast(f16x8, pw);
#pragma unroll
            for (int nt = 0; nt < 8; ++nt) {
                const v4i16_t t0 = __builtin_amdgcn_ds_read_tr16_b64_v4i16((LAS v4i16_t*)(cur + toff[nt])), t1 = __builtin_amdgcn_ds_read_tr16_b64_v4i16((LAS v4i16_t*)(cur + 4096 + toff[nt]));
                typedef short v8i16_t __attribute__((ext_vector_type(8)));
                const v8i16_t tv = {t0[0], t0[1], t0[2], t0[3], t1[0], t1[1], t1[2], t1[3]};
                o[nt] = __builtin_amdgcn_mfma_f32_16x16x32_f16(__builtin_bit_cast(f16x8, tv), pfr, o[nt], 0, 0, 0); }
        }
        l += __shfl_xor(l, 16); l += __shfl_xor(l, 32);
        const float inv = 1.0f / l;
        hbits* orow = Oout + (size_t)tok * (NH * RL) + a * RL + 4 * q;
#pragma unroll
        for (int nt = 0; nt < 8; ++nt) { const unsigned long long w = (unsigned long long)pk2h(o[nt][0] * inv, o[nt][1] * inv) | ((unsigned long long)pk2h(o[nt][2] * inv, o[nt][3] * inv) << 32);
            *(unsigned long long*)(orow + 16 * nt) = w; }
        LDS_WAIT(); asm volatile("" ::: "memory");
#undef P3_DMA
    }
}

typedef float f32x16 __attribute__((ext_vector_type(16)));
constexpr float SWA_QSCALE = 0.125f * 1.4426950408889634f;
__device__ __forceinline__ void p8_swa(Frame& F) {
    const int tid = F.tid, lane = F.lane, wave = F.wave, r32 = lane & 31, hh = lane >> 5;
    LAS unsigned char* Ks = F.lds;
    LAS unsigned char* Vs = F.lds + 20480;
    LAS float* btr = (LAS float*)(F.lds + 40960) + wave * 384;
    const float* rel_bias = F.in[1]; const float* sinks = F.in[11];
    const hbits* QKV = (const hbits*)(F.ws + WS_QKV1); hbits* OB = (hbits*)(F.ws + WS_OB);
    for (int i = lane; i < 384; i += 64) { const int rel = 159 - (i % 192), hd = 8 * (i / 192) + wave; btr[i] = (rel >= 0 && rel < 128) ? rel_bias[(int)BUCKET_TAB[rel] * 16 + hd] * pg8::LOG2E : 0.f; }
    const int lrow = tid >> 3, lch = tid & 7;
    const int g = lane >> 4, dh = g & 1, ti = lane & 15, tr_r = ti >> 2, tr_p = ti & 3;
    int kbase[4], vbase[2];
#pragma unroll
    for (int s = 0; s < 4; ++s) kbase[s] = r32 * 128 + 16 * ((2 * s + hh) ^ ((r32 >> 1) & 7));
#pragma unroll
    for (int dt = 0; dt < 2; ++dt) vbase[dt] = (4 * hh + tr_r) * 128 + 16 * ((4 * dt + 2 * dh + (tr_p >> 1)) ^ (((tr_r >> 1) & 1) << 2)) + 8 * (tr_p & 1);
    for (int u = F.bid; u < NB * 2 * (T / 32); u += F.G) {
        const int qt = u & 63, kvh = (u >> 6) & 1, b = u >> 7, t0 = 32 * qt, head = kvh * 8 + wave;
        __syncthreads();
#pragma unroll
        for (int p = 0; p < 3; ++p) { const int row = lrow + 64 * p;
            if (row < 160) { const int key = t0 - 128 + row; v4u kv = (v4u){0u, 0u, 0u, 0u}, vv = (v4u){0u, 0u, 0u, 0u};
                if (key >= 0) { const hbits* base = QKV + ((size_t)b * T + key) * B_IN; kv = *(const v4u*)(base + 1024 + kvh * 64 + 8 * lch); vv = *(const v4u*)(base + 1152 + kvh * 64 + 8 * lch); }
                *(LAS v4u*)(Ks + row * 128 + 16 * (lch ^ ((row >> 1) & 7))) = kv; *(LAS v4u*)(Vs + row * 128 + 16 * (lch ^ (((row >> 1) & 1) << 2))) = vv; } }
        f16x8 qf[4];
#pragma unroll
        for (int s = 0; s < 4; ++s) qf[s] = __builtin_bit_cast(f16x8, *(const v4u*)(QKV + ((size_t)b * T + t0 + r32) * B_IN + head * 64 + 16 * s + 8 * hh));
        __syncthreads();
        f32x16 S[5];
#pragma unroll
        for (int kt = 0; kt < 5; ++kt) {
#pragma unroll
            for (int r = 0; r < 16; ++r) S[kt][r] = 0.f;
#pragma unroll
            for (int s = 0; s < 4; ++s) { const f16x8 kf = __builtin_bit_cast(f16x8, *(const LAS v4u*)(Ks + kbase[s] + kt * 4096));
                S[kt] = __builtin_amdgcn_mfma_f32_32x32x16_f16(kf, qf[s], S[kt], 0, 0, 0); } }
        const float sink2 = sinks[head] * pg8::LOG2E; float m = sink2;
        int base = 128 + r32 - 4 * hh; asm volatile("" : "+v"(base));
        const LAS float* btl = btr + kvh * 192 + (159 - base);
        const int kmin = 128 - t0 - 4 * hh;
#pragma unroll
        for (int kt = 0; kt < 5; ++kt)
#pragma unroll
            for (int r = 0; r < 16; ++r) { const int c = 32 * kt + (r & 3) + 8 * (r >> 2); const int rel = base - c;
                const bool valid = ((unsigned)rel < 128u) && (c >= kmin);
                const float v = valid ? S[kt][r] + btl[c] : -INFINITY; S[kt][r] = v; m = fmaxf(m, v); }
        m = fmaxf(m, __shfl_xor(m, 32));
        float l = 0.f;
#pragma unroll
        for (int kt = 0; kt < 5; ++kt)
#pragma unroll
            for (int r = 0; r < 16; ++r) { const float p = __builtin_amdgcn_exp2f(S[kt][r] - m); S[kt][r] = p; l += p; }
        l += __shfl_xor(l, 32); l += __builtin_amdgcn_exp2f(sink2 - m);
        const float inv = 1.0f / l;
        f32x16 O[2];
#pragma unroll
        for (int dt = 0; dt < 2; ++dt)
#pragma unroll
            for (int r = 0; r < 16; ++r) O[dt][r] = 0.f;
#pragma unroll
        for (int kt = 0; kt < 5; ++kt)
#pragma unroll
            for (int s = 0; s < 2; ++s) { v4u pw; pw.x = pk2h(S[kt][8 * s + 0], S[kt][8 * s + 1]); pw.y = pk2h(S[kt][8 * s + 2], S[kt][8 * s + 3]); pw.z = pk2h(S[kt][8 * s + 4], S[kt][8 * s + 5]); pw.w = pk2h(S[kt][8 * s + 6], S[kt][8 * s + 7]);
                const f16x8 pfr = __builtin_bit_cast(f16x8, pw);
#pragma unroll
                for (int dt = 0; dt < 2; ++dt) {
                    const v4i16_t t1 = __builtin_amdgcn_ds_read_tr16_b64_v4i16((LAS v4i16_t*)(Vs + vbase[dt] + (32 * kt + 16 * s) * 128));
                    const v4i16_t t2 = __builtin_amdgcn_ds_read_tr16_b64_v4i16((LAS v4i16_t*)(Vs + vbase[dt] + (32 * kt + 16 * s + 8) * 128));
                    typedef short v8i16_t __attribute__((ext_vector_type(8)));
                    const v8i16_t tv = {t1[0], t1[1], t1[2], t1[3], t2[0], t2[1], t2[2], t2[3]};
                    O[dt] = __builtin_amdgcn_mfma_f32_32x32x16_f16(__builtin_bit_cast(f16x8, tv), pfr, O[dt], 0, 0, 0); }
                __builtin_amdgcn_sched_barrier(0); }
        hbits* orow = OB + ((size_t)b * T + t0 + r32) * D + head * 64 + 4 * hh;
#pragma unroll
        for (int dt = 0; dt < 2; ++dt)
#pragma unroll
            for (int g4 = 0; g4 < 4; ++g4) { const unsigned long long w = (unsigned long long)pk2h(O[dt][4 * g4] * inv, O[dt][4 * g4 + 1] * inv) | ((unsigned long long)pk2h(O[dt][4 * g4 + 2] * inv, O[dt][4 * g4 + 3] * inv) << 32);
                *(unsigned long long*)(orow + 32 * dt + 8 * g4) = w; }
    }
}

__device__ __forceinline__ void p12_final(Frame& F) {
    const int gw = F.bid * NWAVES + F.wave, NGW = F.G * NWAVES; const float* g = F.in[4];
    for (int m = gw; m < M; m += NGW) {
        GAS f32x4* xr = (GAS f32x4*)(F.out + (size_t)m * D) + F.lane;
        f32x4 v[4]; float s = 0.f;
#pragma unroll
        for (int j = 0; j < 4; ++j) { v[j] = xr[64 * j]; s += (v[j].x * v[j].x + v[j].y * v[j].y) + (v[j].z * v[j].z + v[j].w * v[j].w); }
        const float r = 1.0f / sqrtf(wave_sum(s) * (1.0f / D) + pg8::RMS_EPS);
#pragma unroll
        for (int j = 0; j < 4; ++j) { const f32x4 gv = *((const f32x4*)g + F.lane + 64 * j); xr[64 * j] = v[j] * r * gv; }
    }
}

struct Args { const float* in[16]; float* out; unsigned char* ws; int ph_lo, ph_hi; };
template <bool COOP>
__global__ void __launch_bounds__(NTHREADS, 2) fwd(Args args) {
    extern __shared__ __attribute__((aligned(16))) unsigned char lds[];
    Frame F;
    F.lds = (LAS unsigned char*)lds; F.tid = threadIdx.x; F.lane = F.tid & 63; F.wave = __builtin_amdgcn_readfirstlane(F.tid >> 6);
    F.G = gridDim.x; F.bid = blockIdx.x;
#pragma unroll
    for (int i = 0; i < 16; ++i) F.in[i] = args.in[i];
    F.out = args.out; F.ws = args.ws;
    unsigned char* ws = args.ws;
    const int lo = args.ph_lo, hi = args.ph_hi;
#define IN(k) (lo <= (k) && (k) < hi)
#define REPEAT(k, call) do { if (PROBE_REPEAT == (k)) { __syncthreads(); call; __syncthreads(); } } while (0)
    XcdBarrier bar; bar.bar = (unsigned*)(ws + WS_CTL) + CW_BAR; bar.x = 0; bar.st = nullptr;
    if constexpr (COOP) {
        volatile LAS unsigned* misc = (volatile LAS unsigned*)(F.lds + LDS_MISC);
        if (F.tid < 64) misc[F.tid] = 0u;
        __syncthreads();
        bar = xcd_barrier_post((unsigned*)(ws + WS_CTL) + CW_BAR, misc);
    }
#define SEAM(k) do { if constexpr (COOP) { if (IN(k) && IN((k) + 1)) xcd_barrier(bar); } } while (0)
    typedef pg8::bf16_t hb;
    float* SS1 = (float*)(ws + WS_SS1); float* SS2 = (float*)(ws + WS_SS2); float* SS3 = (float*)(ws + WS_SS3);
    hb* XH = (hb*)(ws + WS_XH);

    if (IN(0)) { p0_prologue(F); REPEAT(0, p0_prologue(F)); } SEAM(0);
    if (IN(1)) {
        pg8::Gemm g{XH, (const hb*)(ws + WS_WA), M, A_PAD, D}; pg8::StaticOrder S; S.init(M, A_PAD, F.G, F.bid);
        pg8::EpiInA E{(const float*)(ws + WS_RS0), (hb*)(ws + WS_QL), (float*)(ws + WS_CKV), (hb*)(ws + WS_QI), (hb*)(ws + WS_KI), (float*)(ws + WS_WI)};
        pg8::gemm_phase<pg8::EpiInA, pg8::StaticOrder, true, true>(F.lds, g, S, E);
    } SEAM(1);
    if (IN(2)) { p2_indexer(F); REPEAT(2, p2_indexer(F)); } SEAM(2);
    if (IN(3)) { REPEAT(3, p3_sparse_attn(F, (hbits*)F.out)); p3_sparse_attn(F, (hbits*)(ws + WS_QL)); } SEAM(3);
    if (IN(4)) {
        pg8::Gemm g{(const hb*)(ws + WS_QL), (const hb*)(ws + WS_WCT), M, D, NH * RL}; pg8::StaticOrder S; S.init(M, D, F.G, F.bid);
        pg8::EpiRes E{F.in[0], F.out, XH, SS1, nullptr};
        pg8::gemm_phase<pg8::EpiRes, pg8::StaticOrder, true, true>(F.lds, g, S, E);
    } SEAM(4);
    if (IN(5)) {
        pg8::Gemm g{XH, (const hb*)(ws + WS_WGU0), M, 2 * FF, D}; pg8::StaticOrder S; S.init(M, 2 * FF, F.G, F.bid);
        pg8::EpiGU E{SS1, (hb*)(ws + WS_HB)};
        pg8::gemm_phase<pg8::EpiGU, pg8::StaticOrder, true, true>(F.lds, g, S, E);
    } SEAM(5);
    if (IN(6)) {
        pg8::Gemm g{(const hb*)(ws + WS_HB), (const hb*)(ws + WS_WD0), M, D, FF}; pg8::StaticOrder S; S.init(M, D, F.G, F.bid);
        pg8::EpiRes E{F.out, F.out, XH, SS2, nullptr};
        pg8::gemm_phase<pg8::EpiRes, pg8::StaticOrder, true, true>(F.lds, g, S, E);
    } SEAM(6);
    if (IN(7)) {
        pg8::Gemm g{XH, (const hb*)(ws + WS_WB), M, B_IN, D}; pg8::StaticOrder S; S.init(M, B_IN, F.G, F.bid);
        pg8::EpiInB E{SS2, F.in[10], (hb*)(ws + WS_QKV1)};
        pg8::gemm_phase<pg8::EpiInB, pg8::StaticOrder, true, true>(F.lds, g, S, E);
    } SEAM(7);
    if (IN(8)) { p8_swa(F); REPEAT(8, p8_swa(F)); } SEAM(8);
    if (IN(9)) {
        pg8::Gemm g{(const hb*)(ws + WS_OB), (const hb*)(ws + WS_WBO), M, D, D}; pg8::StaticOrder S; S.init(M, D, F.G, F.bid);
        pg8::EpiRes E{F.out, F.out, XH, SS3, F.in[13]};
        pg8::gemm_phase<pg8::EpiRes, pg8::StaticOrder, true, true>(F.lds, g, S, E);
    } SEAM(9);
    if (IN(10)) {
        pg8::Gemm g{XH, (const hb*)(ws + WS_WGU1), M, 2 * FF, D}; pg8::StaticOrder S; S.init(M, 2 * FF, F.G, F.bid);
        pg8::EpiGU E{SS3, (hb*)(ws + WS_HB)};
        pg8::gemm_phase<pg8::EpiGU, pg8::StaticOrder, true, true>(F.lds, g, S, E);
    } SEAM(10);
    if (IN(11)) {
        pg8::Gemm g{(const hb*)(ws + WS_HB), (const hb*)(ws + WS_WD1), M, D, FF}; pg8::StaticOrder S; S.init(M, D, F.G, F.bid);
        pg8::EpiRes E{F.out, F.out, XH, SS1, nullptr};
        pg8::gemm_phase<pg8::EpiRes, pg8::StaticOrder, true, true>(F.lds, g, S, E);
    } SEAM(11);
    if (IN(12)) { p12_final(F); }
#undef IN
#undef SEAM
}

extern "C" void kernel_launch(void* const* d_in, const int* in_sizes, int n_in, void* d_out, int out_size, void* d_ws, size_t ws_size, hipStream_t stream) {
    static int grid = 0;
    if (grid == 0) {
        if (n_in != 16 || in_sizes[0] != M * D || out_size != M * D || ws_size < WS_END) { fprintf(stderr, "kernel_launch: unexpected shapes (n_in %d, in0 %d, out %d, ws %zu)\n", n_in, n_in > 0 ? in_sizes[0] : -1, out_size, ws_size); grid = -1; return; }
        int dev = 0, cus = 0, per_cu = 0;
        if (hipGetDevice(&dev) != hipSuccess || hipDeviceGetAttribute(&cus, hipDeviceAttributeMultiprocessorCount, dev) != hipSuccess) { grid = -1; return; }
        const void* fn = MK_ONE_LAUNCH ? (const void*)fwd<true> : (const void*)fwd<false>;
        if (hipFuncSetAttribute(fn, hipFuncAttributeMaxDynamicSharedMemorySize, LDS_BYTES) != hipSuccess) { fprintf(stderr, "kernel_launch: hipFuncSetAttribute failed\n"); grid = -1; return; }
        if (hipOccupancyMaxActiveBlocksPerMultiprocessor(&per_cu, fn, NTHREADS, LDS_BYTES) != hipSuccess || per_cu < 1) { fprintf(stderr, "kernel_launch: occupancy query says %d blocks per CU\n", per_cu); per_cu = 1; }
        (void)hipGetLastError();
        grid = cus;
    }
    if (grid < 0) return;
    (void)hipMemsetAsync((char*)d_ws + WS_CTL, 0, CTL_ZERO_BYTES, stream);
    Args a{};
    for (int i = 0; i < 16; ++i) a.in[i] = (const float*)d_in[i];
    a.out = (float*)d_out; a.ws = (unsigned char*)d_ws;
#if MK_ONE_LAUNCH
    a.ph_lo = 0; a.ph_hi = N_PHASES;
    hipLaunchKernelGGL(fwd<true>, dim3(grid), dim3(NTHREADS), LDS_BYTES, stream, a);
#else
    for (int p = 0; p < N_PHASES; ++p) { a.ph_lo = p; a.ph_hi = p + 1; hipLaunchKernelGGL(fwd<false>, dim3(grid), dim3(NTHREADS), LDS_BYTES, stream, a); }
#endif
}
```

```cpp
#include <hip/hip_runtime.h>
#include <hip/hip_cooperative_groups.h>
#include <cstdio>
#include <cstdint>
namespace cg = cooperative_groups;

typedef _Float16 f16x8 __attribute__((ext_vector_type(8)));
typedef _Float16 f16x2 __attribute__((ext_vector_type(2)));
typedef _Float16 f16;
namespace pg8 {
#define PG8_LAS __attribute__((address_space(3)))
typedef unsigned short bf16_t;
typedef short bf16x8 __attribute__((ext_vector_type(8)));
typedef float f32x4 __attribute__((ext_vector_type(4)));
typedef unsigned u32x4 __attribute__((ext_vector_type(4)));
constexpr int BM = 256, BK = 64, HALF = 128, HTB = HALF * BK * 2  , STAGE_BYTES = 8 * HTB, NXCD = 8, WGM = 8;

__host__ __device__ __forceinline__ int lds_byte(int r, int c) { const int st = (r >> 4) * 2 + (c >> 5), rr = r & 15, cc = c & 31, ob = rr * 64 + cc * 2; return st * 1024 + (ob ^ (((ob >> 9) & 1) << 5)); }
__host__ __device__ __forceinline__ void stage_rc(int b, int& R, int& C) { const int st = b / 1024, sb = b % 1024, swz = sb ^ (((sb >> 9) & 1) << 5); R = (st >> 1) * 16 + swz / 64; C = (st & 1) * 32 + (swz % 64) / 2; }
__host__ __device__ __forceinline__ int perm32(int rho) { const int n = rho >> 4, i = rho & 15; return 8 * (i >> 2) + 4 * n + (i & 3); }

struct Unit { int pm, pn; };
struct Gemm { const bf16_t* A; const bf16_t* Bt; int M, N, K; };

struct StaticOrder {
    int nM, nN, nwg, G, c;
    __host__ __device__ void init(int M, int N, int G_, int c_) { nM = M / BM; nN = N / BM; nwg = nM * nN; G = G_; c = c_; }
    __host__ __device__ bool next(int i, Unit& u) const {
        const long L = (long)i * G + c; if (L >= nwg) return false;
        int wgid = (int)L; { const int q = nwg / NXCD, r = nwg % NXCD, xcd = wgid % NXCD, off = wgid / NXCD; wgid = (xcd < r ? xcd * (q + 1) : r * (q + 1) + (xcd - r) * q) + off; }
        const int nig = WGM * nN, gid = wgid / nig, fm = gid * WGM, gsz = (nM - fm) < WGM ? (nM - fm) : WGM;
        u.pm = fm + ((wgid % nig) % gsz); u.pn = (wgid % nig) / gsz; return true;
    }
    __device__ __forceinline__ void a_ready(const Unit&) const {}
    __device__ __forceinline__ void done(const Unit&) const {}
};

__device__ __forceinline__ unsigned pk2h(float lo, float hi) { f16x2 v = {(_Float16)lo, (_Float16)hi}; return __builtin_bit_cast(unsigned, v); }
__device__ __forceinline__ u32x4 pk8h(f32x4 a, f32x4 b) { u32x4 w; w.x = pk2h(a[0], a[1]); w.y = pk2h(a[2], a[3]); w.z = pk2h(b[0], b[1]); w.w = pk2h(b[2], b[3]); return w; }
constexpr float RMS_EPS = 1e-6f;
constexpr float LOG2E = 1.4426950408889634f, QSCALE = 0.08838834764831845f * 1.4426950408889634f;

struct EpiInA {
    static constexpr bool PERM = true, AFTER_DRAIN = false;
    const float* rs; bf16_t* QL; float* CKV; bf16_t* QI; bf16_t* KI; float* WI;
    __device__ __forceinline__ void operator()(const f32x4 (&acc)[2][2][4][2], const Unit& u, int wr, int wc, int fr, int fq) const {
        const int row0 = u.pm * BM + wr * 64 + fr;
#pragma unroll
        for (int ai = 0; ai < 2; ++ai)
#pragma unroll
            for (int m = 0; m < 4; ++m) { const int row = row0 + ai * HALF + m * 16; const float r = rs[row];
#pragma unroll
                for (int bj = 0; bj < 2; ++bj) { const int col = u.pn * BM + bj * HALF + wc * 32 + 8 * fq;
                    f32x4 v0 = acc[ai][bj][m][0] * r, v1 = acc[ai][bj][m][1] * r;
                    if (col < 2048) { v0 = v0 * QSCALE; v1 = v1 * QSCALE; *(u32x4*)(QL + (size_t)row * 2048 + col) = pk8h(v0, v1); }
                    else if (col < 2176) { float* p = CKV + (size_t)row * 128 + (col - 2048); *(f32x4*)p = v0; *(f32x4*)(p + 4) = v1; }
                    else if (col < 2688) { v0 = v0 * 0.125f; v1 = v1 * 0.125f; *(u32x4*)(QI + (size_t)row * 512 + (col - 2176)) = pk8h(v0, v1); }
                    else if (col < 2752) { *(u32x4*)(KI + (size_t)row * 64 + (col - 2688)) = pk8h(v0, v1); }
                    else if (col < 2760) { const float s = 0.35355339059327373f; float* p = WI + (size_t)row * 8; *(f32x4*)p = v0 * s; *(f32x4*)(p + 4) = v1 * s; }
                } }
    }
};
template <bool FINAL> struct EpiRes {
    static constexpr bool PERM = true, AFTER_DRAIN = false;
    bf16_t* xh; float* ss; const float* bias; float* xf;
    __device__ __forceinline__ void operator()(const f32x4 (&acc)[2][2][4][2], const Unit& u, int wr, int wc, int fr, int fq) const {
        const int row0 = u.pm * BM + wr * 64 + fr;
#pragma unroll
        for (int ai = 0; ai < 2; ++ai)
#pragma unroll
            for (int m = 0; m < 4; ++m) { const int row = row0 + ai * HALF + m * 16; float sq = 0.f;
#pragma unroll
                for (int bj = 0; bj < 2; ++bj) { const int col = u.pn * BM + bj * HALF + wc * 32 + 8 * fq; const size_t off = (size_t)row * 1024 + col;
                    const f16x8 xo = __builtin_bit_cast(f16x8, *(const u32x4*)(xh + off));
                    f32x4 v0 = acc[ai][bj][m][0] + (f32x4){(float)xo[0], (float)xo[1], (float)xo[2], (float)xo[3]}, v1 = acc[ai][bj][m][1] + (f32x4){(float)xo[4], (float)xo[5], (float)xo[6], (float)xo[7]};
                    if (bias) { v0 = v0 + *(const f32x4*)(bias + col); v1 = v1 + *(const f32x4*)(bias + col + 4); }
                    if constexpr (FINAL) { *(f32x4*)(xf + off) = v0; *(f32x4*)(xf + off + 4) = v1; }
                    else { *(u32x4*)(xh + off) = pk8h(v0, v1);
                        sq += (v0[0] * v0[0] + v0[1] * v0[1]) + (v0[2] * v0[2] + v0[3] * v0[3]) + (v1[0] * v1[0] + v1[1] * v1[1]) + (v1[2] * v1[2] + v1[3] * v1[3]); } }
                if constexpr (!FINAL) { sq += __shfl_xor(sq, 16); sq += __shfl_xor(sq, 32);
                    if (fq == 0) atomicAdd(ss + row, sq); } }
    }
};
struct EpiGU {
    static constexpr bool PERM = true, AFTER_DRAIN = false;
    const float* ss; bf16_t* HB;
    __device__ __forceinline__ void operator()(const f32x4 (&acc)[2][2][4][2], const Unit& u, int wr, int wc, int fr, int fq) const {
        const int row0 = u.pm * BM + wr * 64 + fr; const int col = u.pn * HALF + wc * 32 + 8 * fq;
#pragma unroll
        for (int ai = 0; ai < 2; ++ai)
#pragma unroll
            for (int m = 0; m < 4; ++m) { const int row = row0 + ai * HALF + m * 16; const float r = 1.0f / sqrtf(ss[row] * (1.0f / 1024.0f) + RMS_EPS);
                f32x4 hv[2];
#pragma unroll
                for (int n = 0; n < 2; ++n)
#pragma unroll
                    for (int j = 0; j < 4; ++j) { const float g = acc[ai][0][m][n][j] * r, uu = acc[ai][1][m][n][j] * r;
                        hv[n][j] = g * __builtin_amdgcn_rcpf(1.0f + __builtin_amdgcn_exp2f(-1.4426950408889634f * g)) * uu; }
                *(u32x4*)(HB + (size_t)row * 2816 + col) = pk8h(hv[0], hv[1]); }
    }
};
struct EpiInB {
    static constexpr bool PERM = true, AFTER_DRAIN = false;
    const float* ss; const float* bias; bf16_t* QKV;
    __device__ __forceinline__ void operator()(const f32x4 (&acc)[2][2][4][2], const Unit& u, int wr, int wc, int fr, int fq) const {
        const int row0 = u.pm * BM + wr * 64 + fr;
#pragma unroll
        for (int ai = 0; ai < 2; ++ai)
#pragma unroll
            for (int m = 0; m < 4; ++m) { const int row = row0 + ai * HALF + m * 16; const float r = 1.0f / sqrtf(ss[row] * (1.0f / 1024.0f) + RMS_EPS);
#pragma unroll
                for (int bj = 0; bj < 2; ++bj) { const int col = u.pn * BM + bj * HALF + wc * 32 + 8 * fq;
                    f32x4 v0 = acc[ai][bj][m][0] * r + *(const f32x4*)(bias + col), v1 = acc[ai][bj][m][1] * r + *(const f32x4*)(bias + col + 4);
                    if (col < 1024) { v0 = v0 * (0.125f * LOG2E); v1 = v1 * (0.125f * LOG2E); }
                    *(u32x4*)(QKV + (size_t)row * 1280 + col) = pk8h(v0, v1); } }
    }
};

template <class Epi, class Sched, bool ALIGN_EPI = false, bool SP2 = false>
__device__ __forceinline__ void gemm_phase(PG8_LAS unsigned char* lds, const Gemm g, const Sched& S, const Epi& E) {
    const int tid = threadIdx.x, wid = __builtin_amdgcn_readfirstlane(tid >> 6), lane = tid & 63, wr = wid >> 2, wc = wid & 3, fr = lane & 15, fq = lane >> 4;
    const int K = g.K, nt = K / BK;
    unsigned voffA[2], voffB[2];
#pragma unroll
    for (int i = 0; i < 2; ++i) { int R, C; stage_rc(tid * 16 + i * 8192, R, C); const int Rb = Epi::PERM ? ((R & ~31) + perm32(R & 31)) : R;
        voffA[i] = (unsigned)(R * K + C) * 2u; voffB[i] = (unsigned)(Rb * K + C) * 2u; }
    const size_t kstep = (size_t)(BK * 2);
    const size_t hstep = (size_t)HALF * K * 2;
    const size_t tstep = 2 * hstep;
    const unsigned ldsw = (unsigned)wid * 1024u;
    const int aoff = lds_byte(wr * 64 + fr, fq * 8), boff = lds_byte(wc * 32 + fr, fq * 8);
#define PG8_SA(b, h) (((b) * 2 + (h)) * HTB)
#define PG8_SB(b, h) ((4 + (b) * 2 + (h)) * HTB)
#define PG8_STAGE(bufoff, gbase, voff) do { _Pragma("unroll") for (int _i = 0; _i < 2; ++_i) \
        __builtin_amdgcn_global_load_lds((const unsigned*)((const char*)(gbase) + (voff)[_i]), (PG8_LAS unsigned*)(lds + (bufoff) + ldsw + _i * 8192), 16, 0, 0); } while (0)
#define PG8_LDA(dst, b, h) do { _Pragma("unroll") for (int m = 0; m < 4; ++m) _Pragma("unroll") for (int k = 0; k < 2; ++k) dst[m][k] = *(const PG8_LAS bf16x8*)(lds + PG8_SA(b, h) + aoff + m * 2048 + k * 1024); } while (0)
#define PG8_LDB(dst, b, h) do { _Pragma("unroll") for (int n = 0; n < 2; ++n) _Pragma("unroll") for (int k = 0; k < 2; ++k) dst[n][k] = *(const PG8_LAS bf16x8*)(lds + PG8_SB(b, h) + boff + n * 2048 + k * 1024); } while (0)
#define PG8_MMA(ai, bj, At, Bt) do { __builtin_amdgcn_s_setprio(1); _Pragma("unroll") for (int m = 0; m < 4; ++m) _Pragma("unroll") for (int n = 0; n < 2; ++n) _Pragma("unroll") for (int k = 0; k < 2; ++k) \
        acc[ai][bj][m][n] = __builtin_amdgcn_mfma_f32_16x16x32_f16(__builtin_bit_cast(f16x8, Bt[n][k]), __builtin_bit_cast(f16x8, At[m][k]), acc[ai][bj][m][n], 0, 0, 0); __builtin_amdgcn_s_setprio(0); } while (0)
#define PG8_WAIT_V(n) asm volatile("s_waitcnt vmcnt(" #n ")" ::: "memory")
#define PG8_WAIT_L(n) asm volatile("s_waitcnt lgkmcnt(" #n ")" ::: "memory")
#define PG8_BAR __builtin_amdgcn_s_barrier()
#define PG8_SCHED __builtin_amdgcn_sched_barrier(0)
    Unit cur, nxt; int ui = 0;
    if (!S.next(0, cur)) return;
    f32x4 acc[2][2][4][2];
#pragma unroll
    for (int a = 0; a < 2; ++a)
#pragma unroll
        for (int b = 0; b < 2; ++b)
#pragma unroll
            for (int m = 0; m < 4; ++m)
#pragma unroll
                for (int n = 0; n < 2; ++n) acc[a][b][m][n] = (f32x4){0.f, 0.f, 0.f, 0.f};
    bf16x8 At[4][2], B0[2][2], B1[2][2];
    const char* cA = (const char*)g.A + (size_t)cur.pm * tstep; const char* cB = (const char*)g.Bt + (size_t)cur.pn * tstep;
    S.a_ready(cur);
    if constexpr (SP2) {
        PG8_STAGE(PG8_SB(0, 0), cB, voffB); PG8_STAGE(PG8_SB(0, 1), cB + hstep, voffB); PG8_STAGE(PG8_SA(0, 0), cA, voffA); PG8_STAGE(PG8_SA(0, 1), cA + hstep, voffA);
        if (wr == 1) PG8_BAR;
        PG8_WAIT_V(2); PG8_BAR;
        PG8_STAGE(PG8_SB(1, 0), cB + kstep, voffB); PG8_STAGE(PG8_SA(1, 0), cA + kstep, voffA); PG8_STAGE(PG8_SB(1, 1), cB + hstep + kstep, voffB);
        PG8_WAIT_V(6); PG8_BAR;
    } else {
        PG8_STAGE(PG8_SB(0, 0), cB, voffB); PG8_STAGE(PG8_SA(0, 0), cA, voffA); PG8_STAGE(PG8_SB(0, 1), cB + hstep, voffB); PG8_STAGE(PG8_SA(0, 1), cA + hstep, voffA);
        if (wr == 1) PG8_BAR;
        PG8_WAIT_V(4); PG8_BAR;
        PG8_STAGE(PG8_SB(1, 0), cB + kstep, voffB); PG8_STAGE(PG8_SA(1, 0), cA + kstep, voffA); PG8_STAGE(PG8_SB(1, 1), cB + hstep + kstep, voffB);
        PG8_WAIT_V(6); PG8_BAR;
    }
    for (;;) {
        const bool has_next = S.next(ui + 1, nxt);
        const char* nA = has_next ? (const char*)g.A + (size_t)nxt.pm * tstep : cA; const char* nB = has_next ? (const char*)g.Bt + (size_t)nxt.pn * tstep : cB;
        for (int t = 0; t < nt; t += 2) {
            const bool last = (t == nt - 2);
            const char* a1 = cA + (size_t)(t + 1) * kstep;
            const char* a2 = last ? nA : cA + (size_t)(t + 2) * kstep; const char* b2 = last ? nB : cB + (size_t)(t + 2) * kstep;
            const char* a3 = a2 + kstep; const char* b3 = b2 + kstep;
            if (last && has_next) S.a_ready(nxt);
            if constexpr (SP2) {
            PG8_LDB(B0, 0, 0); PG8_LDB(B1, 0, 1); PG8_SCHED; PG8_LDA(At, 0, 0); PG8_STAGE(PG8_SA(1, 1), a1 + hstep, voffA);
            PG8_WAIT_V(8); PG8_WAIT_L(0); PG8_BAR; PG8_MMA(0, 0, At, B0); PG8_MMA(0, 1, At, B1); PG8_BAR; PG8_SCHED;
            PG8_LDA(At, 0, 1); PG8_STAGE(PG8_SB(0, 0), b2, voffB); PG8_STAGE(PG8_SB(0, 1), b2 + hstep, voffB); PG8_STAGE(PG8_SA(0, 0), a2, voffA);
            PG8_WAIT_V(8); PG8_WAIT_L(0); PG8_BAR; PG8_MMA(1, 0, At, B0); PG8_MMA(1, 1, At, B1); PG8_BAR; PG8_SCHED;
            PG8_LDB(B0, 1, 0); PG8_LDB(B1, 1, 1); PG8_SCHED; PG8_LDA(At, 1, 0); PG8_STAGE(PG8_SA(0, 1), a2 + hstep, voffA);
            PG8_WAIT_V(8); PG8_WAIT_L(0); PG8_BAR; PG8_MMA(0, 0, At, B0); PG8_MMA(0, 1, At, B1); PG8_BAR; PG8_SCHED;
            PG8_LDA(At, 1, 1); PG8_STAGE(PG8_SB(1, 0), b3, voffB); PG8_STAGE(PG8_SB(1, 1), b3 + hstep, voffB); PG8_STAGE(PG8_SA(1, 0), a3, voffA);
            PG8_WAIT_V(8); PG8_WAIT_L(0); PG8_BAR; PG8_MMA(1, 0, At, B0); PG8_MMA(1, 1, At, B1); PG8_BAR; PG8_SCHED;
            } else {
            PG8_LDB(B0, 0, 0); PG8_SCHED; PG8_LDA(At, 0, 0); PG8_STAGE(PG8_SA(1, 1), a1 + hstep, voffA);
            PG8_WAIT_L(8); PG8_BAR; PG8_WAIT_L(0); PG8_MMA(0, 0, At, B0); PG8_BAR; PG8_SCHED;
            PG8_LDB(B1, 0, 1); PG8_STAGE(PG8_SB(0, 0), b2, voffB);
            PG8_BAR; PG8_WAIT_L(0); PG8_MMA(0, 1, At, B1); PG8_BAR;
            PG8_LDA(At, 0, 1); PG8_STAGE(PG8_SA(0, 0), a2, voffA);
            PG8_BAR; PG8_WAIT_L(0); PG8_MMA(1, 0, At, B0); PG8_BAR; PG8_SCHED;
            PG8_STAGE(PG8_SB(0, 1), b2 + hstep, voffB);
            PG8_WAIT_V(6); PG8_BAR; PG8_MMA(1, 1, At, B1); PG8_BAR;
            PG8_LDB(B0, 1, 0); PG8_SCHED; PG8_LDA(At, 1, 0); PG8_STAGE(PG8_SA(0, 1), a2 + hstep, voffA);
            PG8_WAIT_L(8); PG8_BAR; PG8_WAIT_L(0); PG8_MMA(0, 0, At, B0); PG8_BAR; PG8_SCHED;
            PG8_LDB(B1, 1, 1); PG8_STAGE(PG8_SB(1, 0), b3, voffB);
            PG8_BAR; PG8_WAIT_L(0); PG8_MMA(0, 1, At, B1); PG8_BAR;
            PG8_LDA(At, 1, 1); PG8_STAGE(PG8_SA(1, 0), a3, voffA);
            PG8_BAR; PG8_WAIT_L(0); PG8_MMA(1, 0, At, B0); PG8_BAR; PG8_SCHED;
            PG8_STAGE(PG8_SB(1, 1), b3 + hstep, voffB);
            PG8_WAIT_V(6); PG8_BAR; PG8_MMA(1, 1, At, B1); PG8_BAR;
            }
        }
        if constexpr (ALIGN_EPI) { if (wr == 0) PG8_BAR; }
        if constexpr (!Epi::AFTER_DRAIN) { E(acc, cur, wr, wc, fr, fq); S.done(cur); }
        if (!has_next) break;
#pragma unroll
        for (int a = 0; a < 2; ++a)
#pragma unroll
            for (int b = 0; b < 2; ++b)
#pragma unroll
                for (int m = 0; m < 4; ++m)
#pragma unroll
                    for (int n = 0; n < 2; ++n) acc[a][b][m][n] = (f32x4){0.f, 0.f, 0.f, 0.f};
        cur = nxt; cA = nA; cB = nB; ++ui;
        if constexpr (ALIGN_EPI) { if (wr == 1) PG8_BAR; }
    }
    PG8_WAIT_V(0);
    if constexpr (!ALIGN_EPI) { if (wr == 0) PG8_BAR; }
    PG8_BAR;
    if constexpr (Epi::AFTER_DRAIN) { E.fused(acc, cur, wr, wc, fr, fq, lds, wid, lane); S.done(cur); }
#undef PG8_SA
#undef PG8_SB
#undef PG8_STAGE
#undef PG8_LDA
#undef PG8_LDB
#undef PG8_MMA
#undef PG8_WAIT_V
#undef PG8_WAIT_L
#undef PG8_BAR
#undef PG8_SCHED
}
}

constexpr int NB = 8, T = 2048, D = 1024, M = NB * T, NH = 16, RL = 128, VH = 64, HI = 8, DI = 64, KSEL = 256;
constexpr int A_IN = 2760, A_PAD = 2816, B_IN = 1280, FF = 2816, WIN = 128;
constexpr int NWAVES = 8, NTHREADS = NWAVES * 64;
constexpr int N_PHASES = 13;
#ifndef PROBE_REPEAT
#define PROBE_REPEAT (-1)
#endif
#ifndef MK_ONE_LAUNCH
#define MK_ONE_LAUNCH 1
#endif
constexpr size_t MiB = 1u << 20;
constexpr size_t WS_CTL = 0, CTL_ZERO_BYTES = 1 * MiB;
constexpr size_t WS_SS1 = 256 * 1024, WS_SS2 = 320 * 1024, WS_SS3 = 384 * 1024;
constexpr int CW_BAR = 4096;
constexpr size_t WS_RS0 = 1 * MiB;
constexpr size_t WS_WA = 2 * MiB, WS_WUV = WS_WA + (size_t)A_PAD * D * 2, WS_WAO = 8 * MiB, WS_WGU0 = 10 * MiB, WS_WGU1 = 21 * MiB, WS_WD0 = 32 * MiB,
                 WS_WD1 = WS_WD0 + (size_t)D * FF * 2, WS_WB = 43 * MiB, WS_WBO = 46 * MiB;
constexpr size_t WS_XH = 50 * MiB;
constexpr size_t WS_QL = 82 * MiB, WS_CKV = 146 * MiB, WS_CKVN = 154 * MiB, WS_QI = 158 * MiB, WS_KI = 174 * MiB, WS_WI = 176 * MiB, WS_IDX = 178 * MiB, WS_OV = 186 * MiB;
constexpr size_t WS_HB = 82 * MiB, WS_QKV1 = 170 * MiB, WS_OB = 210 * MiB, WS_WCT = 242 * MiB, WS_END = 246 * MiB;
static_assert(WS_WUV + 16 * 64 * 128 * 2 <= WS_WAO && WS_WD1 + (size_t)D * FF * 2 <= WS_WB && WS_WB + (size_t)B_IN * D * 2 <= WS_WBO && WS_WBO + 2 * MiB <= WS_XH, "weights map");
static_assert(WS_HB + (size_t)M * FF * 2 <= WS_QKV1 && WS_QKV1 + (size_t)M * B_IN * 2 <= WS_OB && WS_OB + (size_t)M * D * 2 <= WS_WCT, "activation map");
constexpr int LDS_MISC = 147456, LDS_BYTES = 147456 + 256;

#define GAS __attribute__((address_space(1)))
#define LAS __attribute__((address_space(3)))
typedef unsigned v4u __attribute__((ext_vector_type(4)));
typedef float f32x4 __attribute__((ext_vector_type(4)));
typedef unsigned short hbits;
using pg8::pk2h;

__device__ const unsigned char BUCKET_TAB[129] = {0,1,2,3,4,5,6,7,8,9,10,11,12,13,14,15,16,16,16,17,17,18,18,18,19,19,19,20,20,20,20,21,21,21,21,22,22,22,22,22,23,23,23,23,23,23,24,24,24,24,24,24,25,25,25,25,25,25,25,26,26,26,26,26,26,26,26,27,27,27,27,27,27,27,27,27,27,28,28,28,28,28,28,28,28,28,28,29,29,29,29,29,29,29,29,29,29,29,29,30,30,30,30,30,30,30,30,30,30,30,30,30,30,31,31,31,31,31,31,31,31,31,31,31,31,31,31,31,31};

__device__ __forceinline__ float wave_sum(float v) {
#pragma unroll
    for (int o = 1; o < 64; o <<= 1) v += __shfl_xor(v, o);
    return v;
}
__device__ __forceinline__ float wave_max(float v) {
#pragma unroll
    for (int o = 1; o < 64; o <<= 1) v = fmaxf(v, __shfl_xor(v, o));
    return v;
}
#define LDS_WAIT() asm volatile("s_waitcnt lgkmcnt(0)" ::: "memory")

#define XB_TMO      128
#define XB_XCNT(j)  (256  + 64 * (j))
#define XB_XSUB(j)  (1280 + 64 * (j))
#define XB_XGEN(j)  (2304 + 64 * (j))
#define XB_TOP      3328
#define XB_TOPGEN   3392
#define XCD_BAR_WORDS 3456
#define XB_SPIN_CAP (1u << 18)

__device__ __forceinline__ unsigned xb_ld(unsigned* p)              { return __hip_atomic_load(p, __ATOMIC_RELAXED, __HIP_MEMORY_SCOPE_AGENT); }
__device__ __forceinline__ unsigned xb_add(unsigned* p, unsigned v) { return __hip_atomic_fetch_add(p, v, __ATOMIC_RELAXED, __HIP_MEMORY_SCOPE_AGENT); }
__device__ __forceinline__ unsigned xb_xcc_id() { return (unsigned)__builtin_amdgcn_s_getreg((3 << 11) | 20) & 0xFu; }
#define XB_SPIN(cond, bar) do { unsigned _sp = 0; while (cond) { __builtin_amdgcn_s_sleep(1); \
    if ((++_sp & 255u) == 0u) { if (xb_ld(&(bar)[XB_TMO])) break; if (_sp > XB_SPIN_CAP) { atomicAdd(&(bar)[XB_TMO], 1u); break; } } } } while (0)

struct XcdBarrier {
    unsigned* bar; unsigned x;
    volatile LAS unsigned* st;
};

__device__ __forceinline__ XcdBarrier xcd_barrier_post(unsigned* bar, volatile LAS unsigned* st) {
    XcdBarrier b; b.bar = bar; b.x = xb_xcc_id(); b.st = st;
    if (threadIdx.x == 0) (void)xb_add(&bar[XB_XCNT(b.x)], 1u);
    return b;
}
__device__ __forceinline__ void xcd_barrier_complete(unsigned* bar, unsigned x, unsigned& nloc, unsigned& nx) {
    const unsigned G = gridDim.x * gridDim.y * gridDim.z;
    unsigned sum, cnt, mine, sp = 0u;
    for (;;) {
        sum = 0u; cnt = 0u; mine = 0u;
#pragma unroll
        for (unsigned j = 0; j < 16; ++j) { const unsigned c = xb_ld(&bar[XB_XCNT(j)]); sum += c; cnt += (c > 0u) ? 1u : 0u; mine = (j == x) ? c : mine; }
        if (sum == G) break;
        __builtin_amdgcn_s_sleep(1);
        if ((++sp & 255u) == 0u) { if (xb_ld(&bar[XB_TMO])) break; if (sp > XB_SPIN_CAP) { atomicAdd(&bar[XB_TMO], 1u); break; } }
    }
    nloc = mine > 0u ? mine : 1u; nx = cnt > 0u ? cnt : 1u;
}

__device__ __forceinline__ void xcd_barrier(const XcdBarrier& b) {
    asm volatile("s_waitcnt vmcnt(0)" ::: "memory");
    __syncthreads();
    if (threadIdx.x == 0) {
        unsigned* bar = b.bar;
        __builtin_amdgcn_s_waitcnt(0);
        unsigned nloc = b.st[0], nx = b.st[1];
        if (nloc == 0u) { xcd_barrier_complete(bar, b.x, nloc, nx); b.st[0] = nloc; b.st[1] = nx; }
        const unsigned old = xb_add(&bar[XB_XSUB(b.x)], 1u);
        const unsigned gen = old / nloc;
        if (old + 1u == (gen + 1u) * nloc) {
            __builtin_amdgcn_fence(__ATOMIC_RELEASE, "agent");
            asm volatile("s_waitcnt vmcnt(0)" ::: "memory");
            const unsigned og = xb_add(&bar[XB_TOP], 1u);
            const unsigned tg = og / nx;
            if (og + 1u == (tg + 1u) * nx) xb_add(&bar[XB_TOPGEN], 1u);
            else XB_SPIN(xb_ld(&bar[XB_TOPGEN]) == tg, bar);
            __builtin_amdgcn_fence(__ATOMIC_ACQUIRE, "agent");
            xb_add(&bar[XB_XGEN(b.x)], 1u);
            asm volatile("s_waitcnt vmcnt(0)" ::: "memory");
        } else {
            XB_SPIN(xb_ld(&bar[XB_XGEN(b.x)]) == gen, bar);
            __builtin_amdgcn_fence(__ATOMIC_ACQUIRE, "agent");
            asm volatile("s_waitcnt vmcnt(0)" ::: "memory");
        }
    }
    __syncthreads();
}

struct Frame {
    LAS unsigned char* lds;
    int tid, lane, wave, G, bid;
    const float* in[16]; float* out; unsigned char* ws;
};

__device__ __forceinline__ void tr_item(const float* W, int ldw, int nvalid, const float* gain, hbits* WT, int K, int k0, int n0s, int n0d, LAS float* scr, int lane) {
#pragma unroll 8
    for (int i = 0; i < 32; ++i) { const int kk = 2 * i + (lane >> 5), n = n0s + (lane & 31);
        float v = (n < nvalid) ? W[(size_t)(k0 + kk) * ldw + n] : 0.f; if (gain) v *= gain[k0 + kk]; scr[kk * 33 + (lane & 31)] = v; }
    LDS_WAIT(); asm volatile("" ::: "memory");
    const int c = lane & 7;
#pragma unroll
    for (int j = 0; j < 4; ++j) { const int n = (lane >> 3) + 8 * j; const LAS float* s = scr + (8 * c) * 33 + n;
        v4u o; o.x = pk2h(s[0 * 33], s[1 * 33]); o.y = pk2h(s[2 * 33], s[3 * 33]); o.z = pk2h(s[4 * 33], s[5 * 33]); o.w = pk2h(s[6 * 33], s[7 * 33]);
        *(GAS v4u*)(WT + (size_t)(n0d + n) * K + k0 + 8 * c) = o; }
    LDS_WAIT(); asm volatile("" ::: "memory");
}
__device__ __forceinline__ void p0_prologue(Frame& F) {
    LAS float* scr = (LAS float*)(F.lds + F.wave * 16384);
    const int gw = F.bid * NWAVES + F.wave, NGW = F.G * NWAVES;
    hbits* WA = (hbits*)(F.ws + WS_WA); hbits* WUV = (hbits*)(F.ws + WS_WUV); hbits* WAO = (hbits*)(F.ws + WS_WAO);
    hbits* WB = (hbits*)(F.ws + WS_WB); hbits* WBO = (hbits*)(F.ws + WS_WBO);
    constexpr int I_WA = 16 * (A_PAD / 32), I_UV = 64, I_SQ = 16 * 32, I_GU = 16 * (2 * FF / 32), I_D = (FF / 64) * 32, I_WB = 16 * (B_IN / 32);
    constexpr int NITEMS = I_WA + I_UV + I_SQ + 2 * I_GU + 2 * I_D + I_WB + I_SQ;
    for (int it = gw; it < NITEMS; it += NGW) {
        int r = it;
        if (r < I_WA) { const int nnb = A_PAD / 32, kb = r / nnb, nb = r % nnb; tr_item(F.in[5], A_IN, A_IN, F.in[2], WA, D, 64 * kb, 32 * nb, 32 * nb, scr, F.lane); continue; } r -= I_WA;
        if (r < I_UV) { const int h = r >> 2, kb = (r >> 1) & 1, nb = r & 1; tr_item(F.in[7] + (size_t)h * RL * VH, VH, VH, nullptr, WUV + (size_t)h * VH * RL, RL, 64 * kb, 32 * nb, 32 * nb, scr, F.lane); continue; } r -= I_UV;
        if (r < I_SQ) { const int kb = r / 32, nb = r % 32; tr_item(F.in[8], D, D, nullptr, WAO, D, 64 * kb, 32 * nb, 32 * nb, scr, F.lane); continue; } r -= I_SQ;
        if (r < 2 * I_GU) { const int l = r / I_GU; r -= l * I_GU; const int nnb = 2 * FF / 32, kb = r / nnb, nb = r % nnb; const int c = 32 * nb;
            const int nd = (c < FF) ? ((c / 128) * 256 + (c % 128)) : (((c - FF) / 128) * 256 + 128 + ((c - FF) % 128));
            tr_item(F.in[14] + (size_t)l * D * 2 * FF, 2 * FF, 2 * FF, F.in[3] + l * D, (hbits*)(F.ws + (l ? WS_WGU1 : WS_WGU0)), D, 64 * kb, c, nd, scr, F.lane); continue; } r -= 2 * I_GU;
        if (r < 2 * I_D) { const int l = r / I_D; r -= l * I_D; const int kb = r / 32, nb = r % 32;
            tr_item(F.in[15] + (size_t)l * FF * D, D, D, nullptr, (hbits*)(F.ws + (l ? WS_WD1 : WS_WD0)), FF, 64 * kb, 32 * nb, 32 * nb, scr, F.lane); continue; } r -= 2 * I_D;
        if (r < I_WB) { const int nnb = B_IN / 32, kb = r / nnb, nb = r % nnb; tr_item(F.in[9], B_IN, B_IN, F.in[2] + D, WB, D, 64 * kb, 32 * nb, 32 * nb, scr, F.lane); continue; } r -= I_WB;
        { const int kb = r / 32, nb = r % 32; tr_item(F.in[12], D, D, nullptr, WBO, D, 64 * kb, 32 * nb, 32 * nb, scr, F.lane); }
    }
    { const float* w_uv = F.in[7]; const float* w_out = F.in[8]; hbits* WCT = (hbits*)(F.ws + WS_WCT);
      for (int it = gw; it < 1024; it += NGW) { const int h = it >> 6, dblk = (it >> 2) & 15, rblk = it & 3, d = dblk * 64 + F.lane;
          float wo[64];
#pragma unroll
          for (int v = 0; v < 64; ++v) wo[v] = w_out[(size_t)(h * 64 + v) * D + d];
          for (int r8 = 0; r8 < 4; ++r8) { float acc[8];
#pragma unroll
              for (int rr = 0; rr < 8; ++rr) { const float* u = w_uv + (size_t)(h * RL + rblk * 32 + r8 * 8 + rr) * VH; float sacc = 0.f;
#pragma unroll
                  for (int v = 0; v < 64; ++v) sacc = fmaf(u[v], wo[v], sacc);
                  acc[rr] = sacc; }
              v4u o; o.x = pk2h(acc[0], acc[1]); o.y = pk2h(acc[2], acc[3]); o.z = pk2h(acc[4], acc[5]); o.w = pk2h(acc[6], acc[7]);
              *(GAS v4u*)(WCT + (size_t)d * (NH * RL) + h * RL + rblk * 32 + r8 * 8) = o; } } }
    const float* x = F.in[0]; hbits* XH = (hbits*)(F.ws + WS_XH); float* RS0 = (float*)(F.ws + WS_RS0);
    for (int m = gw; m < M; m += NGW) {
        const GAS f32x4* xr = (const GAS f32x4*)(x + (size_t)m * D) + F.lane;
        f32x4 v[4]; float s = 0.f;
#pragma unroll
        for (int j = 0; j < 4; ++j) { v[j] = xr[64 * j]; s += (v[j].x * v[j].x + v[j].y * v[j].y) + (v[j].z * v[j].z + v[j].w * v[j].w); }
        s = wave_sum(s);
        if (F.lane == 0) RS0[m] = 1.0f / sqrtf(s * (1.0f / D) + pg8::RMS_EPS);
        GAS unsigned long long* o8 = (GAS unsigned long long*)(XH + (size_t)m * D) + F.lane;
#pragma unroll
        for (int j = 0; j < 4; ++j) o8[64 * j] = (unsigned long long)pk2h(v[j].x, v[j].y) | ((unsigned long long)pk2h(v[j].z, v[j].w) << 32);
    }
}

__device__ __forceinline__ unsigned okey(float f) { const unsigned u = __builtin_bit_cast(unsigned, f); return (u & 0x80000000u) ? ~u : (u | 0x80000000u); }
__device__ __forceinline__ int wave_sum_i(int v) {
    v += __builtin_amdgcn_update_dpp(0, v, 0x128, 0xf, 0xf, false);
    v += __builtin_amdgcn_update_dpp(0, v, 0x124, 0xf, 0xf, false);
    v += __builtin_amdgcn_update_dpp(0, v, 0x122, 0xf, 0xf, false);
    v += __builtin_amdgcn_update_dpp(0, v, 0x121, 0xf, 0xf, false);
    return (__builtin_amdgcn_readlane(v, 0) + __builtin_amdgcn_readlane(v, 16)) + (__builtin_amdgcn_readlane(v, 32) + __builtin_amdgcn_readlane(v, 48));
}
__device__ __forceinline__ int lanes_below(unsigned long long m) { return (int)__builtin_amdgcn_mbcnt_hi((unsigned)(m >> 32), __builtin_amdgcn_mbcnt_lo((unsigned)m, 0u)); }
__device__ __forceinline__ void select_topk(const LAS float* sc, int t, unsigned short* idxrow, int lane) {
    unsigned x[32];
#pragma unroll
    for (int q = 0; q < 32; ++q) { const int s = lane + 64 * q; x[q] = (s <= t) ? okey(sc[s]) : 0u; }
#pragma unroll
    for (int jj = 0; jj < 5; ++jj) { const int j = 16 >> jj; const unsigned m = (jj == 0) ? 0x0000FFFFu : (jj == 1) ? 0x00FF00FFu : (jj == 2) ? 0x0F0F0F0Fu : (jj == 3) ? 0x33333333u : 0x55555555u;
#pragma unroll
        for (int k = 0; k < 32; ++k) if ((k & j) == 0) { const unsigned tt = (x[k] ^ (x[k + j] >> j)) & m; x[k] ^= tt; x[k + j] ^= (tt << j); } }
    unsigned alive = 0xFFFFFFFFu, sel = 0u; int need = KSEL;
#pragma unroll
    for (int i = 0; i < 32; ++i) { const unsigned ones = alive & x[i]; const int c = wave_sum_i(__builtin_popcount(ones));
        if (c >= need) alive = ones; else { need -= c; sel |= ones; alive &= ~x[i]; } }
    const int tot = wave_sum_i(__builtin_popcount(alive));
    if (tot == need) sel |= alive;
    else { const unsigned long long lt_mask = (1ull << lane) - 1ull;
        for (int p = 31; p >= 0 && need > 0; --p) { const bool bit = (alive >> p) & 1u; const unsigned long long mb = __ballot(bit); const int c = __builtin_popcountll(mb);
            if (c <= need) { if (bit) sel |= 1u << p; need -= c; } else { if (bit && __builtin_popcountll(mb & lt_mask) < need) sel |= 1u << p; need = 0; } } }
    const int cl = __builtin_popcount(sel); int pos = 0;
#pragma unroll
    for (int bb = 0; bb < 6; ++bb) pos += lanes_below(__ballot((cl >> bb) & 1)) << bb;
    unsigned m = sel;
    while (m) { const int p = __builtin_ctz(m); m &= m - 1u; idxrow[pos++] = (unsigned short)(lane + 64 * (31 - p)); }
}
__device__ __forceinline__ void p2_indexer(Frame& F) {
    const int gw = F.bid * NWAVES + F.wave, NGW = F.G * NWAVES, lane = F.lane, tid = F.tid, wave = F.wave;
    { const float* CKV = (const float*)(F.ws + WS_CKV); hbits* CKVN = (hbits*)(F.ws + WS_CKVN); const float* lg = F.in[6];
      for (int m = gw; m < M; m += NGW) { const float a = CKV[(size_t)m * RL + 2 * lane], b = CKV[(size_t)m * RL + 2 * lane + 1];
          const float s = wave_sum(a * a + b * b); const float r = 1.0f / sqrtf(s * (1.0f / RL) + pg8::RMS_EPS);
          *(unsigned*)(CKVN + (size_t)m * RL + 2 * lane) = pk2h(a * r * lg[2 * lane], b * r * lg[2 * lane + 1]); } }
    LAS float* scb = (LAS float*)F.lds;
    LAS unsigned char* kst = F.lds + 131072;
    const hbits* QI = (const hbits*)(F.ws + WS_QI); const hbits* KI = (const hbits*)(F.ws + WS_KI); const float* WI = (const float*)(F.ws + WS_WI);
    unsigned short* IDX = (unsigned short*)(F.ws + WS_IDX);
    const int a = lane & 15, q = lane >> 4, lrow = tid >> 3, lch = tid & 7, tg = wave & 3, kh = wave >> 2;
    int boff[2];
#pragma unroll
    for (int s = 0; s < 2; ++s) boff[s] = a * 128 + 16 * ((4 * s + q) ^ ((a >> 1) & 7)) + 4096 * kh;
    const int wst = lrow * 128 + 16 * (lch ^ ((lrow >> 1) & 7));
    for (int pu = 0; pu < 2 * ((NB * 64 - F.bid + F.G - 1) / F.G); ++pu) {
        const int p = F.bid + F.G * (pu >> 1), b = p >> 6, j = (pu & 1) ? 127 - (p & 63) : (p & 63), t0 = 16 * j; const size_t tokbase = (size_t)b * T + t0;
        if (t0 < KSEL) {
#pragma unroll
            for (int tt = 0; tt < 2; ++tt) { const int t = t0 + 2 * wave + tt;
#pragma unroll
                for (int jj = 0; jj < 4; ++jj) { const int k = 4 * lane + jj; IDX[(tokbase + 2 * wave + tt) * KSEL + k] = (unsigned short)((k < t) ? k : t); } }
            continue; }
        const int ns = (t0 + 16 + 63) >> 6;
        f16x8 af[2][2];
#pragma unroll
        for (int tl = 0; tl < 2; ++tl)
#pragma unroll
            for (int s = 0; s < 2; ++s) af[tl][s] = __builtin_bit_cast(f16x8, *(const v4u*)(QI + (tokbase + 4 * tg + (a >> 2)) * 512 + ((a & 3) + 4 * tl) * 64 + 32 * s + 8 * q));
        const f32x4 wlo = *(const f32x4*)(WI + (tokbase + 4 * tg + q) * 8), whi = *(const f32x4*)(WI + (tokbase + 4 * tg + q) * 8 + 4);
        LAS float* myrow = scb + (4 * tg + q) * 2048 + 32 * kh + a;
        const hbits* ksrc = KI + ((size_t)b * T + lrow) * DI + 8 * lch;
        v4u r0 = *(const v4u*)(ksrc), r1 = *(const v4u*)(ksrc + 64 * DI);
        *(LAS v4u*)(kst + wst) = r0;
        r0 = *(const v4u*)(ksrc + 2 * 64 * DI);
        for (int st = 0; st < ns; ++st) {
            __syncthreads();
            if (st + 1 < ns) { *(LAS v4u*)(kst + ((st + 1) & 1) * 8192 + wst) = (st & 1) ? r0 : r1; }
            if (st + 3 < ns) { const v4u nx = *(const v4u*)(ksrc + (size_t)(st + 3) * 64 * DI); if (st & 1) r0 = nx; else r1 = nx; }
            const LAS unsigned char* buf = kst + (st & 1) * 8192;
#pragma unroll
            for (int kt = 0; kt < 2; ++kt) { f32x4 au = (f32x4){0.f, 0.f, 0.f, 0.f}, av = (f32x4){0.f, 0.f, 0.f, 0.f};
#pragma unroll
                for (int s = 0; s < 2; ++s) { const f16x8 bf = __builtin_bit_cast(f16x8, *(const LAS v4u*)(buf + boff[s] + 2048 * kt));
                    au = __builtin_amdgcn_mfma_f32_16x16x32_f16(af[0][s], bf, au, 0, 0, 0); av = __builtin_amdgcn_mfma_f32_16x16x32_f16(af[1][s], bf, av, 0, 0, 0); }
                float sc = wlo[0] * fmaxf(au[0], 0.f); sc = fmaf(wlo[1], fmaxf(au[1], 0.f), sc); sc = fmaf(wlo[2], fmaxf(au[2], 0.f), sc); sc = fmaf(wlo[3], fmaxf(au[3], 0.f), sc);
                sc = fmaf(whi[0], fmaxf(av[0], 0.f), sc); sc = fmaf(whi[1], fmaxf(av[1], 0.f), sc); sc = fmaf(whi[2], fmaxf(av[2], 0.f), sc); sc = fmaf(whi[3], fmaxf(av[3], 0.f), sc);
                myrow[64 * st + 16 * kt] = sc; }
        }
        __syncthreads();
#pragma unroll 1
        for (int tt = 0; tt < (PROBE_REPEAT == 21 ? 4 : 2); ++tt) select_topk(scb + (2 * wave + (tt & 1)) * 2048, t0 + 2 * wave + (tt & 1), IDX + (tokbase + 2 * wave + (tt & 1)) * KSEL, lane);
        __syncthreads();
    }
}

typedef short v4i16_t __attribute__((ext_vector_type(4)));
__device__ __forceinline__ int swz_x(int row) { return ((row & 3) << 2) | ((row >> 2) & 3); }
__device__ __forceinline__ void p3_sparse_attn(Frame& F, hbits* Oout) {
    const int lane = F.lane, wave = F.wave, gw = F.bid * NWAVES + wave, NGW = F.G * NWAVES;
    const int a = lane & 15, q = lane >> 4, sq = ((q & 1) << 1) | (q >> 1);
    LAS unsigned char* kvb = F.lds + wave * 16384;
    LAS unsigned short* idl = (LAS unsigned short*)(F.lds + 131072 + wave * 512);
    LAS float* bt = (LAS float*)(F.lds + 135168);
    const float* rel_bias = F.in[1];
    hbits* QL = (hbits*)(F.ws + WS_QL); const hbits* CKVN = (const hbits*)(F.ws + WS_CKVN); const unsigned short* IDX = (const unsigned short*)(F.ws + WS_IDX);
    for (int i = F.tid; i < 129 * 16; i += NTHREADS) bt[i] = rel_bias[(int)BUCKET_TAB[i >> 4] * 16 + (i & 15)] * pg8::LOG2E;
    __syncthreads();
    const int arow = 4 * ((((a >> 2) & 1) << 1) | (a >> 3)) + (a & 3), xa = swz_x(arow);
    int aoff[4];
#pragma unroll
    for (int s = 0; s < 4; ++s) aoff[s] = 256 * arow + 16 * ((4 * s + q) ^ xa);
    const int trow = 4 * sq + (a >> 2), xt = swz_x(trow);
    int toff[8];
#pragma unroll
    for (int nt = 0; nt < 8; ++nt) toff[nt] = 256 * trow + 16 * ((2 * nt + ((a >> 1) & 1)) ^ xt) + 8 * (a & 1);
    const int drow = lane >> 4;
    for (int i = 0; i * NGW < M; ++i) {
        const int tok = gw + NGW * i; if (tok >= M) break;
        const int b = tok >> 11, t = tok & (T - 1); const int n = (t + 1 < KSEL) ? t + 1 : KSEL, nc = (n + 31) >> 5;
        { const unsigned long long v = *(const unsigned long long*)(IDX + (size_t)tok * KSEL + 4 * lane); *(LAS unsigned long long*)(idl + 4 * lane) = v; }
        f16x8 qf[4];
#pragma unroll
        for (int s = 0; s < 4; ++s) qf[s] = __builtin_bit_cast(f16x8, *(const v4u*)(QL + (size_t)tok * (NH * RL) + a * RL + 32 * s + 8 * q));
        LDS_WAIT(); asm volatile("" ::: "memory");
        const hbits* kvbase = CKVN + (size_t)b * T * RL;
#define P3_DMA(c, buf) do { _Pragma("unroll") for (int g = 0; g < 8; ++g) { const int row = 4 * g + drow; const int key = idl[32 * (c) + row]; \
            __builtin_amdgcn_global_load_lds((const unsigned*)(kvbase + (size_t)key * RL + 8 * ((lane & 15) ^ swz_x(row))), (LAS unsigned*)(kvb + (buf) * 8192 + g * 1024), 16, 0, 0); } } while (0)
        P3_DMA(0, 0);
        float m = -INFINITY, l = 0.f; f32x4 o[8];
#pragma unroll
        for (int nt = 0; nt < 8; ++nt) o[nt] = (f32x4){0.f, 0.f, 0.f, 0.f};
        for (int c = 0; c < nc; ++c) {
            LAS unsigned char* cur = kvb + (c & 1) * 8192;
            if (c + 1 < nc) { LDS_WAIT(); asm volatile("" ::: "memory"); P3_DMA(c + 1, (c + 1) & 1); asm volatile("s_waitcnt vmcnt(8)" ::: "memory"); }
            else { asm volatile("s_waitcnt vmcnt(0)" ::: "memory"); }
            f32x4 s0 = (f32x4){0.f, 0.f, 0.f, 0.f}, s1 = (f32x4){0.f, 0.f, 0.f, 0.f};
#pragma unroll
            for (int s = 0; s < 4; ++s) { const f16x8 k0 = __builtin_bit_cast(f16x8, *(const LAS v4u*)(cur + aoff[s])), k1 = __builtin_bit_cast(f16x8, *(const LAS v4u*)(cur + 4096 + aoff[s]));
                s0 = __builtin_amdgcn_mfma_f32_16x16x32_f16(k0, qf[s], s0, 0, 0, 0); s1 = __builtin_amdgcn_mfma_f32_16x16x32_f16(k1, qf[s], s1, 0, 0, 0); }
            { const unsigned long long i0 = *(const LAS unsigned long long*)(idl + 32 * c + 4 * sq), i1 = *(const LAS unsigned long long*)(idl + 32 * c + 16 + 4 * sq);
#pragma unroll
              for (int r = 0; r < 4; ++r) { const int k0 = (int)((i0 >> (16 * r)) & 0xffffu), k1 = (int)((i1 >> (16 * r)) & 0xffffu);
                  const int r0 = t - k0, r1 = t - k1;
                  s0[r] += bt[(((unsigned)r0 < 128u) ? r0 : 128) * 16 + a]; s1[r] += bt[(((unsigned)r1 < 128u) ? r1 : 128) * 16 + a];
                  if (32 * c + 4 * sq + r >= n) s0[r] = -INFINITY;
                  if (32 * c + 16 + 4 * sq + r >= n) s1[r] = -INFINITY; } }
            float cm = fmaxf(fmaxf(fmaxf(s0[0], s0[1]), fmaxf(s0[2], s0[3])), fmaxf(fmaxf(s1[0], s1[1]), fmaxf(s1[2], s1[3])));
            cm = fmaxf(cm, __shfl_xor(cm, 16)); cm = fmaxf(cm, __shfl_xor(cm, 32));
            const float mn = fmaxf(m, cm), alpha = __builtin_amdgcn_exp2f(m - mn); m = mn;
            float ps = 0.f;
#pragma unroll
            for (int r = 0; r < 4; ++r) { s0[r] = __builtin_amdgcn_exp2f(s0[r] - mn); s1[r] = __builtin_amdgcn_exp2f(s1[r] - mn); ps += s0[r] + s1[r]; }
            l = l * alpha + ps;
#pragma unroll
            for (int nt = 0; nt < 8; ++nt) o[nt] = o[nt] * alpha;
            v4u pw; pw.x = pk2h(s0[0], s0[1]); pw.y = pk2h(s0[2], s0[3]); pw.z = pk2h(s1[0], s1[1]); pw.w = pk2h(s1[2], s1[3]);
            const f16x8 pfr = __builtin_bit_cast(f16x8, pw);
#pragma unroll
            for (int nt = 0; nt < 8; ++nt) {
                const v4i16_t t0 = __builtin_amdgcn_ds_read_tr16_b64_v4i16((LAS v4i16_t*)(cur + toff[nt])), t1 = __builtin_amdgcn_ds_read_tr16_b64_v4i16((LAS v4i16_t*)(cur + 4096 + toff[nt]));
                typedef short v8i16_t __attribute__((ext_vector_type(8)));
                const v8i16_t tv = {t0[0], t0[1], t0[2], t0[3], t1[0], t1[1], t1[2], t1[3]};
                o[nt] = __builtin_amdgcn_mfma_f32_16x16x32_f16(__builtin_bit_cast(f16x8, tv), pfr, o[nt], 0, 0, 0); }
        }
        l += __shfl_xor(l, 16); l += __shfl_xor(l, 32);
        const float inv = 1.0f / l;
        hbits* orow = Oout + (size_t)tok * (NH * RL) + a * RL + 4 * q;
#pragma unroll
        for (int nt = 0; nt < 8; ++nt) { const unsigned long long w = (unsigned long long)pk2h(o[nt][0] * inv, o[nt][1] * inv) | ((unsigned long long)pk2h(o[nt][2] * inv, o[nt][3] * inv) << 32);
            *(unsigned long long*)(orow + 16 * nt) = w; }
        LDS_WAIT(); asm volatile("" ::: "memory");
#undef P3_DMA
    }
}

typedef float f32x16 __attribute__((ext_vector_type(16)));
constexpr float SWA_QSCALE = 0.125f * 1.4426950408889634f;
__device__ __forceinline__ void p8_swa(Frame& F) {
    const int tid = F.tid, lane = F.lane, wave = F.wave, r32 = lane & 31, hh = lane >> 5;
    LAS unsigned char* Ks = F.lds;
    LAS unsigned char* Vs = F.lds + 20480;
    LAS float* btr = (LAS float*)(F.lds + 40960) + wave * 384;
    const float* rel_bias = F.in[1]; const float* sinks = F.in[11];
    const hbits* QKV = (const hbits*)(F.ws + WS_QKV1); hbits* OB = (hbits*)(F.ws + WS_OB);
    for (int i = lane; i < 384; i += 64) { const int rel = 159 - (i % 192), hd = 8 * (i / 192) + wave; btr[i] = (rel >= 0 && rel < 128) ? rel_bias[(int)BUCKET_TAB[rel] * 16 + hd] * pg8::LOG2E : 0.f; }
    const int lrow = tid >> 3, lch = tid & 7;
    const int g = lane >> 4, dh = g & 1, ti = lane & 15, tr_r = ti >> 2, tr_p = ti & 3;
    int kbase[4], vbase[2];
#pragma unroll
    for (int s = 0; s < 4; ++s) kbase[s] = r32 * 128 + 16 * ((2 * s + hh) ^ ((r32 >> 1) & 7));
#pragma unroll
    for (int dt = 0; dt < 2; ++dt) vbase[dt] = (4 * hh + tr_r) * 128 + 16 * ((4 * dt + 2 * dh + (tr_p >> 1)) ^ (((tr_r >> 1) & 1) << 2)) + 8 * (tr_p & 1);
    for (int u = F.bid; u < NB * 2 * (T / 32); u += F.G) {
        const int qt = u & 63, kvh = (u >> 6) & 1, b = u >> 7, t0 = 32 * qt, head = kvh * 8 + wave;
        __syncthreads();
#pragma unroll
        for (int p = 0; p < 3; ++p) { const int row = lrow + 64 * p;
            if (row < 160) { const int key = t0 - 128 + row; v4u kv = (v4u){0u, 0u, 0u, 0u}, vv = (v4u){0u, 0u, 0u, 0u};
                if (key >= 0) { const hbits* base = QKV + ((size_t)b * T + key) * B_IN; kv = *(const v4u*)(base + 1024 + kvh * 64 + 8 * lch); vv = *(const v4u*)(base + 1152 + kvh * 64 + 8 * lch); }
                *(LAS v4u*)(Ks + row * 128 + 16 * (lch ^ ((row >> 1) & 7))) = kv; *(LAS v4u*)(Vs + row * 128 + 16 * (lch ^ (((row >> 1) & 1) << 2))) = vv; } }
        f16x8 qf[4];
#pragma unroll
        for (int s = 0; s < 4; ++s) qf[s] = __builtin_bit_cast(f16x8, *(const v4u*)(QKV + ((size_t)b * T + t0 + r32) * B_IN + head * 64 + 16 * s + 8 * hh));
        __syncthreads();
        f32x16 S[5];
#pragma unroll
        for (int kt = 0; kt < 5; ++kt) {
#pragma unroll
            for (int r = 0; r < 16; ++r) S[kt][r] = 0.f;
#pragma unroll
            for (int s = 0; s < 4; ++s) { const f16x8 kf = __builtin_bit_cast(f16x8, *(const LAS v4u*)(Ks + kbase[s] + kt * 4096));
                S[kt] = __builtin_amdgcn_mfma_f32_32x32x16_f16(kf, qf[s], S[kt], 0, 0, 0); } }
        const float sink2 = sinks[head] * pg8::LOG2E; float m = sink2;
        int base = 128 + r32 - 4 * hh; asm volatile("" : "+v"(base));
        const LAS float* btl = btr + kvh * 192 + (159 - base);
        const int kmin = 128 - t0 - 4 * hh;
#pragma unroll
        for (int kt = 0; kt < 5; ++kt)
#pragma unroll
            for (int r = 0; r < 16; ++r) { const int c = 32 * kt + (r & 3) + 8 * (r >> 2); const int rel = base - c;
                const bool valid = ((unsigned)rel < 128u) && (c >= kmin);
                const float v = valid ? S[kt][r] + btl[c] : -INFINITY; S[kt][r] = v; m = fmaxf(m, v); }
        m = fmaxf(m, __shfl_xor(m, 32));
        float l = 0.f;
#pragma unroll
        for (int kt = 0; kt < 5; ++kt)
#pragma unroll
            for (int r = 0; r < 16; ++r) { const float p = __builtin_amdgcn_exp2f(S[kt][r] - m); S[kt][r] = p; l += p; }
        l += __shfl_xor(l, 32); l += __builtin_amdgcn_exp2f(sink2 - m);
        const float inv = 1.0f / l;
        f32x16 O[2];
#pragma unroll
        for (int dt = 0; dt < 2; ++dt)
#pragma unroll
            for (int r = 0; r < 16; ++r) O[dt][r] = 0.f;
#pragma unroll
        for (int kt = 0; kt < 5; ++kt)
#pragma unroll
            for (int s = 0; s < 2; ++s) { v4u pw; pw.x = pk2h(S[kt][8 * s + 0], S[kt][8 * s + 1]); pw.y = pk2h(S[kt][8 * s + 2], S[kt][8 * s + 3]); pw.z = pk2h(S[kt][8 * s + 4], S[kt][8 * s + 5]); pw.w = pk2h(S[kt][8 * s + 6], S[kt][8 * s + 7]);
                const f16x8 pfr = __builtin_bit_cast(f16x8, pw);
#pragma unroll
                for (int dt = 0; dt < 2; ++dt) {
                    const v4i16_t t1 = __builtin_amdgcn_ds_read_tr16_b64_v4i16((LAS v4i16_t*)(Vs + vbase[dt] + (32 * kt + 16 * s) * 128));
                    const v4i16_t t2 = __builtin_amdgcn_ds_read_tr16_b64_v4i16((LAS v4i16_t*)(Vs + vbase[dt] + (32 * kt + 16 * s + 8) * 128));
                    typedef short v8i16_t __attribute__((ext_vector_type(8)));
                    const v8i16_t tv = {t1[0], t1[1], t1[2], t1[3], t2[0], t2[1], t2[2], t2[3]};
                    O[dt] = __builtin_amdgcn_mfma_f32_32x32x16_f16(__builtin_bit_cast(f16x8, tv), pfr, O[dt], 0, 0, 0); }
                __builtin_amdgcn_sched_barrier(0); }
        hbits* orow = OB + ((size_t)b * T + t0 + r32) * D + head * 64 + 4 * hh;
#pragma unroll
        for (int dt = 0; dt < 2; ++dt)
#pragma unroll
            for (int g4 = 0; g4 < 4; ++g4) { const unsigned long long w = (unsigned long long)pk2h(O[dt][4 * g4] * inv, O[dt][4 * g4 + 1] * inv) | ((unsigned long long)pk2h(O[dt][4 * g4 + 2] * inv, O[dt][4 * g4 + 3] * inv) << 32);
                *(unsigned long long*)(orow + 32 * dt + 8 * g4) = w; }
    }
}

__device__ __forceinline__ void p12_final(Frame& F) {
    const int gw = F.bid * NWAVES + F.wave, NGW = F.G * NWAVES; const float* g = F.in[4];
    for (int m = gw; m < M; m += NGW) {
        GAS f32x4* xr = (GAS f32x4*)(F.out + (size_t)m * D) + F.lane;
        f32x4 v[4]; float s = 0.f;
#pragma unroll
        for (int j = 0; j < 4; ++j) { v[j] = xr[64 * j]; s += (v[j].x * v[j].x + v[j].y * v[j].y) + (v[j].z * v[j].z + v[j].w * v[j].w); }
        const float r = 1.0f / sqrtf(wave_sum(s) * (1.0f / D) + pg8::RMS_EPS);
#pragma unroll
        for (int j = 0; j < 4; ++j) { const f32x4 gv = *((const f32x4*)g + F.lane + 64 * j); xr[64 * j] = v[j] * r * gv; }
    }
}

struct Args { const float* in[16]; float* out; unsigned char* ws; int ph_lo, ph_hi; };
template <bool COOP>
__global__ void __launch_bounds__(NTHREADS, 2) fwd(Args args) {
    extern __shared__ __attribute__((aligned(16))) unsigned char lds[];
    Frame F;
    F.lds = (LAS unsigned char*)lds; F.tid = threadIdx.x; F.lane = F.tid & 63; F.wave = __builtin_amdgcn_readfirstlane(F.tid >> 6);
    F.G = gridDim.x; F.bid = blockIdx.x;
#pragma unroll
    for (int i = 0; i < 16; ++i) F.in[i] = args.in[i];
    F.out = args.out; F.ws = args.ws;
    unsigned char* ws = args.ws;
    const int lo = args.ph_lo, hi = args.ph_hi;
#define IN(k) (lo <= (k) && (k) < hi)
#define REPEAT(k, call) do { if (PROBE_REPEAT == (k)) { __syncthreads(); call; __syncthreads(); } } while (0)
    XcdBarrier bar; bar.bar = (unsigned*)(ws + WS_CTL) + CW_BAR; bar.x = 0; bar.st = nullptr;
    if constexpr (COOP) {
        volatile LAS unsigned* misc = (volatile LAS unsigned*)(F.lds + LDS_MISC);
        if (F.tid < 64) misc[F.tid] = 0u;
        __syncthreads();
        bar = xcd_barrier_post((unsigned*)(ws + WS_CTL) + CW_BAR, misc);
    }
#define SEAM(k) do { if constexpr (COOP) { if (IN(k) && IN((k) + 1)) xcd_barrier(bar); } } while (0)
    typedef pg8::bf16_t hb;
    float* SS1 = (float*)(ws + WS_SS1); float* SS2 = (float*)(ws + WS_SS2); float* SS3 = (float*)(ws + WS_SS3);
    hb* XH = (hb*)(ws + WS_XH);

    if (IN(0)) { p0_prologue(F); REPEAT(0, p0_prologue(F)); } SEAM(0);
    if (IN(1)) {
        pg8::Gemm g{XH, (const hb*)(ws + WS_WA), M, A_PAD, D}; pg8::StaticOrder S; S.init(M, A_PAD, F.G, F.bid);
        pg8::EpiInA E{(const float*)(ws + WS_RS0), (hb*)(ws + WS_QL), (float*)(ws + WS_CKV), (hb*)(ws + WS_QI), (hb*)(ws + WS_KI), (float*)(ws + WS_WI)};
        pg8::gemm_phase<pg8::EpiInA, pg8::StaticOrder, true, true>(F.lds, g, S, E);
    } SEAM(1);
    if (IN(2)) { p2_indexer(F); REPEAT(2, p2_indexer(F)); } SEAM(2);
    if (IN(3)) { REPEAT(3, p3_sparse_attn(F, (hbits*)F.out)); p3_sparse_attn(F, (hbits*)(ws + WS_QL)); } SEAM(3);
    if (IN(4)) {
        pg8::Gemm g{(const hb*)(ws + WS_QL), (const hb*)(ws + WS_WCT), M, D, NH * RL}; pg8::StaticOrder S; S.init(M, D, F.G, F.bid);
        pg8::EpiRes<false> E{XH, SS1, nullptr, nullptr};
        pg8::gemm_phase<pg8::EpiRes<false>, pg8::StaticOrder, true, true>(F.lds, g, S, E);
    } SEAM(4);
    if (IN(5)) {
        pg8::Gemm g{XH, (const hb*)(ws + WS_WGU0), M, 2 * FF, D}; pg8::StaticOrder S; S.init(M, 2 * FF, F.G, F.bid);
        pg8::EpiGU E{SS1, (hb*)(ws + WS_HB)};
        pg8::gemm_phase<pg8::EpiGU, pg8::StaticOrder, true, true>(F.lds, g, S, E);
    } SEAM(5);
    if (IN(6)) {
        pg8::Gemm g{(const hb*)(ws + WS_HB), (const hb*)(ws + WS_WD0), M, D, FF}; pg8::StaticOrder S; S.init(M, D, F.G, F.bid);
        pg8::EpiRes<false> E{XH, SS2, nullptr, nullptr};
        pg8::gemm_phase<pg8::EpiRes<false>, pg8::StaticOrder, true, true>(F.lds, g, S, E);
    } SEAM(6);
    if (IN(7)) {
        pg8::Gemm g{XH, (const hb*)(ws + WS_WB), M, B_IN, D}; pg8::StaticOrder S; S.init(M, B_IN, F.G, F.bid);
        pg8::EpiInB E{SS2, F.in[10], (hb*)(ws + WS_QKV1)};
        pg8::gemm_phase<pg8::EpiInB, pg8::StaticOrder, true, true>(F.lds, g, S, E);
    } SEAM(7);
    if (IN(8)) { p8_swa(F); REPEAT(8, p8_swa(F)); } SEAM(8);
    if (IN(9)) {
        pg8::Gemm g{(const hb*)(ws + WS_OB), (const hb*)(ws + WS_WBO), M, D, D}; pg8::StaticOrder S; S.init(M, D, F.G, F.bid);
        pg8::EpiRes<false> E{XH, SS3, F.in[13], nullptr};
        pg8::gemm_phase<pg8::EpiRes<false>, pg8::StaticOrder, true, true>(F.lds, g, S, E);
    } SEAM(9);
    if (IN(10)) {
        pg8::Gemm g{XH, (const hb*)(ws + WS_WGU1), M, 2 * FF, D}; pg8::StaticOrder S; S.init(M, 2 * FF, F.G, F.bid);
        pg8::EpiGU E{SS3, (hb*)(ws + WS_HB)};
        pg8::gemm_phase<pg8::EpiGU, pg8::StaticOrder, true, true>(F.lds, g, S, E);
    } SEAM(10);
    if (IN(11)) {
        pg8::Gemm g{(const hb*)(ws + WS_HB), (const hb*)(ws + WS_WD1), M, D, FF}; pg8::StaticOrder S; S.init(M, D, F.G, F.bid);
        pg8::EpiRes<true> E{XH, nullptr, nullptr, F.out};
        pg8::gemm_phase<pg8::EpiRes<true>, pg8::StaticOrder, true, true>(F.lds, g, S, E);
    } SEAM(11);
    if (IN(12)) { p12_final(F); }
#undef IN
#undef SEAM
}

extern "C" void kernel_launch(void* const* d_in, const int* in_sizes, int n_in, void* d_out, int out_size, void* d_ws, size_t ws_size, hipStream_t stream) {
    static int grid = 0;
    if (grid == 0) {
        if (n_in != 16 || in_sizes[0] != M * D || out_size != M * D || ws_size < WS_END) { fprintf(stderr, "kernel_launch: unexpected shapes (n_in %d, in0 %d, out %d, ws %zu)\n", n_in, n_in > 0 ? in_sizes[0] : -1, out_size, ws_size); grid = -1; return; }
        int dev = 0, cus = 0, per_cu = 0;
        if (hipGetDevice(&dev) != hipSuccess || hipDeviceGetAttribute(&cus, hipDeviceAttributeMultiprocessorCount, dev) != hipSuccess) { grid = -1; return; }
        const void* fn = MK_ONE_LAUNCH ? (const void*)fwd<true> : (const void*)fwd<false>;
        if (hipFuncSetAttribute(fn, hipFuncAttributeMaxDynamicSharedMemorySize, LDS_BYTES) != hipSuccess) { fprintf(stderr, "kernel_launch: hipFuncSetAttribute failed\n"); grid = -1; return; }
        if (hipOccupancyMaxActiveBlocksPerMultiprocessor(&per_cu, fn, NTHREADS, LDS_BYTES) != hipSuccess || per_cu < 1) { fprintf(stderr, "kernel_launch: occupancy query says %d blocks per CU\n", per_cu); per_cu = 1; }
        (void)hipGetLastError();
        grid = cus;
    }
    if (grid < 0) return;
    (void)hipMemsetAsync((char*)d_ws + WS_CTL, 0, CTL_ZERO_BYTES, stream);
    Args a{};
    for (int i = 0; i < 16; ++i) a.in[i] = (const float*)d_in[i];
    a.out = (float*)d_out; a.ws = (unsigned char*)d_ws;
#if MK_ONE_LAUNCH
    a.ph_lo = 0; a.ph_hi = N_PHASES;
    hipLaunchKernelGGL(fwd<true>, dim3(grid), dim3(NTHREADS), LDS_BYTES, stream, a);
#else
    for (int p = 0; p < N_PHASES; ++p) { a.ph_lo = p; a.ph_hi = p + 1; hipLaunchKernelGGL(fwd<false>, dim3(grid), dim3(NTHREADS), LDS_BYTES, stream, a); }
#endif
}
```

```cpp
#include <hip/hip_runtime.h>
#include <hip/hip_cooperative_groups.h>
#include <cstdio>
#include <cstdint>
namespace cg = cooperative_groups;

typedef _Float16 f16x8 __attribute__((ext_vector_type(8)));
typedef _Float16 f16x2 __attribute__((ext_vector_type(2)));
typedef _Float16 f16;
namespace pg8 {
#define PG8_LAS __attribute__((address_space(3)))
typedef unsigned short bf16_t;
typedef short bf16x8 __attribute__((ext_vector_type(8)));
typedef float f32x4 __attribute__((ext_vector_type(4)));
typedef unsigned u32x4 __attribute__((ext_vector_type(4)));
constexpr int BM = 256, BK = 64, HALF = 128, HTB = HALF * BK * 2  , STAGE_BYTES = 8 * HTB, NXCD = 8, WGM = 8;

__host__ __device__ __forceinline__ int lds_byte(int r, int c) { const int st = (r >> 4) * 2 + (c >> 5), rr = r & 15, cc = c & 31, ob = rr * 64 + cc * 2; return st * 1024 + (ob ^ (((ob >> 9) & 1) << 5)); }
__host__ __device__ __forceinline__ void stage_rc(int b, int& R, int& C) { const int st = b / 1024, sb = b % 1024, swz = sb ^ (((sb >> 9) & 1) << 5); R = (st >> 1) * 16 + swz / 64; C = (st & 1) * 32 + (swz % 64) / 2; }
__host__ __device__ __forceinline__ int perm32(int rho) { const int n = rho >> 4, i = rho & 15; return 8 * (i >> 2) + 4 * n + (i & 3); }

struct Unit { int pm, pn; };
struct Gemm { const bf16_t* A; const bf16_t* Bt; int M, N, K; };

struct StaticOrder {
    int nM, nN, nwg, G, c;
    __host__ __device__ void init(int M, int N, int G_, int c_) { nM = M / BM; nN = N / BM; nwg = nM * nN; G = G_; c = c_; }
    __host__ __device__ bool next(int i, Unit& u) const {
        const long L = (long)i * G + c; if (L >= nwg) return false;
        int wgid = (int)L; { const int q = nwg / NXCD, r = nwg % NXCD, xcd = wgid % NXCD, off = wgid / NXCD; wgid = (xcd < r ? xcd * (q + 1) : r * (q + 1) + (xcd - r) * q) + off; }
        const int nig = WGM * nN, gid = wgid / nig, fm = gid * WGM, gsz = (nM - fm) < WGM ? (nM - fm) : WGM;
        u.pm = fm + ((wgid % nig) % gsz); u.pn = (wgid % nig) / gsz; return true;
    }
    __device__ __forceinline__ void a_ready(const Unit&) const {}
    __device__ __forceinline__ void done(const Unit&) const {}
};

__device__ __forceinline__ unsigned pk2h(float lo, float hi) { f16x2 v = {(_Float16)lo, (_Float16)hi}; return __builtin_bit_cast(unsigned, v); }
__device__ __forceinline__ u32x4 pk8h(f32x4 a, f32x4 b) { u32x4 w; w.x = pk2h(a[0], a[1]); w.y = pk2h(a[2], a[3]); w.z = pk2h(b[0], b[1]); w.w = pk2h(b[2], b[3]); return w; }
constexpr float RMS_EPS = 1e-6f;
constexpr float LOG2E = 1.4426950408889634f, QSCALE = 0.08838834764831845f * 1.4426950408889634f;

struct EpiInA {
    static constexpr bool PERM = true, AFTER_DRAIN = false;
    const float* rs; bf16_t* QL; float* CKV; bf16_t* QI; bf16_t* KI; float* WI;
    __device__ __forceinline__ void operator()(const f32x4 (&acc)[2][2][4][2], const Unit& u, int wr, int wc, int fr, int fq) const {
        const int row0 = u.pm * BM + wr * 64 + fr;
#pragma unroll
        for (int ai = 0; ai < 2; ++ai)
#pragma unroll
            for (int m = 0; m < 4; ++m) { const int row = row0 + ai * HALF + m * 16; const float r = rs[row];
#pragma unroll
                for (int bj = 0; bj < 2; ++bj) { const int col = u.pn * BM + bj * HALF + wc * 32 + 8 * fq;
                    f32x4 v0 = acc[ai][bj][m][0] * r, v1 = acc[ai][bj][m][1] * r;
                    if (col < 2048) { v0 = v0 * QSCALE; v1 = v1 * QSCALE; *(u32x4*)(QL + (size_t)row * 2048 + col) = pk8h(v0, v1); }
                    else if (col < 2176) { float* p = CKV + (size_t)row * 128 + (col - 2048); *(f32x4*)p = v0; *(f32x4*)(p + 4) = v1; }
                    else if (col < 2688) { v0 = v0 * 0.125f; v1 = v1 * 0.125f; *(u32x4*)(QI + (size_t)row * 512 + (col - 2176)) = pk8h(v0, v1); }
                    else if (col < 2752) { *(u32x4*)(KI + (size_t)row * 64 + (col - 2688)) = pk8h(v0, v1); }
                    else if (col < 2760) { const float s = 0.35355339059327373f; float* p = WI + (size_t)row * 8; *(f32x4*)p = v0 * s; *(f32x4*)(p + 4) = v1 * s; }
                } }
    }
};
template <bool FINAL> struct EpiRes {
    static constexpr bool PERM = true, AFTER_DRAIN = false;
    bf16_t* xh; float* ss; const float* bias; float* xf;
    __device__ __forceinline__ void operator()(const f32x4 (&acc)[2][2][4][2], const Unit& u, int wr, int wc, int fr, int fq) const {
        const int row0 = u.pm * BM + wr * 64 + fr;
#pragma unroll
        for (int ai = 0; ai < 2; ++ai)
#pragma unroll
            for (int m = 0; m < 4; ++m) { const int row = row0 + ai * HALF + m * 16; float sq = 0.f;
#pragma unroll
                for (int bj = 0; bj < 2; ++bj) { const int col = u.pn * BM + bj * HALF + wc * 32 + 8 * fq; const size_t off = (size_t)row * 1024 + col;
                    const f16x8 xo = __builtin_bit_cast(f16x8, *(const u32x4*)(xh + off));
                    f32x4 v0 = acc[ai][bj][m][0] + (f32x4){(float)xo[0], (float)xo[1], (float)xo[2], (float)xo[3]}, v1 = acc[ai][bj][m][1] + (f32x4){(float)xo[4], (float)xo[5], (float)xo[6], (float)xo[7]};
                    if (bias) { v0 = v0 + *(const f32x4*)(bias + col); v1 = v1 + *(const f32x4*)(bias + col + 4); }
                    if constexpr (FINAL) { *(f32x4*)(xf + off) = v0; *(f32x4*)(xf + off + 4) = v1; }
                    else { *(u32x4*)(xh + off) = pk8h(v0, v1);
                        sq += (v0[0] * v0[0] + v0[1] * v0[1]) + (v0[2] * v0[2] + v0[3] * v0[3]) + (v1[0] * v1[0] + v1[1] * v1[1]) + (v1[2] * v1[2] + v1[3] * v1[3]); } }
                if constexpr (!FINAL) { sq += __shfl_xor(sq, 16); sq += __shfl_xor(sq, 32);
                    if (fq == 0) atomicAdd(ss + row, sq); } }
    }
};
struct EpiGU {
    static constexpr bool PERM = true, AFTER_DRAIN = false;
    const float* ss; bf16_t* HB;
    __device__ __forceinline__ void operator()(const f32x4 (&acc)[2][2][4][2], const Unit& u, int wr, int wc, int fr, int fq) const {
        const int row0 = u.pm * BM + wr * 64 + fr; const int col = u.pn * HALF + wc * 32 + 8 * fq;
#pragma unroll
        for (int ai = 0; ai < 2; ++ai)
#pragma unroll
            for (int m = 0; m < 4; ++m) { const int row = row0 + ai * HALF + m * 16; const float r = 1.0f / sqrtf(ss[row] * (1.0f / 1024.0f) + RMS_EPS);
                f32x4 hv[2];
#pragma unroll
                for (int n = 0; n < 2; ++n)
#pragma unroll
                    for (int j = 0; j < 4; ++j) { const float g = acc[ai][0][m][n][j] * r, uu = acc[ai][1][m][n][j] * r;
                        hv[n][j] = g * __builtin_amdgcn_rcpf(1.0f + __builtin_amdgcn_exp2f(-1.4426950408889634f * g)) * uu; }
                *(u32x4*)(HB + (size_t)row * 2816 + col) = pk8h(hv[0], hv[1]); }
    }
};
struct EpiInB {
    static constexpr bool PERM = true, AFTER_DRAIN = false;
    const float* ss; const float* bias; bf16_t* QKV;
    __device__ __forceinline__ void operator()(const f32x4 (&acc)[2][2][4][2], const Unit& u, int wr, int wc, int fr, int fq) const {
        const int row0 = u.pm * BM + wr * 64 + fr;
#pragma unroll
        for (int ai = 0; ai < 2; ++ai)
#pragma unroll
            for (int m = 0; m < 4; ++m) { const int row = row0 + ai * HALF + m * 16; const float r = 1.0f / sqrtf(ss[row] * (1.0f / 1024.0f) + RMS_EPS);
#pragma unroll
                for (int bj = 0; bj < 2; ++bj) { const int col = u.pn * BM + bj * HALF + wc * 32 + 8 * fq;
                    f32x4 v0 = acc[ai][bj][m][0] * r + *(const f32x4*)(bias + col), v1 = acc[ai][bj][m][1] * r + *(const f32x4*)(bias + col + 4);
                    if (col < 1024) { v0 = v0 * (0.125f * LOG2E); v1 = v1 * (0.125f * LOG2E); }
                    *(u32x4*)(QKV + (size_t)row * 1280 + col) = pk8h(v0, v1); } }
    }
};

template <class Epi, class Sched, bool ALIGN_EPI = false, bool SP2 = false>
__device__ __forceinline__ void gemm_phase(PG8_LAS unsigned char* lds, const Gemm g, const Sched& S, const Epi& E) {
    const int tid = threadIdx.x, wid = __builtin_amdgcn_readfirstlane(tid >> 6), lane = tid & 63, wr = wid >> 2, wc = wid & 3, fr = lane & 15, fq = lane >> 4;
    const int K = g.K, nt = K / BK;
    unsigned voffA[2], voffB[2];
#pragma unroll
    for (int i = 0; i < 2; ++i) { int R, C; stage_rc(tid * 16 + i * 8192, R, C); const int Rb = Epi::PERM ? ((R & ~31) + perm32(R & 31)) : R;
        voffA[i] = (unsigned)(R * K + C) * 2u; voffB[i] = (unsigned)(Rb * K + C) * 2u; }
    const size_t kstep = (size_t)(BK * 2);
    const size_t hstep = (size_t)HALF * K * 2;
    const size_t tstep = 2 * hstep;
    const unsigned ldsw = (unsigned)wid * 1024u;
    const int aoff = lds_byte(wr * 64 + fr, fq * 8), boff = lds_byte(wc * 32 + fr, fq * 8);
#define PG8_SA(b, h) (((b) * 2 + (h)) * HTB)
#define PG8_SB(b, h) ((4 + (b) * 2 + (h)) * HTB)
#define PG8_STAGE(bufoff, gbase, voff) do { _Pragma("unroll") for (int _i = 0; _i < 2; ++_i) \
        __builtin_amdgcn_global_load_lds((const unsigned*)((const char*)(gbase) + (voff)[_i]), (PG8_LAS unsigned*)(lds + (bufoff) + ldsw + _i * 8192), 16, 0, 0); } while (0)
#define PG8_LDA(dst, b, h) do { _Pragma("unroll") for (int m = 0; m < 4; ++m) _Pragma("unroll") for (int k = 0; k < 2; ++k) dst[m][k] = *(const PG8_LAS bf16x8*)(lds + PG8_SA(b, h) + aoff + m * 2048 + k * 1024); } while (0)
#define PG8_LDB(dst, b, h) do { _Pragma("unroll") for (int n = 0; n < 2; ++n) _Pragma("unroll") for (int k = 0; k < 2; ++k) dst[n][k] = *(const PG8_LAS bf16x8*)(lds + PG8_SB(b, h) + boff + n * 2048 + k * 1024); } while (0)
#define PG8_MMA(ai, bj, At, Bt) do { __builtin_amdgcn_s_setprio(1); _Pragma("unroll") for (int m = 0; m < 4; ++m) _Pragma("unroll") for (int n = 0; n < 2; ++n) _Pragma("unroll") for (int k = 0; k < 2; ++k) \
        acc[ai][bj][m][n] = __builtin_amdgcn_mfma_f32_16x16x32_f16(__builtin_bit_cast(f16x8, Bt[n][k]), __builtin_bit_cast(f16x8, At[m][k]), acc[ai][bj][m][n], 0, 0, 0); __builtin_amdgcn_s_setprio(0); } while (0)
#define PG8_WAIT_V(n) asm volatile("s_waitcnt vmcnt(" #n ")" ::: "memory")
#define PG8_WAIT_L(n) asm volatile("s_waitcnt lgkmcnt(" #n ")" ::: "memory")
#define PG8_BAR __builtin_amdgcn_s_barrier()
#define PG8_SCHED __builtin_amdgcn_sched_barrier(0)
    Unit cur, nxt; int ui = 0;
    if (!S.next(0, cur)) return;
    f32x4 acc[2][2][4][2];
#pragma unroll
    for (int a = 0; a < 2; ++a)
#pragma unroll
        for (int b = 0; b < 2; ++b)
#pragma unroll
            for (int m = 0; m < 4; ++m)
#pragma unroll
                for (int n = 0; n < 2; ++n) acc[a][b][m][n] = (f32x4){0.f, 0.f, 0.f, 0.f};
    bf16x8 At[4][2], B0[2][2], B1[2][2];
    const char* cA = (const char*)g.A + (size_t)cur.pm * tstep; const char* cB = (const char*)g.Bt + (size_t)cur.pn * tstep;
    S.a_ready(cur);
    if constexpr (SP2) {
        PG8_STAGE(PG8_SB(0, 0), cB, voffB); PG8_STAGE(PG8_SB(0, 1), cB + hstep, voffB); PG8_STAGE(PG8_SA(0, 0), cA, voffA); PG8_STAGE(PG8_SA(0, 1), cA + hstep, voffA);
        if (wr == 1) PG8_BAR;
        PG8_WAIT_V(2); PG8_BAR;
        PG8_STAGE(PG8_SB(1, 0), cB + kstep, voffB); PG8_STAGE(PG8_SA(1, 0), cA + kstep, voffA); PG8_STAGE(PG8_SB(1, 1), cB + hstep + kstep, voffB);
        PG8_WAIT_V(6); PG8_BAR;
    } else {
        PG8_STAGE(PG8_SB(0, 0), cB, voffB); PG8_STAGE(PG8_SA(0, 0), cA, voffA); PG8_STAGE(PG8_SB(0, 1), cB + hstep, voffB); PG8_STAGE(PG8_SA(0, 1), cA + hstep, voffA);
        if (wr == 1) PG8_BAR;
        PG8_WAIT_V(4); PG8_BAR;
        PG8_STAGE(PG8_SB(1, 0), cB + kstep, voffB); PG8_STAGE(PG8_SA(1, 0), cA + kstep, voffA); PG8_STAGE(PG8_SB(1, 1), cB + hstep + kstep, voffB);
        PG8_WAIT_V(6); PG8_BAR;
    }
    for (;;) {
        const bool has_next = S.next(ui + 1, nxt);
        const char* nA = has_next ? (const char*)g.A + (size_t)nxt.pm * tstep : cA; const char* nB = has_next ? (const char*)g.Bt + (size_t)nxt.pn * tstep : cB;
        for (int t = 0; t < nt; t += 2) {
            const bool last = (t == nt - 2);
            const char* a1 = cA + (size_t)(t + 1) * kstep;
            const char* a2 = last ? nA : cA + (size_t)(t + 2) * kstep; const char* b2 = last ? nB : cB + (size_t)(t + 2) * kstep;
            const char* a3 = a2 + kstep; const char* b3 = b2 + kstep;
            if (last && has_next) S.a_ready(nxt);
            if constexpr (SP2) {
            PG8_LDB(B0, 0, 0); PG8_LDB(B1, 0, 1); PG8_SCHED; PG8_LDA(At, 0, 0); PG8_STAGE(PG8_SA(1, 1), a1 + hstep, voffA);
            PG8_WAIT_V(8); PG8_WAIT_L(0); PG8_BAR; PG8_MMA(0, 0, At, B0); PG8_MMA(0, 1, At, B1); PG8_BAR; PG8_SCHED;
            PG8_LDA(At, 0, 1); PG8_STAGE(PG8_SB(0, 0), b2, voffB); PG8_STAGE(PG8_SB(0, 1), b2 + hstep, voffB); PG8_STAGE(PG8_SA(0, 0), a2, voffA);
            PG8_WAIT_V(8); PG8_WAIT_L(0); PG8_BAR; PG8_MMA(1, 0, At, B0); PG8_MMA(1, 1, At, B1); PG8_BAR; PG8_SCHED;
            PG8_LDB(B0, 1, 0); PG8_LDB(B1, 1, 1); PG8_SCHED; PG8_LDA(At, 1, 0); PG8_STAGE(PG8_SA(0, 1), a2 + hstep, voffA);
            PG8_WAIT_V(8); PG8_WAIT_L(0); PG8_BAR; PG8_MMA(0, 0, At, B0); PG8_MMA(0, 1, At, B1); PG8_BAR; PG8_SCHED;
            PG8_LDA(At, 1, 1); PG8_STAGE(PG8_SB(1, 0), b3, voffB); PG8_STAGE(PG8_SB(1, 1), b3 + hstep, voffB); PG8_STAGE(PG8_SA(1, 0), a3, voffA);
            PG8_WAIT_V(8); PG8_WAIT_L(0); PG8_BAR; PG8_MMA(1, 0, At, B0); PG8_MMA(1, 1, At, B1); PG8_BAR; PG8_SCHED;
            } else {
            PG8_LDB(B0, 0, 0); PG8_SCHED; PG8_LDA(At, 0, 0); PG8_STAGE(PG8_SA(1, 1), a1 + hstep, voffA);
            PG8_WAIT_L(8); PG8_BAR; PG8_WAIT_L(0); PG8_MMA(0, 0, At, B0); PG8_BAR; PG8_SCHED;
            PG8_LDB(B1, 0, 1); PG8_STAGE(PG8_SB(0, 0), b2, voffB);
            PG8_BAR; PG8_WAIT_L(0); PG8_MMA(0, 1, At, B1); PG8_BAR;
            PG8_LDA(At, 0, 1); PG8_STAGE(PG8_SA(0, 0), a2, voffA);
            PG8_BAR; PG8_WAIT_L(0); PG8_MMA(1, 0, At, B0); PG8_BAR; PG8_SCHED;
            PG8_STAGE(PG8_SB(0, 1), b2 + hstep, voffB);
            PG8_WAIT_V(6); PG8_BAR; PG8_MMA(1, 1, At, B1); PG8_BAR;
            PG8_LDB(B0, 1, 0); PG8_SCHED; PG8_LDA(At, 1, 0); PG8_STAGE(PG8_SA(0, 1), a2 + hstep, voffA);
            PG8_WAIT_L(8); PG8_BAR; PG8_WAIT_L(0); PG8_MMA(0, 0, At, B0); PG8_BAR; PG8_SCHED;
            PG8_LDB(B1, 1, 1); PG8_STAGE(PG8_SB(1, 0), b3, voffB);
            PG8_BAR; PG8_WAIT_L(0); PG8_MMA(0, 1, At, B1); PG8_BAR;
            PG8_LDA(At, 1, 1); PG8_STAGE(PG8_SA(1, 0), a3, voffA);
            PG8_BAR; PG8_WAIT_L(0); PG8_MMA(1, 0, At, B0); PG8_BAR; PG8_SCHED;
            PG8_STAGE(PG8_SB(1, 1), b3 + hstep, voffB);
            PG8_WAIT_V(6); PG8_BAR; PG8_MMA(1, 1, At, B1); PG8_BAR;
            }
        }
        if constexpr (ALIGN_EPI) { if (wr == 0) PG8_BAR; }
        if constexpr (!Epi::AFTER_DRAIN) { E(acc, cur, wr, wc, fr, fq); S.done(cur); }
        if (!has_next) break;
#pragma unroll
        for (int a = 0; a < 2; ++a)
#pragma unroll
            for (int b = 0; b < 2; ++b)
#pragma unroll
                for (int m = 0; m < 4; ++m)
#pragma unroll
                    for (int n = 0; n < 2; ++n) acc[a][b][m][n] = (f32x4){0.f, 0.f, 0.f, 0.f};
        cur = nxt; cA = nA; cB = nB; ++ui;
        if constexpr (ALIGN_EPI) { if (wr == 1) PG8_BAR; }
    }
    PG8_WAIT_V(0);
    if constexpr (!ALIGN_EPI) { if (wr == 0) PG8_BAR; }
    PG8_BAR;
    if constexpr (Epi::AFTER_DRAIN) { E.fused(acc, cur, wr, wc, fr, fq, lds, wid, lane); S.done(cur); }
#undef PG8_SA
#undef PG8_SB
#undef PG8_STAGE
#undef PG8_LDA
#undef PG8_LDB
#undef PG8_MMA
#undef PG8_WAIT_V
#undef PG8_WAIT_L
#undef PG8_BAR
#undef PG8_SCHED
}
}

constexpr int NB = 8, T = 2048, D = 1024, M = NB * T, NH = 16, RL = 128, VH = 64, HI = 8, DI = 64, KSEL = 256;
constexpr int A_IN = 2760, A_PAD = 2816, B_IN = 1280, FF = 2816, WIN = 128;
constexpr int NWAVES = 8, NTHREADS = NWAVES * 64;
constexpr int N_PHASES = 13;
#ifndef PROBE_REPEAT
#define PROBE_REPEAT (-1)
#endif
#ifndef MK_ONE_LAUNCH
#define MK_ONE_LAUNCH 1
#endif
constexpr size_t MiB = 1u << 20;
constexpr size_t WS_CTL = 0, CTL_ZERO_BYTES = 1 * MiB;
constexpr size_t WS_SS1 = 256 * 1024, WS_SS2 = 320 * 1024, WS_SS3 = 384 * 1024;
constexpr int CW_BAR = 4096;
constexpr size_t WS_RS0 = 1 * MiB;
constexpr size_t WS_WA = 2 * MiB, WS_WUV = WS_WA + (size_t)A_PAD * D * 2, WS_WAO = 8 * MiB, WS_WGU0 = 10 * MiB, WS_WGU1 = 21 * MiB, WS_WD0 = 32 * MiB,
                 WS_WD1 = WS_WD0 + (size_t)D * FF * 2, WS_WB = 43 * MiB, WS_WBO = 46 * MiB;
constexpr size_t WS_XH = 50 * MiB;
constexpr size_t WS_QL = 82 * MiB, WS_CKV = 146 * MiB, WS_CKVN = 154 * MiB, WS_QI = 158 * MiB, WS_KI = 174 * MiB, WS_WI = 176 * MiB, WS_IDX = 178 * MiB, WS_OV = 186 * MiB;
constexpr size_t WS_HB = 82 * MiB, WS_QKV1 = 170 * MiB, WS_OB = 210 * MiB, WS_WCT = 242 * MiB, WS_END = 246 * MiB;
static_assert(WS_WUV + 16 * 64 * 128 * 2 <= WS_WAO && WS_WD1 + (size_t)D * FF * 2 <= WS_WB && WS_WB + (size_t)B_IN * D * 2 <= WS_WBO && WS_WBO + 2 * MiB <= WS_XH, "weights map");
static_assert(WS_HB + (size_t)M * FF * 2 <= WS_QKV1 && WS_QKV1 + (size_t)M * B_IN * 2 <= WS_OB && WS_OB + (size_t)M * D * 2 <= WS_WCT, "activation map");
constexpr int LDS_MISC = 147456, LDS_BYTES = 147456 + 256;

#define GAS __attribute__((address_space(1)))
#define LAS __attribute__((address_space(3)))
typedef unsigned v4u __attribute__((ext_vector_type(4)));
typedef float f32x4 __attribute__((ext_vector_type(4)));
typedef unsigned short hbits;
using pg8::pk2h;

__device__ const unsigned char BUCKET_TAB[129] = {0,1,2,3,4,5,6,7,8,9,10,11,12,13,14,15,16,16,16,17,17,18,18,18,19,19,19,20,20,20,20,21,21,21,21,22,22,22,22,22,23,23,23,23,23,23,24,24,24,24,24,24,25,25,25,25,25,25,25,26,26,26,26,26,26,26,26,27,27,27,27,27,27,27,27,27,27,28,28,28,28,28,28,28,28,28,28,29,29,29,29,29,29,29,29,29,29,29,29,30,30,30,30,30,30,30,30,30,30,30,30,30,30,31,31,31,31,31,31,31,31,31,31,31,31,31,31,31,31};

__device__ __forceinline__ float wave_sum(float v) {
#pragma unroll
    for (int o = 1; o < 64; o <<= 1) v += __shfl_xor(v, o);
    return v;
}
__device__ __forceinline__ float wave_max(float v) {
#pragma unroll
    for (int o = 1; o < 64; o <<= 1) v = fmaxf(v, __shfl_xor(v, o));
    return v;
}
#define LDS_WAIT() asm volatile("s_waitcnt lgkmcnt(0)" ::: "memory")

#define XB_TMO      128
#define XB_XCNT(j)  (256  + 64 * (j))
#define XB_XSUB(j)  (1280 + 64 * (j))
#define XB_XGEN(j)  (2304 + 64 * (j))
#define XB_TOP      3328
#define XB_TOPGEN   3392
#define XCD_BAR_WORDS 3456
#define XB_SPIN_CAP (1u << 18)

__device__ __forceinline__ unsigned xb_ld(unsigned* p)              { return __hip_atomic_load(p, __ATOMIC_RELAXED, __HIP_MEMORY_SCOPE_AGENT); }
__device__ __forceinline__ unsigned xb_add(unsigned* p, unsigned v) { return __hip_atomic_fetch_add(p, v, __ATOMIC_RELAXED, __HIP_MEMORY_SCOPE_AGENT); }
__device__ __forceinline__ unsigned xb_xcc_id() { return (unsigned)__builtin_amdgcn_s_getreg((3 << 11) | 20) & 0xFu; }
#define XB_SPIN(cond, bar) do { unsigned _sp = 0; while (cond) { __builtin_amdgcn_s_sleep(1); \
    if ((++_sp & 255u) == 0u) { if (xb_ld(&(bar)[XB_TMO])) break; if (_sp > XB_SPIN_CAP) { atomicAdd(&(bar)[XB_TMO], 1u); break; } } } } while (0)

struct XcdBarrier {
    unsigned* bar; unsigned x;
    volatile LAS unsigned* st;
};

__device__ __forceinline__ XcdBarrier xcd_barrier_post(unsigned* bar, volatile LAS unsigned* st) {
    XcdBarrier b; b.bar = bar; b.x = xb_xcc_id(); b.st = st;
    if (threadIdx.x == 0) (void)xb_add(&bar[XB_XCNT(b.x)], 1u);
    return b;
}
__device__ __forceinline__ void xcd_barrier_complete(unsigned* bar, unsigned x, unsigned& nloc, unsigned& nx) {
    const unsigned G = gridDim.x * gridDim.y * gridDim.z;
    unsigned sum, cnt, mine, sp = 0u;
    for (;;) {
        sum = 0u; cnt = 0u; mine = 0u;
#pragma unroll
        for (unsigned j = 0; j < 16; ++j) { const unsigned c = xb_ld(&bar[XB_XCNT(j)]); sum += c; cnt += (c > 0u) ? 1u : 0u; mine = (j == x) ? c : mine; }
        if (sum == G) break;
        __builtin_amdgcn_s_sleep(1);
        if ((++sp & 255u) == 0u) { if (xb_ld(&bar[XB_TMO])) break; if (sp > XB_SPIN_CAP) { atomicAdd(&bar[XB_TMO], 1u); break; } }
    }
    nloc = mine > 0u ? mine : 1u; nx = cnt > 0u ? cnt : 1u;
}

__device__ __forceinline__ void xcd_barrier(const XcdBarrier& b) {
    asm volatile("s_waitcnt vmcnt(0)" ::: "memory");
    __syncthreads();
    if (threadIdx.x == 0) {
        unsigned* bar = b.bar;
        __builtin_amdgcn_s_waitcnt(0);
        unsigned nloc = b.st[0], nx = b.st[1];
        if (nloc == 0u) { xcd_barrier_complete(bar, b.x, nloc, nx); b.st[0] = nloc; b.st[1] = nx; }
        const unsigned old = xb_add(&bar[XB_XSUB(b.x)], 1u);
        const unsigned gen = old / nloc;
        if (old + 1u == (gen + 1u) * nloc) {
            __builtin_amdgcn_fence(__ATOMIC_RELEASE, "agent");
            asm volatile("s_waitcnt vmcnt(0)" ::: "memory");
            const unsigned og = xb_add(&bar[XB_TOP], 1u);
            const unsigned tg = og / nx;
            if (og + 1u == (tg + 1u) * nx) xb_add(&bar[XB_TOPGEN], 1u);
            else XB_SPIN(xb_ld(&bar[XB_TOPGEN]) == tg, bar);
            __builtin_amdgcn_fence(__ATOMIC_ACQUIRE, "agent");
            xb_add(&bar[XB_XGEN(b.x)], 1u);
            asm volatile("s_waitcnt vmcnt(0)" ::: "memory");
        } else {
            XB_SPIN(xb_ld(&bar[XB_XGEN(b.x)]) == gen, bar);
            __builtin_amdgcn_fence(__ATOMIC_ACQUIRE, "agent");
            asm volatile("s_waitcnt vmcnt(0)" ::: "memory");
        }
    }
    __syncthreads();
}

struct Frame {
    LAS unsigned char* lds;
    int tid, lane, wave, G, bid;
    const float* in[16]; float* out; unsigned char* ws;
};

__device__ __forceinline__ void tr_item(const float* W, int ldw, int nvalid, const float* gain, hbits* WT, int K, int k0, int n0s, int n0d, LAS float* scr, int lane) {
    const int kq = lane >> 3, nq = lane & 7, n = n0s + 4 * nq;
    f32x4 v[8];
#pragma unroll
    for (int i = 0; i < 8; ++i) v[i] = (n < nvalid) ? *(const f32x4*)(W + (size_t)(k0 + kq + 8 * i) * ldw + n) : (f32x4){0.f, 0.f, 0.f, 0.f};
#pragma unroll
    for (int i = 0; i < 8; ++i) { const int kk = kq + 8 * i; const float g = gain ? gain[k0 + kk] : 1.0f; LAS float* d = scr + kk * 33 + 4 * nq;
        d[0] = v[i][0] * g; d[1] = v[i][1] * g; d[2] = v[i][2] * g; d[3] = v[i][3] * g; }
    LDS_WAIT(); asm volatile("" ::: "memory");
    const int c = lane & 7;
#pragma unroll
    for (int j = 0; j < 4; ++j) { const int nn = (lane >> 3) + 8 * j; const LAS float* s = scr + (8 * c) * 33 + nn;
        v4u o; o.x = pk2h(s[0 * 33], s[1 * 33]); o.y = pk2h(s[2 * 33], s[3 * 33]); o.z = pk2h(s[4 * 33], s[5 * 33]); o.w = pk2h(s[6 * 33], s[7 * 33]);
        *(GAS v4u*)(WT + (size_t)(n0d + nn) * K + k0 + 8 * c) = o; }
    LDS_WAIT(); asm volatile("" ::: "memory");
}
template <int SET> __device__ __forceinline__ void conv_jobs(Frame& F, int rank, int nranks) {
    LAS float* scr = (LAS float*)(F.lds + F.wave * 16384);
    const int gw = rank * NWAVES + F.wave, NGW = nranks * NWAVES;
    constexpr int I_WA = 16 * (A_PAD / 32), I_SQ = 16 * 32, I_GU = 16 * (2 * FF / 32), I_D = (FF / 64) * 32, I_WB = 16 * (B_IN / 32), I_CT = 1024;
    constexpr int NITEMS = (SET == 0) ? I_WA + I_GU : (SET == 1) ? I_D + I_CT : (SET == 2) ? I_WB + I_SQ + I_GU : I_D;
    for (int it = gw; it < NITEMS; it += NGW) {
        int r = it;
        if constexpr (SET == 0) { if (r < I_WA) { const int nnb = A_PAD / 32, kb = r / nnb, nb = r % nnb; tr_item(F.in[5], A_IN, A_IN, F.in[2], (hbits*)(F.ws + WS_WA), D, 64 * kb, 32 * nb, 32 * nb, scr, F.lane); continue; } r -= I_WA; }
        if constexpr (SET == 2) {
            if (r < I_WB) { const int nnb = B_IN / 32, kb = r / nnb, nb = r % nnb; tr_item(F.in[9], B_IN, B_IN, F.in[2] + D, (hbits*)(F.ws + WS_WB), D, 64 * kb, 32 * nb, 32 * nb, scr, F.lane); continue; } r -= I_WB;
            if (r < I_SQ) { const int kb = r / 32, nb = r % 32; tr_item(F.in[12], D, D, nullptr, (hbits*)(F.ws + WS_WBO), D, 64 * kb, 32 * nb, 32 * nb, scr, F.lane); continue; } r -= I_SQ; }
        if constexpr (SET == 0 || SET == 2) { constexpr int l = (SET == 2) ? 1 : 0; const int nnb = 2 * FF / 32, kb = r / nnb, nb = r % nnb; const int c = 32 * nb;
            const int nd = (c < FF) ? ((c / 128) * 256 + (c % 128)) : (((c - FF) / 128) * 256 + 128 + ((c - FF) % 128));
            tr_item(F.in[14] + (size_t)l * D * 2 * FF, 2 * FF, 2 * FF, F.in[3] + l * D, (hbits*)(F.ws + (l ? WS_WGU1 : WS_WGU0)), D, 64 * kb, c, nd, scr, F.lane); continue; }
        if constexpr (SET == 1 || SET == 3) { constexpr int l = (SET == 3) ? 1 : 0;
            if (r < I_D) { const int kb = r / 32, nb = r % 32; tr_item(F.in[15] + (size_t)l * FF * D, D, D, nullptr, (hbits*)(F.ws + (l ? WS_WD1 : WS_WD0)), FF, 64 * kb, 32 * nb, 32 * nb, scr, F.lane); continue; } r -= I_D; }
        if constexpr (SET == 1) {
            const float* w_uv = F.in[7]; const float* w_out = F.in[8]; hbits* WCT = (hbits*)(F.ws + WS_WCT);
            const int h = r >> 6, dblk = (r >> 2) & 15, rblk = r & 3, d = dblk * 64 + F.lane;
            float wo[64];
#pragma unroll
            for (int v = 0; v < 64; ++v) wo[v] = w_out[(size_t)(h * 64 + v) * D + d];
            for (int r8 = 0; r8 < 4; ++r8) { float acc[8];
#pragma unroll
                for (int rr = 0; rr < 8; ++rr) { const float* u = w_uv + (size_t)(h * RL + rblk * 32 + r8 * 8 + rr) * VH; float sacc = 0.f;
#pragma unroll
                    for (int v = 0; v < 64; ++v) sacc = fmaf(u[v], wo[v], sacc);
                    acc[rr] = sacc; }
                v4u o; o.x = pk2h(acc[0], acc[1]); o.y = pk2h(acc[2], acc[3]); o.z = pk2h(acc[4], acc[5]); o.w = pk2h(acc[6], acc[7]);
                *(GAS v4u*)(WCT + (size_t)d * (NH * RL) + h * RL + rblk * 32 + r8 * 8) = o; } }
    }
}
template <int SET> __device__ __forceinline__ void gemm_tail_filler(Frame& F, int units) {
    const int rounds = (units + F.G - 1) / F.G, busy = units - (rounds - 1) * F.G;
    if (busy >= F.G) { conv_jobs<SET>(F, F.bid, F.G); return; }
    if (F.bid >= busy) conv_jobs<SET>(F, F.bid - busy, F.G - busy);
}
__device__ __forceinline__ void p0_prologue(Frame& F) {
    const int gw = F.bid * NWAVES + F.wave, NGW = F.G * NWAVES;
    conv_jobs<0>(F, F.bid, F.G);
    const float* x = F.in[0]; hbits* XH = (hbits*)(F.ws + WS_XH); float* RS0 = (float*)(F.ws + WS_RS0);
    for (int m = gw; m < M; m += NGW) {
        const GAS f32x4* xr = (const GAS f32x4*)(x + (size_t)m * D) + F.lane;
        f32x4 v[4]; float s = 0.f;
#pragma unroll
        for (int j = 0; j < 4; ++j) { v[j] = xr[64 * j]; s += (v[j].x * v[j].x + v[j].y * v[j].y) + (v[j].z * v[j].z + v[j].w * v[j].w); }
        s = wave_sum(s);
        if (F.lane == 0) RS0[m] = 1.0f / sqrtf(s * (1.0f / D) + pg8::RMS_EPS);
        GAS unsigned long long* o8 = (GAS unsigned long long*)(XH + (size_t)m * D) + F.lane;
#pragma unroll
        for (int j = 0; j < 4; ++j) o8[64 * j] = (unsigned long long)pk2h(v[j].x, v[j].y) | ((unsigned long long)pk2h(v[j].z, v[j].w) << 32);
    }
}

__device__ __forceinline__ unsigned okey(float f) { const unsigned u = __builtin_bit_cast(unsigned, f); return (u & 0x80000000u) ? ~u : (u | 0x80000000u); }
__device__ __forceinline__ int wave_sum_i(int v) {
    v += __builtin_amdgcn_update_dpp(0, v, 0x128, 0xf, 0xf, false);
    v += __builtin_amdgcn_update_dpp(0, v, 0x124, 0xf, 0xf, false);
    v += __builtin_amdgcn_update_dpp(0, v, 0x122, 0xf, 0xf, false);
    v += __builtin_amdgcn_update_dpp(0, v, 0x121, 0xf, 0xf, false);
    return (__builtin_amdgcn_readlane(v, 0) + __builtin_amdgcn_readlane(v, 16)) + (__builtin_amdgcn_readlane(v, 32) + __builtin_amdgcn_readlane(v, 48));
}
__device__ __forceinline__ int lanes_below(unsigned long long m) { return (int)__builtin_amdgcn_mbcnt_hi((unsigned)(m >> 32), __builtin_amdgcn_mbcnt_lo((unsigned)m, 0u)); }
__device__ __forceinline__ void select_topk(const LAS float* sc, int t, unsigned short* idxrow, int lane) {
    unsigned x[32];
#pragma unroll
    for (int q = 0; q < 32; ++q) { const int s = lane + 64 * q; x[q] = (s <= t) ? okey(sc[s]) : 0u; }
#pragma unroll
    for (int jj = 0; jj < 5; ++jj) { const int j = 16 >> jj; const unsigned m = (jj == 0) ? 0x0000FFFFu : (jj == 1) ? 0x00FF00FFu : (jj == 2) ? 0x0F0F0F0Fu : (jj == 3) ? 0x33333333u : 0x55555555u;
#pragma unroll
        for (int k = 0; k < 32; ++k) if ((k & j) == 0) { const unsigned tt = (x[k] ^ (x[k + j] >> j)) & m; x[k] ^= tt; x[k + j] ^= (tt << j); } }
    unsigned alive = 0xFFFFFFFFu, sel = 0u; int need = KSEL;
#pragma unroll
    for (int i = 0; i < 32; ++i) { const unsigned ones = alive & x[i]; const int c = wave_sum_i(__builtin_popcount(ones));
        if (c >= need) alive = ones; else { need -= c; sel |= ones; alive &= ~x[i]; } }
    const int tot = wave_sum_i(__builtin_popcount(alive));
    if (tot == need) sel |= alive;
    else { const unsigned long long lt_mask = (1ull << lane) - 1ull;
        for (int p = 31; p >= 0 && need > 0; --p) { const bool bit = (alive >> p) & 1u; const unsigned long long mb = __ballot(bit); const int c = __builtin_popcountll(mb);
            if (c <= need) { if (bit) sel |= 1u << p; need -= c; } else { if (bit && __builtin_popcountll(mb & lt_mask) < need) sel |= 1u << p; need = 0; } } }
    const int cl = __builtin_popcount(sel); int pos = 0;
#pragma unroll
    for (int bb = 0; bb < 6; ++bb) pos += lanes_below(__ballot((cl >> bb) & 1)) << bb;
    unsigned m = sel;
    while (m) { const int p = __builtin_ctz(m); m &= m - 1u; idxrow[pos++] = (unsigned short)(lane + 64 * (31 - p)); }
}
__device__ __forceinline__ void p2_indexer(Frame& F) {
    const int gw = F.bid * NWAVES + F.wave, NGW = F.G * NWAVES, lane = F.lane, tid = F.tid, wave = F.wave;
    { const float* CKV = (const float*)(F.ws + WS_CKV); hbits* CKVN = (hbits*)(F.ws + WS_CKVN); const float* lg = F.in[6];
      for (int m = gw; m < M; m += NGW) { const float a = CKV[(size_t)m * RL + 2 * lane], b = CKV[(size_t)m * RL + 2 * lane + 1];
          const float s = wave_sum(a * a + b * b); const float r = 1.0f / sqrtf(s * (1.0f / RL) + pg8::RMS_EPS);
          *(unsigned*)(CKVN + (size_t)m * RL + 2 * lane) = pk2h(a * r * lg[2 * lane], b * r * lg[2 * lane + 1]); } }
    LAS float* scb = (LAS float*)F.lds;
    LAS unsigned char* kst = F.lds + 131072;
    const hbits* QI = (const hbits*)(F.ws + WS_QI); const hbits* KI = (const hbits*)(F.ws + WS_KI); const float* WI = (const float*)(F.ws + WS_WI);
    unsigned short* IDX = (unsigned short*)(F.ws + WS_IDX);
    const int a = lane & 15, q = lane >> 4, lrow = tid >> 3, lch = tid & 7, tg = wave & 3, kh = wave >> 2;
    int boff[2];
#pragma unroll
    for (int s = 0; s < 2; ++s) boff[s] = a * 128 + 16 * ((4 * s + q) ^ ((a >> 1) & 7)) + 4096 * kh;
    const int wst = lrow * 128 + 16 * (lch ^ ((lrow >> 1) & 7));
    for (int pu = 0; pu < 2 * ((NB * 64 - F.bid + F.G - 1) / F.G); ++pu) {
        const int p = F.bid + F.G * (pu >> 1), b = p >> 6, j = (pu & 1) ? 127 - (p & 63) : (p & 63), t0 = 16 * j; const size_t tokbase = (size_t)b * T + t0;
        if (t0 < KSEL) {
#pragma unroll
            for (int tt = 0; tt < 2; ++tt) { const int t = t0 + 2 * wave + tt;
#pragma unroll
                for (int jj = 0; jj < 4; ++jj) { const int k = 4 * lane + jj; IDX[(tokbase + 2 * wave + tt) * KSEL + k] = (unsigned short)((k < t) ? k : t); } }
            continue; }
        const int ns = (t0 + 16 + 63) >> 6;
        f16x8 af[2][2];
#pragma unroll
        for (int tl = 0; tl < 2; ++tl)
#pragma unroll
            for (int s = 0; s < 2; ++s) af[tl][s] = __builtin_bit_cast(f16x8, *(const v4u*)(QI + (tokbase + 4 * tg + (a >> 2)) * 512 + ((a & 3) + 4 * tl) * 64 + 32 * s + 8 * q));
        const f32x4 wlo = *(const f32x4*)(WI + (tokbase + 4 * tg + q) * 8), whi = *(const f32x4*)(WI + (tokbase + 4 * tg + q) * 8 + 4);
        LAS float* myrow = scb + (4 * tg + q) * 2048 + 32 * kh + a;
        const hbits* ksrc = KI + ((size_t)b * T + lrow) * DI + 8 * lch;
        v4u r0 = *(const v4u*)(ksrc), r1 = *(const v4u*)(ksrc + 64 * DI);
        *(LAS v4u*)(kst + wst) = r0;
        r0 = *(const v4u*)(ksrc + 2 * 64 * DI);
        for (int st = 0; st < ns; ++st) {
            __syncthreads();
            if (st + 1 < ns) { *(LAS v4u*)(kst + ((st + 1) & 1) * 8192 + wst) = (st & 1) ? r0 : r1; }
            if (st + 3 < ns) { const v4u nx = *(const v4u*)(ksrc + (size_t)(st + 3) * 64 * DI); if (st & 1) r0 = nx; else r1 = nx; }
            const LAS unsigned char* buf = kst + (st & 1) * 8192;
#pragma unroll
            for (int kt = 0; kt < 2; ++kt) { f32x4 au = (f32x4){0.f, 0.f, 0.f, 0.f}, av = (f32x4){0.f, 0.f, 0.f, 0.f};
#pragma unroll
                for (int s = 0; s < 2; ++s) { const f16x8 bf = __builtin_bit_cast(f16x8, *(const LAS v4u*)(buf + boff[s] + 2048 * kt));
                    au = __builtin_amdgcn_mfma_f32_16x16x32_f16(af[0][s], bf, au, 0, 0, 0); av = __builtin_amdgcn_mfma_f32_16x16x32_f16(af[1][s], bf, av, 0, 0, 0); }
                float sc = wlo[0] * fmaxf(au[0], 0.f); sc = fmaf(wlo[1], fmaxf(au[1], 0.f), sc); sc = fmaf(wlo[2], fmaxf(au[2], 0.f), sc); sc = fmaf(wlo[3], fmaxf(au[3], 0.f), sc);
                sc = fmaf(whi[0], fmaxf(av[0], 0.f), sc); sc = fmaf(whi[1], fmaxf(av[1], 0.f), sc); sc = fmaf(whi[2], fmaxf(av[2], 0.f), sc); sc = fmaf(whi[3], fmaxf(av[3], 0.f), sc);
                myrow[64 * st + 16 * kt] = sc; }
        }
        __syncthreads();
#pragma unroll 1
        for (int tt = 0; tt < (PROBE_REPEAT == 21 ? 4 : 2); ++tt) select_topk(scb + (2 * wave + (tt & 1)) * 2048, t0 + 2 * wave + (tt & 1), IDX + (tokbase + 2 * wave + (tt & 1)) * KSEL, lane);
        __syncthreads();
    }
}

typedef short v4i16_t __attribute__((ext_vector_type(4)));
__device__ __forceinline__ int swz_x(int row) { return ((row & 3) << 2) | ((row >> 2) & 3); }
__device__ __forceinline__ void p3_sparse_attn(Frame& F, hbits* Oout) {
    const int lane = F.lane, wave = F.wave, gw = F.bid * NWAVES + wave, NGW = F.G * NWAVES;
    const int a = lane & 15, q = lane >> 4, sq = ((q & 1) << 1) | (q >> 1);
    LAS unsigned char* kvb = F.lds + wave * 16384;
    LAS unsigned short* idl = (LAS unsigned short*)(F.lds + 131072 + wave * 512);
    LAS float* bt = (LAS float*)(F.lds + 135168);
    const float* rel_bias = F.in[1];
    hbits* QL = (hbits*)(F.ws + WS_QL); const hbits* CKVN = (const hbits*)(F.ws + WS_CKVN); const unsigned short* IDX = (const unsigned short*)(F.ws + WS_IDX);
    for (int i = F.tid; i < 129 * 16; i += NTHREADS) bt[i] = rel_bias[(int)BUCKET_TAB[i >> 4] * 16 + (i & 15)] * pg8::LOG2E;
    __syncthreads();
    const int arow = 4 * ((((a >> 2) & 1) << 1) | (a >> 3)) + (a & 3), xa = swz_x(arow);
    int aoff[4];
#pragma unroll
    for (int s = 0; s < 4; ++s) aoff[s] = 256 * arow + 16 * ((4 * s + q) ^ xa);
    const int trow = 4 * sq + (a >> 2), xt = swz_x(trow);
    int toff[8];
#pragma unroll
    for (int nt = 0; nt < 8; ++nt) toff[nt] = 256 * trow + 16 * ((2 * nt + ((a >> 1) & 1)) ^ xt) + 8 * (a & 1);
    const int drow = lane >> 4;
    for (int i = 0; i * NGW < M; ++i) {
        const int tok = gw + NGW * i; if (tok >= M) break;
        const int b = tok >> 11, t = tok & (T - 1); const int n = (t + 1 < KSEL) ? t + 1 : KSEL, nc = (n + 31) >> 5;
        { const unsigned long long v = *(const unsigned long long*)(IDX + (size_t)tok * KSEL + 4 * lane); *(LAS unsigned long long*)(idl + 4 * lane) = v; }
        f16x8 qf[4];
#pragma unroll
        for (int s = 0; s < 4; ++s) qf[s] = __builtin_bit_cast(f16x8, *(const v4u*)(QL + (size_t)tok * (NH * RL) + a * RL + 32 * s + 8 * q));
        LDS_WAIT(); asm volatile("" ::: "memory");
        const hbits* kvbase = CKVN + (size_t)b * T * RL;
#define P3_DMA(c, buf) do { _Pragma("unroll") for (int g = 0; g < 8; ++g) { const int row = 4 * g + drow; const int key = idl[32 * (c) + row]; \
            __builtin_amdgcn_global_load_lds((const unsigned*)(kvbase + (size_t)key * RL + 8 * ((lane & 15) ^ swz_x(row))), (LAS unsigned*)(kvb + (buf) * 8192 + g * 1024), 16, 0, 0); } } while (0)
        P3_DMA(0, 0);
        float m = -INFINITY, l = 0.f; f32x4 o[8];
#pragma unroll
        for (int nt = 0; nt < 8; ++nt) o[nt] = (f32x4){0.f, 0.f, 0.f, 0.f};
        for (int c = 0; c < nc; ++c) {
            LAS unsigned char* cur = kvb + (c & 1) * 8192;
            if (c + 1 < nc) { LDS_WAIT(); asm volatile("" ::: "memory"); P3_DMA(c + 1, (c + 1) & 1); asm volatile("s_waitcnt vmcnt(8)" ::: "memory"); }
            else { asm volatile("s_waitcnt vmcnt(0)" ::: "memory"); }
            f32x4 s0 = (f32x4){0.f, 0.f, 0.f, 0.f}, s1 = (f32x4){0.f, 0.f, 0.f, 0.f};
#pragma unroll
            for (int s = 0; s < 4; ++s) { const f16x8 k0 = __builtin_bit_cast(f16x8, *(const LAS v4u*)(cur + aoff[s])), k1 = __builtin_bit_cast(f16x8, *(const LAS v4u*)(cur + 4096 + aoff[s]));
                s0 = __builtin_amdgcn_mfma_f32_16x16x32_f16(k0, qf[s], s0, 0, 0, 0); s1 = __builtin_amdgcn_mfma_f32_16x16x32_f16(k1, qf[s], s1, 0, 0, 0); }
            { const unsigned long long i0 = *(const LAS unsigned long long*)(idl + 32 * c + 4 * sq), i1 = *(const LAS unsigned long long*)(idl + 32 * c + 16 + 4 * sq);
#pragma unroll
              for (int r = 0; r < 4; ++r) { const int k0 = (int)((i0 >> (16 * r)) & 0xffffu), k1 = (int)((i1 >> (16 * r)) & 0xffffu);
                  const int r0 = t - k0, r1 = t - k1;
                  s0[r] += bt[(((unsigned)r0 < 128u) ? r0 : 128) * 16 + a]; s1[r] += bt[(((unsigned)r1 < 128u) ? r1 : 128) * 16 + a];
                  if (32 * c + 4 * sq + r >= n) s0[r] = -INFINITY;
                  if (32 * c + 16 + 4 * sq + r >= n) s1[r] = -INFINITY; } }
            float cm = fmaxf(fmaxf(fmaxf(s0[0], s0[1]), fmaxf(s0[2], s0[3])), fmaxf(fmaxf(s1[0], s1[1]), fmaxf(s1[2], s1[3])));
            cm = fmaxf(cm, __shfl_xor(cm, 16)); cm = fmaxf(cm, __shfl_xor(cm, 32));
            const float mn = fmaxf(m, cm), alpha = __builtin_amdgcn_exp2f(m - mn); m = mn;
            float ps = 0.f;
#pragma unroll
            for (int r = 0; r < 4; ++r) { s0[r] = __builtin_amdgcn_exp2f(s0[r] - mn); s1[r] = __builtin_amdgcn_exp2f(s1[r] - mn); ps += s0[r] + s1[r]; }
            l = l * alpha + ps;
#pragma unroll
            for (int nt = 0; nt < 8; ++nt) o[nt] = o[nt] * alpha;
            v4u pw; pw.x = pk2h(s0[0], s0[1]); pw.y = pk2h(s0[2], s0[3]); pw.z = pk2h(s1[0], s1[1]); pw.w = pk2h(s1[2], s1[3]);
            const f16x8 pfr = __builtin_bit_cast(f16x8, pw);
#pragma unroll
            for (int nt = 0; nt < 8; ++nt) {
                const v4i16_t t0 = __builtin_amdgcn_ds_read_tr16_b64_v4i16((LAS v4i16_t*)(cur + toff[nt])), t1 = __builtin_amdgcn_ds_read_tr16_b64_v4i16((LAS v4i16_t*)(cur + 4096 + toff[nt]));
                typedef short v8i16_t __attribute__((ext_vector_type(8)));
                const v8i16_t tv = {t0[0], t0[1], t0[2], t0[3], t1[0], t1[1], t1[2], t1[3]};
                o[nt] = __builtin_amdgcn_mfma_f32_16x16x32_f16(__builtin_bit_cast(f16x8, tv), pfr, o[nt], 0, 0, 0); }
        }
        l += __shfl_xor(l, 16); l += __shfl_xor(l, 32);
        const float inv = 1.0f / l;
        hbits* orow = Oout + (size_t)tok * (NH * RL) + a * RL + 4 * q;
#pragma unroll
        for (int nt = 0; nt < 8; ++nt) { const unsigned long long w = (unsigned long long)pk2h(o[nt][0] * inv, o[nt][1] * inv) | ((unsigned long long)pk2h(o[nt][2] * inv, o[nt][3] * inv) << 32);
            *(unsigned long long*)(orow + 16 * nt) = w; }
        LDS_WAIT(); asm volatile("" ::: "memory");
#undef P3_DMA
    }
}

typedef float f32x16 __attribute__((ext_vector_type(16)));
constexpr float SWA_QSCALE = 0.125f * 1.4426950408889634f;
__device__ __forceinline__ void p8_swa(Frame& F) {
    const int tid = F.tid, lane = F.lane, wave = F.wave, r32 = lane & 31, hh = lane >> 5;
    LAS unsigned char* Ks = F.lds;
    LAS unsigned char* Vs = F.lds + 20480;
    LAS float* btr = (LAS float*)(F.lds + 40960) + wave * 384;
    const float* rel_bias = F.in[1]; const float* sinks = F.in[11];
    const hbits* QKV = (const hbits*)(F.ws + WS_QKV1); hbits* OB = (hbits*)(F.ws + WS_OB);
    for (int i = lane; i < 384; i += 64) { const int rel = 159 - (i % 192), hd = 8 * (i / 192) + wave; btr[i] = (rel >= 0 && rel < 128) ? rel_bias[(int)BUCKET_TAB[rel] * 16 + hd] * pg8::LOG2E : 0.f; }
    const int lrow = tid >> 3, lch = tid & 7;
    const int g = lane >> 4, dh = g & 1, ti = lane & 15, tr_r = ti >> 2, tr_p = ti & 3;
    int kbase[4], vbase[2];
#pragma unroll
    for (int s = 0; s < 4; ++s) kbase[s] = r32 * 128 + 16 * ((2 * s + hh) ^ ((r32 >> 1) & 7));
#pragma unroll
    for (int dt = 0; dt < 2; ++dt) vbase[dt] = (4 * hh + tr_r) * 128 + 16 * ((4 * dt + 2 * dh + (tr_p >> 1)) ^ (((tr_r >> 1) & 1) << 2)) + 8 * (tr_p & 1);
    for (int u = F.bid; u < NB * 2 * (T / 32); u += F.G) {
        const int qt = u & 63, kvh = (u >> 6) & 1, b = u >> 7, t0 = 32 * qt, head = kvh * 8 + wave;
        __syncthreads();
#pragma unroll
        for (int p = 0; p < 3; ++p) { const int row = lrow + 64 * p;
            if (row < 160) { const int key = t0 - 128 + row; v4u kv = (v4u){0u, 0u, 0u, 0u}, vv = (v4u){0u, 0u, 0u, 0u};
                if (key >= 0) { const hbits* base = QKV + ((size_t)b * T + key) * B_IN; kv = *(const v4u*)(base + 1024 + kvh * 64 + 8 * lch); vv = *(const v4u*)(base + 1152 + kvh * 64 + 8 * lch); }
                *(LAS v4u*)(Ks + row * 128 + 16 * (lch ^ ((row >> 1) & 7))) = kv; *(LAS v4u*)(Vs + row * 128 + 16 * (lch ^ (((row >> 1) & 1) << 2))) = vv; } }
        f16x8 qf[4];
#pragma unroll
        for (int s = 0; s < 4; ++s) qf[s] = __builtin_bit_cast(f16x8, *(const v4u*)(QKV + ((size_t)b * T + t0 + r32) * B_IN + head * 64 + 16 * s + 8 * hh));
        __syncthreads();
        f32x16 S[5];
#pragma unroll
        for (int kt = 0; kt < 5; ++kt) {
#pragma unroll
            for (int r = 0; r < 16; ++r) S[kt][r] = 0.f;
#pragma unroll
            for (int s = 0; s < 4; ++s) { const f16x8 kf = __builtin_bit_cast(f16x8, *(const LAS v4u*)(Ks + kbase[s] + kt * 4096));
                S[kt] = __builtin_amdgcn_mfma_f32_32x32x16_f16(kf, qf[s], S[kt], 0, 0, 0); } }
        const float sink2 = sinks[head] * pg8::LOG2E; float m = sink2;
        int base = 128 + r32 - 4 * hh; asm volatile("" : "+v"(base));
        const LAS float* btl = btr + kvh * 192 + (159 - base);
        const int kmin = 128 - t0 - 4 * hh;
#pragma unroll
        for (int kt = 0; kt < 5; ++kt)
#pragma unroll
            for (int r = 0; r < 16; ++r) { const int c = 32 * kt + (r & 3) + 8 * (r >> 2); const int rel = base - c;
                const bool valid = ((unsigned)rel < 128u) && (c >= kmin);
                const float v = valid ? S[kt][r] + btl[c] : -INFINITY; S[kt][r] = v; m = fmaxf(m, v); }
        m = fmaxf(m, __shfl_xor(m, 32));
        float l = 0.f;
#pragma unroll
        for (int kt = 0; kt < 5; ++kt)
#pragma unroll
            for (int r = 0; r < 16; ++r) { const float p = __builtin_amdgcn_exp2f(S[kt][r] - m); S[kt][r] = p; l += p; }
        l += __shfl_xor(l, 32); l += __builtin_amdgcn_exp2f(sink2 - m);
        const float inv = 1.0f / l;
        f32x16 O[2];
#pragma unroll
        for (int dt = 0; dt < 2; ++dt)
#pragma unroll
            for (int r = 0; r < 16; ++r) O[dt][r] = 0.f;
#pragma unroll
        for (int kt = 0; kt < 5; ++kt)
#pragma unroll
            for (int s = 0; s < 2; ++s) { v4u pw; pw.x = pk2h(S[kt][8 * s + 0], S[kt][8 * s + 1]); pw.y = pk2h(S[kt][8 * s + 2], S[kt][8 * s + 3]); pw.z = pk2h(S[kt][8 * s + 4], S[kt][8 * s + 5]); pw.w = pk2h(S[kt][8 * s + 6], S[kt][8 * s + 7]);
                const f16x8 pfr = __builtin_bit_cast(f16x8, pw);
#pragma unroll
                for (int dt = 0; dt < 2; ++dt) {
                    const v4i16_t t1 = __builtin_amdgcn_ds_read_tr16_b64_v4i16((LAS v4i16_t*)(Vs + vbase[dt] + (32 * kt + 16 * s) * 128));
                    const v4i16_t t2 = __builtin_amdgcn_ds_read_tr16_b64_v4i16((LAS v4i16_t*)(Vs + vbase[dt] + (32 * kt + 16 * s + 8) * 128));
                    typedef short v8i16_t __attribute__((ext_vector_type(8)));
                    const v8i16_t tv = {t1[0], t1[1], t1[2], t1[3], t2[0], t2[1], t2[2], t2[3]};
                    O[dt] = __builtin_amdgcn_mfma_f32_32x32x16_f16(__builtin_bit_cast(f16x8, tv), pfr, O[dt], 0, 0, 0); }
                __builtin_amdgcn_sched_barrier(0); }
        hbits* orow = OB + ((size_t)b * T + t0 + r32) * D + head * 64 + 4 * hh;
#pragma unroll
        for (int dt = 0; dt < 2; ++dt)
#pragma unroll
            for (int g4 = 0; g4 < 4; ++g4) { const unsigned long long w = (unsigned long long)pk2h(O[dt][4 * g4] * inv, O[dt][4 * g4 + 1] * inv) | ((unsigned long long)pk2h(O[dt][4 * g4 + 2] * inv, O[dt][4 * g4 + 3] * inv) << 32);
                *(unsigned long long*)(orow + 32 * dt + 8 * g4) = w; }
    }
}

__device__ __forceinline__ void p12_final(Frame& F) {
    const int gw = F.bid * NWAVES + F.wave, NGW = F.G * NWAVES; const float* g = F.in[4];
    for (int m = gw; m < M; m += NGW) {
        GAS f32x4* xr = (GAS f32x4*)(F.out + (size_t)m * D) + F.lane;
        f32x4 v[4]; float s = 0.f;
#pragma unroll
        for (int j = 0; j < 4; ++j) { v[j] = xr[64 * j]; s += (v[j].x * v[j].x + v[j].y * v[j].y) + (v[j].z * v[j].z + v[j].w * v[j].w); }
        const float r = 1.0f / sqrtf(wave_sum(s) * (1.0f / D) + pg8::RMS_EPS);
#pragma unroll
        for (int j = 0; j < 4; ++j) { const f32x4 gv = *((const f32x4*)g + F.lane + 64 * j); xr[64 * j] = v[j] * r * gv; }
    }
}

struct Args { const float* in[16]; float* out; unsigned char* ws; int ph_lo, ph_hi; };
template <bool COOP>
__global__ void __launch_bounds__(NTHREADS, 2) fwd(Args args) {
    extern __shared__ __attribute__((aligned(16))) unsigned char lds[];
    Frame F;
    F.lds = (LAS unsigned char*)lds; F.tid = threadIdx.x; F.lane = F.tid & 63; F.wave = __builtin_amdgcn_readfirstlane(F.tid >> 6);
    F.G = gridDim.x; F.bid = blockIdx.x;
#pragma unroll
    for (int i = 0; i < 16; ++i) F.in[i] = args.in[i];
    F.out = args.out; F.ws = args.ws;
    unsigned char* ws = args.ws;
    const int lo = args.ph_lo, hi = args.ph_hi;
#define IN(k) (lo <= (k) && (k) < hi)
#define REPEAT(k, call) do { if (PROBE_REPEAT == (k)) { __syncthreads(); call; __syncthreads(); } } while (0)
    XcdBarrier bar; bar.bar = (unsigned*)(ws + WS_CTL) + CW_BAR; bar.x = 0; bar.st = nullptr;
    if constexpr (COOP) {
        volatile LAS unsigned* misc = (volatile LAS unsigned*)(F.lds + LDS_MISC);
        if (F.tid < 64) misc[F.tid] = 0u;
        __syncthreads();
        bar = xcd_barrier_post((unsigned*)(ws + WS_CTL) + CW_BAR, misc);
    }
#define SEAM(k) do { if constexpr (COOP) { if (IN(k) && IN((k) + 1)) xcd_barrier(bar); } } while (0)
    typedef pg8::bf16_t hb;
    float* SS1 = (float*)(ws + WS_SS1); float* SS2 = (float*)(ws + WS_SS2); float* SS3 = (float*)(ws + WS_SS3);
    hb* XH = (hb*)(ws + WS_XH);

    if (IN(0)) { p0_prologue(F); REPEAT(0, p0_prologue(F)); } SEAM(0);
    if (IN(1)) {
        pg8::Gemm g{XH, (const hb*)(ws + WS_WA), M, A_PAD, D}; pg8::StaticOrder S; S.init(M, A_PAD, F.G, F.bid);
        pg8::EpiInA E{(const float*)(ws + WS_RS0), (hb*)(ws + WS_QL), (float*)(ws + WS_CKV), (hb*)(ws + WS_QI), (hb*)(ws + WS_KI), (float*)(ws + WS_WI)};
        pg8::gemm_phase<pg8::EpiInA, pg8::StaticOrder, true, true>(F.lds, g, S, E);
        gemm_tail_filler<1>(F, (M / 256) * (A_PAD / 256));
    } SEAM(1);
    if (IN(2)) { p2_indexer(F); REPEAT(2, p2_indexer(F)); } SEAM(2);
    if (IN(3)) { REPEAT(3, p3_sparse_attn(F, (hbits*)F.out)); p3_sparse_attn(F, (hbits*)(ws + WS_QL)); } SEAM(3);
    if (IN(4)) {
        pg8::Gemm g{(const hb*)(ws + WS_QL), (const hb*)(ws + WS_WCT), M, D, NH * RL}; pg8::StaticOrder S; S.init(M, D, F.G, F.bid);
        pg8::EpiRes<false> E{XH, SS1, nullptr, nullptr};
        pg8::gemm_phase<pg8::EpiRes<false>, pg8::StaticOrder, true, true>(F.lds, g, S, E);
    } SEAM(4);
    if (IN(5)) {
        pg8::Gemm g{XH, (const hb*)(ws + WS_WGU0), M, 2 * FF, D}; pg8::StaticOrder S; S.init(M, 2 * FF, F.G, F.bid);
        pg8::EpiGU E{SS1, (hb*)(ws + WS_HB)};
        pg8::gemm_phase<pg8::EpiGU, pg8::StaticOrder, true, true>(F.lds, g, S, E);
        gemm_tail_filler<2>(F, (M / 256) * (2 * FF / 256));
    } SEAM(5);
    if (IN(6)) {
        pg8::Gemm g{(const hb*)(ws + WS_HB), (const hb*)(ws + WS_WD0), M, D, FF}; pg8::StaticOrder S; S.init(M, D, F.G, F.bid);
        pg8::EpiRes<false> E{XH, SS2, nullptr, nullptr};
        pg8::gemm_phase<pg8::EpiRes<false>, pg8::StaticOrder, true, true>(F.lds, g, S, E);
    } SEAM(6);
    if (IN(7)) {
        pg8::Gemm g{XH, (const hb*)(ws + WS_WB), M, B_IN, D}; pg8::StaticOrder S; S.init(M, B_IN, F.G, F.bid);
        pg8::EpiInB E{SS2, F.in[10], (hb*)(ws + WS_QKV1)};
        pg8::gemm_phase<pg8::EpiInB, pg8::StaticOrder, true, true>(F.lds, g, S, E);
        gemm_tail_filler<3>(F, (M / 256) * (B_IN / 256));
    } SEAM(7);
    if (IN(8)) { p8_swa(F); REPEAT(8, p8_swa(F)); } SEAM(8);
    if (IN(9)) {
        pg8::Gemm g{(const hb*)(ws + WS_OB), (const hb*)(ws + WS_WBO), M, D, D}; pg8::StaticOrder S; S.init(M, D, F.G, F.bid);
        pg8::EpiRes<false> E{XH, SS3, F.in[13], nullptr};
        pg8::gemm_phase<pg8::EpiRes<false>, pg8::StaticOrder, true, true>(F.lds, g, S, E);
    } SEAM(9);
    if (IN(10)) {
        pg8::Gemm g{XH, (const hb*)(ws + WS_WGU1), M, 2 * FF, D}; pg8::StaticOrder S; S.init(M, 2 * FF, F.G, F.bid);
        pg8::EpiGU E{SS3, (hb*)(ws + WS_HB)};
        pg8::gemm_phase<pg8::EpiGU, pg8::StaticOrder, true, true>(F.lds, g, S, E);
    } SEAM(10);
    if (IN(11)) {
        pg8::Gemm g{(const hb*)(ws + WS_HB), (const hb*)(ws + WS_WD1), M, D, FF}; pg8::StaticOrder S; S.init(M, D, F.G, F.bid);
        pg8::EpiRes<true> E{XH, nullptr, nullptr, F.out};
        pg8::gemm_phase<pg8::EpiRes<true>, pg8::StaticOrder, true, true>(F.lds, g, S, E);
    } SEAM(11);
    if (IN(12)) { p12_final(F); }
#undef IN
#undef SEAM
}

extern "C" void kernel_launch(void* const* d_in, const int* in_sizes, int n_in, void* d_out, int out_size, void* d_ws, size_t ws_size, hipStream_t stream) {
    static int grid = 0;
    if (grid == 0) {
        if (n_in != 16 || in_sizes[0] != M * D || out_size != M * D || ws_size < WS_END) { fprintf(stderr, "kernel_launch: unexpected shapes (n_in %d, in0 %d, out %d, ws %zu)\n", n_in, n_in > 0 ? in_sizes[0] : -1, out_size, ws_size); grid = -1; return; }
        int dev = 0, cus = 0, per_cu = 0;
        if (hipGetDevice(&dev) != hipSuccess || hipDeviceGetAttribute(&cus, hipDeviceAttributeMultiprocessorCount, dev) != hipSuccess) { grid = -1; return; }
        const void* fn = MK_ONE_LAUNCH ? (const void*)fwd<true> : (const void*)fwd<false>;
        if (hipFuncSetAttribute(fn, hipFuncAttributeMaxDynamicSharedMemorySize, LDS_BYTES) != hipSuccess) { fprintf(stderr, "kernel_launch: hipFuncSetAttribute failed\n"); grid = -1; return; }
        if (hipOccupancyMaxActiveBlocksPerMultiprocessor(&per_cu, fn, NTHREADS, LDS_BYTES) != hipSuccess || per_cu < 1) { fprintf(stderr, "kernel_launch: occupancy query says %d blocks per CU\n", per_cu); per_cu = 1; }
        (void)hipGetLastError();
        grid = cus;
    }
    if (grid < 0) return;
    (void)hipMemsetAsync((char*)d_ws + WS_CTL, 0, CTL_ZERO_BYTES, stream);
    Args a{};
    for (int i = 0; i < 16; ++i) a.in[i] = (const float*)d_in[i];
    a.out = (float*)d_out; a.ws = (unsigned char*)d_ws;
#if MK_ONE_LAUNCH
    a.ph_lo = 0; a.ph_hi = N_PHASES;
    hipLaunchKernelGGL(fwd<true>, dim3(grid), dim3(NTHREADS), LDS_BYTES, stream, a);
#else
    for (int p = 0; p < N_PHASES; ++p) { a.ph_lo = p; a.ph_hi = p + 1; hipLaunchKernelGGL(fwd<false>, dim3(grid), dim3(NTHREADS), LDS_BYTES, stream, a); }
#endif
}
```
